# Optimizing an MI355X kernel written in HIP

```python
import jax, jax.numpy as jnp
from jax import lax
import numpy as np

D_MODEL = 1024
BATCH = 8
SEQ = 2048
DEPTH = 1

N_META = 16
POOL_WINDOWS = (2, 4, 8, 16)
N_POOL_GROUPS = 4
POOL_WIDTH = D_MODEL
POOL_GROUP_DIM = POOL_WIDTH // N_POOL_GROUPS
DN_HEADS = 8
DN_HEAD_DIM = 128
DN_WIDTH = DN_HEADS * DN_HEAD_DIM
CONV_WIDTH = 4
CHUNK = 64
N_EXPERT_GROUPS = 4
EXPERTS_PER_GROUP = 8
N_EXPERTS = N_EXPERT_GROUPS * EXPERTS_PER_GROUP
TOP_K_IN_GROUP = 2
D_FF_EXPERT = 512
NORM_EPS = 1e-6
PROJ_SPLITS = [POOL_WIDTH, POOL_WIDTH + 3 * DN_WIDTH, POOL_WIDTH + 4 * DN_WIDTH,
               POOL_WIDTH + 4 * DN_WIDTH + DN_HEADS, POOL_WIDTH + 4 * DN_WIDTH + 2 * DN_HEADS,
               POOL_WIDTH + 4 * DN_WIDTH + 2 * DN_HEADS + D_MODEL]
PROJ_COLS = POOL_WIDTH + 4 * DN_WIDTH + 2 * DN_HEADS + 2 * D_MODEL

kernel_name = "hybrid_pool_gdn_hiermoe_block"


def rmsnorm(x, w):
    xf = x.astype(jnp.float32)
    y = xf * lax.rsqrt(jnp.mean(xf * xf, axis=-1, keepdims=True) + NORM_EPS)
    return (y * w.astype(jnp.float32)).astype(x.dtype)


def l2norm(t):
    return t * lax.rsqrt(jnp.sum(t * t, axis=-1, keepdims=True) + NORM_EPS)


def multiscale_pool_branch(u, pool_w, pool_scale):
    Bsz, L, _ = u.shape
    uf = u.astype(jnp.float32)
    cs = jnp.concatenate([jnp.zeros((Bsz, 1, POOL_WIDTH), jnp.float32), jnp.cumsum(uf, axis=1)], axis=1)
    t = jnp.arange(L)
    outs = []
    for gi, win in enumerate(POOL_WINDOWS):
        cs_g = cs[:, :, gi * POOL_GROUP_DIM:(gi + 1) * POOL_GROUP_DIM]
        start = jnp.maximum(t + 1 - win, 0)
        window_sum = cs_g[:, 1:] - jnp.take(cs_g, start, axis=1)
        count = (t + 1 - start).astype(jnp.float32)
        outs.append(window_sum / count[None, :, None])
    pooled = jnp.concatenate(outs, axis=-1) - uf
    pooled = pooled.reshape(Bsz, L, N_POOL_GROUPS, POOL_GROUP_DIM)
    mixed = jnp.einsum('blgc,gcd->blgd', pooled, pool_w.astype(jnp.float32)).reshape(Bsz, L, POOL_WIDTH)
    return (mixed * pool_scale.astype(jnp.float32)).astype(u.dtype)


def causal_depthwise_conv(x, w):
    C = x.shape[-1]
    return lax.conv_general_dilated(x, w[:, None, :].astype(x.dtype), window_strides=(1,),
                                    padding=[(CONV_WIDTH - 1, 0)],
                                    dimension_numbers=('NWC', 'WIO', 'NWC'), feature_group_count=C)


def chunk_gated_delta_rule(q, k, v, g, beta, S0, chunk):
    Bsz, H, T, dk = q.shape
    dv = v.shape[-1]
    n = T // chunk
    q = q.reshape(Bsz, H, n, chunk, dk) * (dk ** -0.5)
    k = k.reshape(Bsz, H, n, chunk, dk)
    v = v.reshape(Bsz, H, n, chunk, dv)
    beta = beta.reshape(Bsz, H, n, chunk)
    gam = jnp.cumsum(g.reshape(Bsz, H, n, chunk), axis=-1)
    idx = jnp.arange(chunk)
    lower_incl = idx[:, None] >= idx[None, :]
    strict = idx[:, None] > idx[None, :]
    decay_mat = jnp.exp(jnp.where(lower_incl, gam[..., :, None] - gam[..., None, :], -jnp.inf))
    kk = jnp.einsum('bhncd,bhnsd->bhncs', k, k)
    A = jnp.where(strict, beta[..., :, None] * kk * decay_mat, 0.0)
    rhs = jnp.concatenate([v * beta[..., None], k * (beta * jnp.exp(gam))[..., None]], axis=-1)
    sol = lax.linalg.triangular_solve(A, rhs, left_side=True, lower=True, unit_diagonal=True)
    u_w, w_w = sol[..., :dv], sol[..., dv:]
    qk = jnp.einsum('bhncd,bhnsd->bhncs', q, k) * decay_mat
    q_dec = q * jnp.exp(gam)[..., None]
    k_dec = k * jnp.exp(gam[..., -1:] - gam)[..., None]
    chunk_decay = jnp.exp(gam[..., -1])

    def step(S, xs):
        u_c, w_c, qk_c, qd_c, kd_c, cd_c = xs
        v_new = u_c - jnp.einsum('bhck,bhkv->bhcv', w_c, S)
        o_c = jnp.einsum('bhck,bhkv->bhcv', qd_c, S) + jnp.einsum('bhcs,bhsv->bhcv', qk_c, v_new)
        S = S * cd_c[..., None, None] + jnp.einsum('bhck,bhcv->bhkv', kd_c, v_new)
        return S, o_c

    xs = tuple(jnp.moveaxis(t_, 2, 0) for t_ in (u_w, w_w, qk, q_dec, k_dec, chunk_decay))
    S_final, o = lax.scan(step, S0, xs)
    o = jnp.moveaxis(o, 0, 2).reshape(Bsz, H, T, dv)
    return o, S_final


def gated_deltanet_branch(p_qkv, p_z, p_a, p_b, conv_w, a_log, dt_bias, norm_w):
    Bsz, L, _ = p_qkv.shape
    qkv = jax.nn.silu(causal_depthwise_conv(p_qkv, conv_w))
    q, k, v = jnp.split(qkv, 3, axis=-1)

    def heads(t):
        return t.reshape(Bsz, L, DN_HEADS, DN_HEAD_DIM).transpose(0, 2, 1, 3).astype(jnp.float32)

    q = l2norm(heads(q))
    k = l2norm(heads(k))
    v = heads(v)
    beta = jax.nn.sigmoid(p_b.astype(jnp.float32)).transpose(0, 2, 1)
    g = (-jnp.exp(a_log.astype(jnp.float32))
         * jax.nn.softplus(p_a.astype(jnp.float32) + dt_bias.astype(jnp.float32))).transpose(0, 2, 1)
    S0 = jnp.zeros((Bsz, DN_HEADS, DN_HEAD_DIM, DN_HEAD_DIM), jnp.float32)
    o_meta, S_meta = chunk_gated_delta_rule(q[:, :, :N_META], k[:, :, :N_META], v[:, :, :N_META],
                                            g[:, :, :N_META], beta[:, :, :N_META], S0, N_META)
    o_real, _ = chunk_gated_delta_rule(q[:, :, N_META:], k[:, :, N_META:], v[:, :, N_META:],
                                       g[:, :, N_META:], beta[:, :, N_META:], S_meta, CHUNK)
    o = jnp.concatenate([o_meta, o_real], axis=2).transpose(0, 2, 1, 3)
    o = o * lax.rsqrt(jnp.mean(o * o, axis=-1, keepdims=True) + NORM_EPS) * norm_w.astype(jnp.float32)
    z = p_z.astype(jnp.float32).reshape(Bsz, L, DN_HEADS, DN_HEAD_DIM)
    o = o * jax.nn.silu(z)
    return o.reshape(Bsz, L, DN_WIDTH).astype(p_qkv.dtype)


def hierarchical_moe(u, w_grp, b_grp, w_rtr, b_rtr, w_gate, w_up, w_down):
    Bsz, L, D = u.shape
    xt = u.reshape(-1, D)
    grp_probs = jax.nn.softmax((xt @ w_grp + b_grp).astype(jnp.float32), axis=-1)
    p_grp, g_idx = lax.top_k(grp_probs, 1)
    exp_logits = (xt @ w_rtr + b_rtr).astype(jnp.float32).reshape(-1, N_EXPERT_GROUPS, EXPERTS_PER_GROUP)
    sel_logits = jnp.take_along_axis(exp_logits, g_idx[:, :, None], axis=1)[:, 0]
    w_e, e_idx = lax.top_k(jax.nn.softmax(sel_logits, axis=-1), TOP_K_IN_GROUP)
    w_e = w_e / jnp.sum(w_e, axis=-1, keepdims=True)
    exp_weight = jnp.sum(jax.nn.one_hot(e_idx, EXPERTS_PER_GROUP, dtype=jnp.float32) * w_e[..., None], axis=1)
    comb = (jax.nn.one_hot(g_idx[:, 0], N_EXPERT_GROUPS, dtype=jnp.float32)[:, :, None]
            * (p_grp * exp_weight)[:, None, :])
    y = jnp.zeros_like(xt)
    for gi in range(N_EXPERT_GROUPS):
        hdn = (jax.nn.silu(jnp.einsum('nd,edf->nef', xt, w_gate[gi]))
               * jnp.einsum('nd,edf->nef', xt, w_up[gi]))
        hdn = hdn * comb[:, gi, :, None].astype(hdn.dtype)
        y = y + jnp.einsum('nef,efd->nd', hdn, w_down[gi])
    return y.reshape(Bsz, L, D)


def setup_inputs(seed: int = 0) -> dict:
    key = jax.random.key(seed)
    ks = jax.random.split(key, 24)
    f32 = jnp.float32
    dt = jnp.exp(jax.random.uniform(ks[8], (DEPTH, DN_HEADS), f32, np.log(0.001), np.log(0.1)))
    return {
        'x': jax.random.normal(ks[0], (BATCH, SEQ, D_MODEL), f32),
        'meta_tokens': jax.random.normal(ks[1], (N_META, D_MODEL), f32),
        'norm_mix_w': 1.0 + 0.02 * jax.random.normal(ks[2], (DEPTH, D_MODEL), f32),
        'w_in': jax.random.normal(ks[3], (DEPTH, D_MODEL, PROJ_COLS), f32) * D_MODEL ** -0.5,
        'conv_w': jax.random.normal(ks[4], (DEPTH, CONV_WIDTH, 3 * DN_WIDTH), f32) * CONV_WIDTH ** -0.5,
        'pool_w': jax.random.normal(ks[5], (DEPTH, N_POOL_GROUPS, POOL_GROUP_DIM, POOL_GROUP_DIM), f32) * POOL_GROUP_DIM ** -0.5,
        'pool_scale': 1.0 + 0.1 * jax.random.normal(ks[6], (DEPTH, POOL_WIDTH), f32),
        'a_log': jnp.log(jax.random.uniform(ks[7], (DEPTH, DN_HEADS), f32, 1.0, 16.0)),
        'dt_bias': dt + jnp.log(-jnp.expm1(-dt)),
        'dn_norm_w': 1.0 + 0.02 * jax.random.normal(ks[9], (DEPTH, DN_HEAD_DIM), f32),
        'w_out': jax.random.normal(ks[10], (DEPTH, D_MODEL, D_MODEL), f32) * D_MODEL ** -0.5,
        'norm_ffn_w': 1.0 + 0.02 * jax.random.normal(ks[11], (DEPTH, D_MODEL), f32),
        'router_group_w': jax.random.normal(ks[12], (DEPTH, D_MODEL, N_EXPERT_GROUPS), f32) * D_MODEL ** -0.5,
        'router_group_b': 0.01 * jax.random.normal(ks[13], (DEPTH, N_EXPERT_GROUPS), f32),
        'router_expert_w': jax.random.normal(ks[14], (DEPTH, D_MODEL, N_EXPERTS), f32) * D_MODEL ** -0.5,
        'router_expert_b': 0.01 * jax.random.normal(ks[15], (DEPTH, N_EXPERTS), f32),
        'expert_w_gate': jax.random.normal(ks[16], (DEPTH, N_EXPERT_GROUPS, EXPERTS_PER_GROUP, D_MODEL, D_FF_EXPERT), f32) * D_MODEL ** -0.5,
        'expert_w_up': jax.random.normal(ks[17], (DEPTH, N_EXPERT_GROUPS, EXPERTS_PER_GROUP, D_MODEL, D_FF_EXPERT), f32) * D_MODEL ** -0.5,
        'expert_w_down': jax.random.normal(ks[18], (DEPTH, N_EXPERT_GROUPS, EXPERTS_PER_GROUP, D_FF_EXPERT, D_MODEL), f32) * D_FF_EXPERT ** -0.5,
        'norm_final_w': 1.0 + 0.02 * jax.random.normal(ks[19], (D_MODEL,), f32),
    }


def reference(x, meta_tokens, norm_mix_w, w_in, conv_w, pool_w, pool_scale, a_log, dt_bias, dn_norm_w,
              w_out, norm_ffn_w, router_group_w, router_group_b, router_expert_w, router_expert_b,
              expert_w_gate, expert_w_up, expert_w_down, norm_final_w):
    Bsz = x.shape[0]
    meta = jnp.broadcast_to(meta_tokens[None].astype(x.dtype), (Bsz, N_META, D_MODEL))
    h = jnp.concatenate([meta, x], axis=1)
    for layer in range(DEPTH):
        u = rmsnorm(h, norm_mix_w[layer])
        p = u @ w_in[layer]
        p_pool, p_qkv, p_z, p_a, p_b, g_pool, g_dn = jnp.split(p, PROJ_SPLITS, axis=-1)
        y_pool = multiscale_pool_branch(p_pool, pool_w[layer], pool_scale[layer])
        y_dn = gated_deltanet_branch(p_qkv, p_z, p_a, p_b, conv_w[layer], a_log[layer], dt_bias[layer],
                                     dn_norm_w[layer])
        merged = jax.nn.sigmoid(g_pool) * y_pool + jax.nn.sigmoid(g_dn) * y_dn
        h = h + merged @ w_out[layer]
        h = h + hierarchical_moe(rmsnorm(h, norm_ffn_w[layer]), router_group_w[layer], router_group_b[layer],
                                 router_expert_w[layer], router_expert_b[layer], expert_w_gate[layer],
                                 expert_w_up[layer], expert_w_down[layer])
    out = rmsnorm(h, norm_final_w)
    return out[:, N_META:]
```

```cpp
#include <hip/hip_runtime.h>
#include <cstdio>
#include <cstdint>

namespace pg8 {
#define PG8_LAS __attribute__((address_space(3)))
typedef unsigned short bf16_t;
typedef short bf16x8 __attribute__((ext_vector_type(8)));
typedef float f32x4 __attribute__((ext_vector_type(4)));
typedef unsigned u32x4 __attribute__((ext_vector_type(4)));
typedef unsigned u32x2 __attribute__((ext_vector_type(2)));
constexpr int BM = 256, BK = 64, HALF = 128, HTB = HALF * BK * 2  , STAGE_BYTES = 8 * HTB, NXCD = 8, WGM = 8;

__host__ __device__ __forceinline__ int lds_byte(int r, int c) { const int st = (r >> 4) * 2 + (c >> 5), rr = r & 15, cc = c & 31, ob = rr * 64 + cc * 2; return st * 1024 + (ob ^ (((ob >> 9) & 1) << 5)); }
__host__ __device__ __forceinline__ void stage_rc(int b, int& R, int& C) { const int st = b / 1024, sb = b % 1024, swz = sb ^ (((sb >> 9) & 1) << 5); R = (st >> 1) * 16 + swz / 64; C = (st & 1) * 32 + (swz % 64) / 2; }
__host__ __device__ __forceinline__ int perm32(int rho) { const int n = rho >> 4, i = rho & 15; return 8 * (i >> 2) + 4 * n + (i & 3); }

struct Unit { int pm, pn; };
struct Gemm { const bf16_t* A; const bf16_t* Bt; int M, N, K; };

struct StaticOrder {
    int nM, nN, nwg, G, c;
    __host__ __device__ void init(int M, int N, int G_, int c_) { nM = M / BM; nN = N / BM; nwg = nM * nN; G = G_; c = c_; }
    __host__ __device__ bool next(int i, Unit& u) const {
        const long L = (long)i * G + c; if (L >= nwg) return false;
        int wgid = (int)L; { const int q = nwg / NXCD, r = nwg % NXCD, xcd = wgid % NXCD, off = wgid / NXCD; wgid = (xcd < r ? xcd * (q + 1) : r * (q + 1) + (xcd - r) * q) + off; }
        const int nig = WGM * nN, gid = wgid / nig, fm = gid * WGM, gsz = (nM - fm) < WGM ? (nM - fm) : WGM;
        u.pm = fm + ((wgid % nig) % gsz); u.pn = (wgid % nig) / gsz; return true;
    }
    __device__ __forceinline__ int gather_row(const Unit&, int) const { return 0; }
};

template <class Epi, class Sched, bool ALIGN_EPI, bool GATHER>
__device__ __forceinline__ void gemm_phase(PG8_LAS unsigned char* lds, const Gemm g, const Sched& S, const Epi& E) {
    const int tid = threadIdx.x, wid = __builtin_amdgcn_readfirstlane(tid >> 6), lane = tid & 63, wr = wid >> 2, wc = wid & 3, fr = lane & 15, fq = lane >> 4;
    const int K = g.K, nt = K / BK;
    unsigned voffA[2], voffB[2]; int RA[2], CA[2];
#pragma unroll
    for (int i = 0; i < 2; ++i) { int R, C; stage_rc(tid * 16 + i * 8192, R, C); const int Rb = Epi::PERM ? ((R & ~31) + perm32(R & 31)) : R;
        RA[i] = R; CA[i] = C; voffA[i] = (unsigned)(R * K + C) * 2u; voffB[i] = (unsigned)(Rb * K + C) * 2u; }
    const size_t kstep = (size_t)(BK * 2);
    const size_t hstep = (size_t)HALF * K * 2;
    const size_t tstep = 2 * hstep;
    const unsigned ldsw = (unsigned)wid * 1024u;
    const int aoff = lds_byte(wr * 64 + fr, fq * 8), boff = lds_byte(wc * 32 + fr, fq * 8);
#define PG8_SA(b, h) (((b) * 2 + (h)) * HTB)
#define PG8_SB(b, h) ((4 + (b) * 2 + (h)) * HTB)
#define PG8_STAGE(bufoff, gbase, voff) do { _Pragma("unroll") for (int _i = 0; _i < 2; ++_i) \
        __builtin_amdgcn_global_load_lds((const unsigned*)((const char*)(gbase) + (voff)[_i]), (PG8_LAS unsigned*)(lds + (bufoff) + ldsw + _i * 8192), 16, 0, 0); } while (0)
#define PG8_STAGE_A(b, h, gbase, NEXT) do { if constexpr (GATHER) { unsigned _vo[2] = { (NEXT) ? nvo[h][0] : cvo[h][0], (NEXT) ? nvo[h][1] : cvo[h][1] }; PG8_STAGE(PG8_SA(b, h), (gbase), _vo); } \
        else { PG8_STAGE(PG8_SA(b, h), (gbase) + (h) * hstep, voffA); } } while (0)
#define PG8_LDA(dst, b, h) do { _Pragma("unroll") for (int m = 0; m < 4; ++m) _Pragma("unroll") for (int k = 0; k < 2; ++k) dst[m][k] = *(const PG8_LAS bf16x8*)(lds + PG8_SA(b, h) + aoff + m * 2048 + k * 1024); } while (0)
#define PG8_LDB(dst, b, h) do { _Pragma("unroll") for (int n = 0; n < 2; ++n) _Pragma("unroll") for (int k = 0; k < 2; ++k) dst[n][k] = *(const PG8_LAS bf16x8*)(lds + PG8_SB(b, h) + boff + n * 2048 + k * 1024); } while (0)
#define PG8_MMA(ai, bj, At, Bt) do { __builtin_amdgcn_s_setprio(1); _Pragma("unroll") for (int m = 0; m < 4; ++m) _Pragma("unroll") for (int n = 0; n < 2; ++n) _Pragma("unroll") for (int k = 0; k < 2; ++k) \
        acc[ai][bj][m][n] = __builtin_amdgcn_mfma_f32_16x16x32_bf16(Bt[n][k], At[m][k], acc[ai][bj][m][n], 0, 0, 0); __builtin_amdgcn_s_setprio(0); } while (0)
#define PG8_WAIT_V(n) asm volatile("s_waitcnt vmcnt(" #n ")" ::: "memory")
#define PG8_WAIT_L(n) asm volatile("s_waitcnt lgkmcnt(" #n ")" ::: "memory")
#define PG8_BAR __builtin_amdgcn_s_barrier()
#define PG8_SCHED __builtin_amdgcn_sched_barrier(0)
    Unit cur, nxt; int ui = 0;
    if (!S.next(0, cur)) return;
    f32x4 acc[2][2][4][2];
#pragma unroll
    for (int a = 0; a < 2; ++a)
#pragma unroll
        for (int b = 0; b < 2; ++b)
#pragma unroll
            for (int m = 0; m < 4; ++m)
#pragma unroll
                for (int n = 0; n < 2; ++n) acc[a][b][m][n] = (f32x4){0.f, 0.f, 0.f, 0.f};
    bf16x8 At[4][2], B0[2][2], B1[2][2];
    unsigned cvo[2][2] = {{0u, 0u}, {0u, 0u}}, nvo[2][2] = {{0u, 0u}, {0u, 0u}};
    if constexpr (GATHER) {
#pragma unroll
        for (int h = 0; h < 2; ++h)
#pragma unroll
            for (int i = 0; i < 2; ++i) cvo[h][i] = (unsigned)(S.gather_row(cur, h * HALF + RA[i]) * K + CA[i]) * 2u;
    }
    const char* cA = GATHER ? (const char*)g.A : (const char*)g.A + (size_t)cur.pm * tstep; const char* cB = (const char*)g.Bt + (size_t)cur.pn * tstep;
    PG8_STAGE(PG8_SB(0, 0), cB, voffB); PG8_STAGE(PG8_SB(0, 1), cB + hstep, voffB); PG8_STAGE_A(0, 0, cA, false); PG8_STAGE_A(0, 1, cA, false);
    if (wr == 1) PG8_BAR;
    PG8_WAIT_V(2); PG8_BAR;
    PG8_STAGE(PG8_SB(1, 0), cB + kstep, voffB); PG8_STAGE_A(1, 0, cA + kstep, false); PG8_STAGE(PG8_SB(1, 1), cB + hstep + kstep, voffB);
    PG8_WAIT_V(6); PG8_BAR;
    for (;;) {
        const bool has_next = S.next(ui + 1, nxt);
        const char* nA = GATHER ? (const char*)g.A : (has_next ? (const char*)g.A + (size_t)nxt.pm * tstep : cA);
        const char* nB = has_next ? (const char*)g.Bt + (size_t)nxt.pn * tstep : cB;
        for (int t = 0; t < nt; t += 2) {
            const bool last = (t == nt - 2);
            const char* a1 = cA + (size_t)(t + 1) * kstep;
            const char* a2 = last ? nA : cA + (size_t)(t + 2) * kstep; const char* b2 = last ? nB : cB + (size_t)(t + 2) * kstep;
            const char* a3 = a2 + kstep; const char* b3 = b2 + kstep;
            if constexpr (GATHER) { if (last) {
#pragma unroll
                for (int h = 0; h < 2; ++h)
#pragma unroll
                    for (int i = 0; i < 2; ++i) nvo[h][i] = has_next ? (unsigned)(S.gather_row(nxt, h * HALF + RA[i]) * K + CA[i]) * 2u : cvo[h][i];
            } }
            PG8_LDB(B0, 0, 0); PG8_LDB(B1, 0, 1); PG8_SCHED; PG8_LDA(At, 0, 0); PG8_STAGE_A(1, 1, a1, false);
            PG8_WAIT_V(8); PG8_WAIT_L(0); PG8_BAR; PG8_MMA(0, 0, At, B0); PG8_MMA(0, 1, At, B1); PG8_BAR; PG8_SCHED;
            PG8_LDA(At, 0, 1); PG8_STAGE(PG8_SB(0, 0), b2, voffB); PG8_STAGE(PG8_SB(0, 1), b2 + hstep, voffB); PG8_STAGE_A(0, 0, a2, last);
            PG8_WAIT_V(8); PG8_WAIT_L(0); PG8_BAR; PG8_MMA(1, 0, At, B0); PG8_MMA(1, 1, At, B1); PG8_BAR; PG8_SCHED;
            PG8_LDB(B0, 1, 0); PG8_LDB(B1, 1, 1); PG8_SCHED; PG8_LDA(At, 1, 0); PG8_STAGE_A(0, 1, a2, last);
            PG8_WAIT_V(8); PG8_WAIT_L(0); PG8_BAR; PG8_MMA(0, 0, At, B0); PG8_MMA(0, 1, At, B1); PG8_BAR; PG8_SCHED;
            PG8_LDA(At, 1, 1); PG8_STAGE(PG8_SB(1, 0), b3, voffB); PG8_STAGE(PG8_SB(1, 1), b3 + hstep, voffB); PG8_STAGE_A(1, 0, a3, last);
            PG8_WAIT_V(8); PG8_WAIT_L(0); PG8_BAR; PG8_MMA(1, 0, At, B0); PG8_MMA(1, 1, At, B1); PG8_BAR; PG8_SCHED;
        }
        if constexpr (ALIGN_EPI) { if (wr == 0) PG8_BAR; }
        E(acc, cur, wr, wc, fr, fq);
        if (!has_next) break;
#pragma unroll
        for (int a = 0; a < 2; ++a)
#pragma unroll
            for (int b = 0; b < 2; ++b)
#pragma unroll
                for (int m = 0; m < 4; ++m)
#pragma unroll
                    for (int n = 0; n < 2; ++n) acc[a][b][m][n] = (f32x4){0.f, 0.f, 0.f, 0.f};
        cur = nxt; cA = nA; cB = nB; ++ui;
        if constexpr (GATHER) {
#pragma unroll
            for (int h = 0; h < 2; ++h)
#pragma unroll
                for (int i = 0; i < 2; ++i) cvo[h][i] = nvo[h][i];
        }
        if constexpr (ALIGN_EPI) { if (wr == 1) PG8_BAR; }
    }
    PG8_WAIT_V(0);
    if constexpr (!ALIGN_EPI) { if (wr == 0) PG8_BAR; }
    PG8_BAR;
#undef PG8_SA
#undef PG8_SB
#undef PG8_STAGE
#undef PG8_STAGE_A
#undef PG8_LDA
#undef PG8_LDB
#undef PG8_MMA
#undef PG8_WAIT_V
#undef PG8_WAIT_L
#undef PG8_BAR
#undef PG8_SCHED
}
}

#define GAS __attribute__((address_space(1)))
#define LAS __attribute__((address_space(3)))
typedef unsigned short bf16;
typedef unsigned v4u __attribute__((ext_vector_type(4)));
typedef unsigned v2u __attribute__((ext_vector_type(2)));
typedef float f32x4 __attribute__((ext_vector_type(4)));
typedef float f32x16 __attribute__((ext_vector_type(16)));
typedef short bf16x8 __attribute__((ext_vector_type(8)));
typedef __bf16 bf16x2_t __attribute__((ext_vector_type(2)));
typedef float f32x2_t __attribute__((ext_vector_type(2)));
typedef GAS unsigned gu32;
#define RLX_AGENT __ATOMIC_RELAXED, __HIP_MEMORY_SCOPE_AGENT
#define LDS_WAIT() asm volatile("s_waitcnt lgkmcnt(0)" ::: "memory")
#define VM_WAIT() asm volatile("s_waitcnt vmcnt(0)" ::: "memory")
__device__ __forceinline__ unsigned pk2(float lo, float hi) { f32x2_t v = {lo, hi}; bf16x2_t r = __builtin_convertvector(v, bf16x2_t); return __builtin_bit_cast(unsigned, r); }
__device__ __forceinline__ unsigned short f2bf(float f) { return (unsigned short)(pk2(f, 0.f) & 0xffffu); }
__device__ __forceinline__ float bf2f(unsigned short b) { return __builtin_bit_cast(float, ((unsigned)b) << 16); }
__device__ __forceinline__ float bflo(unsigned w) { return __builtin_bit_cast(float, w << 16); }
__device__ __forceinline__ float bfhi(unsigned w) { return __builtin_bit_cast(float, w & 0xffff0000u); }
__device__ __forceinline__ float sigmoidf_(float x) { return 1.f / (1.f + __expf(-x)); }
__device__ __forceinline__ float siluf_(float x) { return x / (1.f + __expf(-x)); }
__device__ __forceinline__ float wave_sum(float v) {
#pragma unroll
    for (int o = 1; o < 64; o <<= 1) v += __shfl_xor(v, o);
    return v;
}
__device__ __forceinline__ int crow(int reg, int h) { return (reg & 3) + 8 * (reg >> 2) + 4 * h; }
#define MFMA32(a, b, c) __builtin_amdgcn_mfma_f32_32x32x16_bf16((a), (b), (c), 0, 0, 0)
#define MFMA16(a, b, c) __builtin_amdgcn_mfma_f32_16x16x32_bf16((a), (b), (c), 0, 0, 0)
__device__ __forceinline__ bf16x8 pack_step(const f32x16& x, int s) {
    v4u p; p.x = pk2(x[8 * s], x[8 * s + 1]); p.y = pk2(x[8 * s + 2], x[8 * s + 3]); p.z = pk2(x[8 * s + 4], x[8 * s + 5]); p.w = pk2(x[8 * s + 6], x[8 * s + 7]);
    return __builtin_bit_cast(bf16x8, p);
}

#define XB_TMO      128
#define XB_XCNT(j)  (256  + 64 * (j))
#define XB_XSUB(j)  (1280 + 64 * (j))
#define XB_XGEN(j)  (2304 + 64 * (j))
#define XB_TOP      3328
#define XB_TOPGEN   3392
#define XCD_BAR_WORDS 3456
#define XB_SPIN_CAP (1u << 18)

__device__ __forceinline__ unsigned xb_ld(unsigned* p)              { return __hip_atomic_load(p, __ATOMIC_RELAXED, __HIP_MEMORY_SCOPE_AGENT); }
__device__ __forceinline__ unsigned xb_add(unsigned* p, unsigned v) { return __hip_atomic_fetch_add(p, v, __ATOMIC_RELAXED, __HIP_MEMORY_SCOPE_AGENT); }
__device__ __forceinline__ unsigned xb_xcc_id() { return (unsigned)__builtin_amdgcn_s_getreg((3 << 11) | 20) & 0xFu; }
#define XB_SPIN(cond, bar) do { unsigned _sp = 0; while (cond) { __builtin_amdgcn_s_sleep(1); \
    if ((++_sp & 255u) == 0u) { if (xb_ld(&(bar)[XB_TMO])) break; if (_sp > XB_SPIN_CAP) { atomicAdd(&(bar)[XB_TMO], 1u); break; } } } } while (0)

struct XcdBarrier {
    unsigned* bar; unsigned x;
    volatile LAS unsigned* st;
};

__device__ __forceinline__ XcdBarrier xcd_barrier_post(unsigned* bar, volatile LAS unsigned* st) {
    XcdBarrier b; b.bar = bar; b.x = xb_xcc_id(); b.st = st;
    if (threadIdx.x == 0) (void)xb_add(&bar[XB_XCNT(b.x)], 1u);
    return b;
}
__device__ __forceinline__ void xcd_barrier_complete(unsigned* bar, unsigned x, unsigned& nloc, unsigned& nx) {
    const unsigned G = gridDim.x * gridDim.y * gridDim.z;
    unsigned sum, cnt, mine, sp = 0u;
    for (;;) {
        sum = 0u; cnt = 0u; mine = 0u;
#pragma unroll
        for (unsigned j = 0; j < 16; ++j) { const unsigned c = xb_ld(&bar[XB_XCNT(j)]); sum += c; cnt += (c > 0u) ? 1u : 0u; mine = (j == x) ? c : mine; }
        if (sum == G) break;
        __builtin_amdgcn_s_sleep(1);
        if ((++sp & 255u) == 0u) { if (xb_ld(&bar[XB_TMO])) break; if (sp > XB_SPIN_CAP) { atomicAdd(&bar[XB_TMO], 1u); break; } }
    }
    nloc = mine > 0u ? mine : 1u; nx = cnt > 0u ? cnt : 1u;
}

__device__ __forceinline__ void xcd_barrier(const XcdBarrier& b) {
    asm volatile("s_waitcnt vmcnt(0)" ::: "memory");
    __syncthreads();
    if (threadIdx.x == 0) {
        unsigned* bar = b.bar;
        __builtin_amdgcn_s_waitcnt(0);
        unsigned nloc = b.st[0], nx = b.st[1];
        if (nloc == 0u) { xcd_barrier_complete(bar, b.x, nloc, nx); b.st[0] = nloc; b.st[1] = nx; }
        const unsigned old = xb_add(&bar[XB_XSUB(b.x)], 1u);
        const unsigned gen = old / nloc;
        if (old + 1u == (gen + 1u) * nloc) {
            __builtin_amdgcn_fence(__ATOMIC_RELEASE, "agent");
            asm volatile("s_waitcnt vmcnt(0)" ::: "memory");
            const unsigned og = xb_add(&bar[XB_TOP], 1u);
            const unsigned tg = og / nx;
            if (og + 1u == (tg + 1u) * nx) xb_add(&bar[XB_TOPGEN], 1u);
            else XB_SPIN(xb_ld(&bar[XB_TOPGEN]) == tg, bar);
            __builtin_amdgcn_fence(__ATOMIC_ACQUIRE, "agent");
            xb_add(&bar[XB_XGEN(b.x)], 1u);
            asm volatile("s_waitcnt vmcnt(0)" ::: "memory");
        } else {
            XB_SPIN(xb_ld(&bar[XB_XGEN(b.x)]) == gen, bar);
            __builtin_amdgcn_fence(__ATOMIC_ACQUIRE, "agent");
            asm volatile("s_waitcnt vmcnt(0)" ::: "memory");
        }
    }
    __syncthreads();
}

constexpr int NWAVES = 8;
constexpr int BATCH = 8, SEQ = 2048, D = 1024, NMETA = 16, NH = 8, HD = 128;
constexpr int MR = BATCH * SEQ;
constexpr int LX = 2112, NX = BATCH * LX;
constexpr int NCH = 33, NCHUNKS = BATCH * NH * NCH;
constexpr int PROJ = 7184;
constexpr int NEXP = 32, FF = 512;
constexpr int MAXT = 160;
constexpr float EPS = 1e-6f;

constexpr size_t MiB = 1u << 20;
constexpr size_t WS_CTL = 0, CTL_ZERO_BYTES = 64 * 1024;
constexpr size_t WS_GB     = 1 * MiB;
constexpr size_t WS_UMETA  = WS_GB + 1152 * 1024;
constexpr size_t WS_HALO   = WS_UMETA + 64 * 1024;
constexpr size_t WS_CD     = 7 * MiB;
constexpr size_t WS_CNT    = 7 * MiB + 64 * 1024;
constexpr size_t WS_TILEE  = WS_CNT + 64 * 1024;
constexpr size_t WS_TOK    = WS_TILEE + 4096;
constexpr size_t WS_ROWIDX = 8 * MiB;
constexpr size_t WS_ROWS   = WS_ROWIDX + 256 * 1024;
constexpr size_t WS_ROWW   = WS_ROWS + 256 * 1024;
constexpr size_t WS_TOKPOS = WS_ROWW + 256 * 1024;
constexpr size_t WS_BTIN   = 10 * MiB;
constexpr size_t WS_BTOUT  = 24 * MiB;
constexpr size_t WS_U      = 26 * MiB;
constexpr size_t WS_O      = 58 * MiB;
constexpr size_t WS_QKV    = 90 * MiB;
constexpr size_t WS_CLX    = 189 * MiB;
constexpr size_t WS_PM     = 90 * MiB;
constexpr size_t WS_ZS     = 123 * MiB;
constexpr size_t WS_GP     = 155 * MiB;
constexpr size_t WS_GD     = 187 * MiB;
constexpr size_t WS_MERGED = 219 * MiB;
constexpr size_t WS_H1     = 90 * MiB;
constexpr size_t WS_XN     = 10 * MiB;
constexpr size_t WS_HDN    = 42 * MiB;
constexpr size_t WS_BTGU   = 154 * MiB;
constexpr size_t WS_BTDN   = 250 * MiB;
constexpr size_t WS_Y      = 154 * MiB;
constexpr size_t WS_END    = 289 * MiB;

constexpr int LDS_BYTES = 163840;
constexpr int MISC_OFF = 163840 - 256;

struct Frame {
    LAS unsigned char* lds;
    volatile LAS unsigned* MISC;
    int tid, lane, wave;
    int vcu, G;
    unsigned char* ws;
    const float *x, *meta, *norm_mix_w, *w_in, *conv_w, *pool_w, *pool_scale, *a_log, *dt_bias, *dn_norm_w, *w_out, *norm_ffn_w,
                *rg_w, *rg_b, *re_w, *re_b, *w_gate, *w_up, *w_down, *norm_final_w;
    float* out;
};
__device__ __forceinline__ int xrow_of(int r) { return (r >> 11) * LX + 64 + (r & 2047); }

__device__ __forceinline__ void transpose_item(const float* W, int ldw, int c0, bf16* WT, int ldk, int r0, int k0, LAS float* scr, int lane) {
#pragma unroll 8
    for (int i = 0; i < 32; ++i) { const int kk = 2 * i + (lane >> 5); scr[kk * 33 + (lane & 31)] = W[(size_t)(k0 + kk) * ldw + c0 + (lane & 31)]; }
    LDS_WAIT(); asm volatile("" ::: "memory");
    const int c = lane & 7;
#pragma unroll
    for (int j = 0; j < 4; ++j) { const int n = (lane >> 3) + 8 * j; const LAS float* s = scr + (8 * c) * 33 + n;
        v4u o; o.x = pk2(s[0 * 33], s[1 * 33]); o.y = pk2(s[2 * 33], s[3 * 33]); o.z = pk2(s[4 * 33], s[5 * 33]); o.w = pk2(s[6 * 33], s[7 * 33]);
        *(GAS v4u*)(WT + (size_t)(r0 + n) * ldk + k0 + 8 * c) = o; }
    LDS_WAIT(); asm volatile("" ::: "memory");
}
__device__ __forceinline__ void transpose_item_gu(const float* Wg, const float* Wu, bf16* WT, int r0, int k0, LAS float* scr, int lane) {
    const int d = lane & 31, cdst = r0 + d, f = (cdst >> 3) * 4 + (cdst & 3); const float* src = ((cdst >> 2) & 1) ? Wu : Wg;
#pragma unroll 8
    for (int i = 0; i < 32; ++i) { const int kk = 2 * i + (lane >> 5); scr[kk * 33 + d] = src[(size_t)(k0 + kk) * FF + f]; }
    LDS_WAIT(); asm volatile("" ::: "memory");
    const int c = lane & 7;
#pragma unroll
    for (int j = 0; j < 4; ++j) { const int n = (lane >> 3) + 8 * j; const LAS float* s = scr + (8 * c) * 33 + n;
        v4u o; o.x = pk2(s[0 * 33], s[1 * 33]); o.y = pk2(s[2 * 33], s[3 * 33]); o.z = pk2(s[4 * 33], s[5 * 33]); o.w = pk2(s[6 * 33], s[7 * 33]);
        *(GAS v4u*)(WT + (size_t)(r0 + n) * D + k0 + 8 * c) = o; }
    LDS_WAIT(); asm volatile("" ::: "memory");
}

__device__ __forceinline__ void p0_prologue(Frame& F) {
    const int gw = F.vcu * NWAVES + F.wave, NGW = F.G * NWAVES, lane = F.lane;
    LAS float* WabT = (LAS float*)F.lds;
    for (int k = F.tid; k < D; k += NWAVES * 64) {
        const f32x4* src = (const f32x4*)(F.w_in + (size_t)k * PROJ + 5120);
#pragma unroll
        for (int q = 0; q < 4; ++q) { const f32x4 v = src[q]; WabT[(4 * q + 0) * D + k] = v.x; WabT[(4 * q + 1) * D + k] = v.y; WabT[(4 * q + 2) * D + k] = v.z; WabT[(4 * q + 3) * D + k] = v.w; }
    }
    __syncthreads();
    bf16* U = (bf16*)(F.ws + WS_U); bf16* UM = (bf16*)(F.ws + WS_UMETA); float* GB = (float*)(F.ws + WS_GB);
    f32x4 nw[4];
#pragma unroll
    for (int j = 0; j < 4; ++j) nw[j] = ((const f32x4*)F.norm_mix_w)[64 * j + lane];
    for (int r = gw; r < MR + NMETA; r += NGW) {
        const bool ismeta = r >= MR; const int mj = r - MR;
        const f32x4* xr = (const f32x4*)(ismeta ? F.meta + (size_t)mj * D : F.x + (size_t)r * D) + lane;
        f32x4 v[4]; float s = 0.f;
#pragma unroll
        for (int j = 0; j < 4; ++j) { v[j] = xr[64 * j]; s += (v[j].x * v[j].x + v[j].y * v[j].y) + (v[j].z * v[j].z + v[j].w * v[j].w); }
        const float rstd = 1.f / sqrtf(wave_sum(s) * (1.f / D) + EPS);
#pragma unroll
        for (int j = 0; j < 4; ++j) v[j] = v[j] * rstd * nw[j];
        unsigned long long* o8 = (unsigned long long*)(ismeta ? UM + (size_t)mj * D : U + (size_t)r * D) + lane;
#pragma unroll
        for (int j = 0; j < 4; ++j) o8[64 * j] = (unsigned long long)pk2(v[j].x, v[j].y) | ((unsigned long long)pk2(v[j].z, v[j].w) << 32);
        float mine = 0.f;
#pragma unroll 2
        for (int o = 0; o < 16; ++o) {
            float p = 0.f;
#pragma unroll
            for (int j = 0; j < 4; ++j) { const f32x4 w = *(const LAS f32x4*)(WabT + o * D + 256 * j + 4 * lane); p += (v[j].x * w.x + v[j].y * w.y) + (v[j].z * w.z + v[j].w * w.w); }
            p = wave_sum(p);
            mine = (lane == o) ? p : mine;
        }
        if (lane < 16) {
            float val;
            if (lane < 8) { const float xx = mine + F.dt_bias[lane]; const float sp = xx > 20.f ? xx : log1pf(__expf(xx)); val = -__expf(F.a_log[lane]) * sp; }
            else val = 1.f / (1.f + __expf(-mine));
            if (!ismeta) GB[(size_t)xrow_of(r) * 16 + lane] = val;
            else {
#pragma unroll
                for (int b = 0; b < BATCH; ++b) GB[(size_t)(b * LX + 48 + mj) * 16 + lane] = val; }
        }
    }
    __syncthreads();
    bf16* BTIN = (bf16*)(F.ws + WS_BTIN); bf16* BTOUT = (bf16*)(F.ws + WS_BTOUT);
    LAS float* scr = (LAS float*)(F.lds + 65536 + F.wave * 8448);
    constexpr int NB_TOT = 96 + 32 + 32 + 32 + 32;
    for (int it = gw; it < NB_TOT * 16; it += NGW) {
        const int kb = it & 15; int nb = it >> 4;
        if (nb < 96) { transpose_item(F.w_in, PROJ, 1024 + 32 * nb, BTIN, D, 32 * nb, 64 * kb, scr, lane); continue; } nb -= 96;
        if (nb < 32) { transpose_item(F.w_in, PROJ, 4096 + 32 * nb, BTIN, D, 4096 + 32 * nb, 64 * kb, scr, lane); continue; } nb -= 32;
        if (nb < 32) { transpose_item(F.w_in, PROJ, 5136 + 32 * nb, BTIN, D, 5120 + 32 * nb, 64 * kb, scr, lane); continue; } nb -= 32;
        if (nb < 32) { transpose_item(F.w_in, PROJ, 6160 + 32 * nb, BTIN, D, 6144 + 32 * nb, 64 * kb, scr, lane); continue; } nb -= 32;
        transpose_item(F.w_out, D, 32 * nb, BTOUT, D, 32 * nb, 64 * kb, scr, lane);
    }
    for (int tile = gw; tile < 4 * 64 * 16; tile += NGW) {
        const int g = tile >> 10, kt = (tile >> 4) & 63, ntl = tile & 15;
        const int m = lane & 15, q = lane >> 4;
        const float* arow = F.w_in + (size_t)(16 * kt + m) * PROJ + 256 * g + 8 * q;
        const float* bcol = F.pool_w + (size_t)g * 65536 + (size_t)(8 * q) * 256 + 16 * ntl + m;
        f32x4 acc = {0.f, 0.f, 0.f, 0.f};
#pragma unroll 2
        for (int s = 0; s < 8; ++s) {
            const f32x4 a0 = *(const f32x4*)(arow + 32 * s), a1 = *(const f32x4*)(arow + 32 * s + 4);
            float bv[8];
#pragma unroll
            for (int j = 0; j < 8; ++j) bv[j] = bcol[(size_t)(32 * s + j) * 256];
            v4u ap, bp; ap.x = pk2(a0.x, a0.y); ap.y = pk2(a0.z, a0.w); ap.z = pk2(a1.x, a1.y); ap.w = pk2(a1.z, a1.w);
            bp.x = pk2(bv[0], bv[1]); bp.y = pk2(bv[2], bv[3]); bp.z = pk2(bv[4], bv[5]); bp.w = pk2(bv[6], bv[7]);
            acc = MFMA16(__builtin_bit_cast(bf16x8, ap), __builtin_bit_cast(bf16x8, bp), acc);
        }
        v2u o; o.x = pk2(acc[0], acc[1]); o.y = pk2(acc[2], acc[3]);
        *(GAS v2u*)(BTIN + (size_t)(3072 + 256 * g + 16 * ntl + m) * D + 16 * kt + 4 * q) = o;
    }
}

typedef pg8::f32x4 (&AccRef)[2][2][4][2];
struct EpiQKV {
    static constexpr bool PERM = true;
    bf16* QKV; bf16* HALO;
    __device__ __forceinline__ void operator()(const pg8::f32x4 (&acc)[2][2][4][2], const pg8::Unit& u, int wr, int wc, int fr, int fq) const {
        const int col0 = u.pn * 256 + wc * 32 + 8 * fq;
#pragma unroll
        for (int ai = 0; ai < 2; ++ai)
#pragma unroll
            for (int m = 0; m < 4; ++m) {
                const int r = u.pm * 256 + ai * 128 + wr * 64 + m * 16 + fr; const int b = r >> 11, xin = 64 + (r & 2047);
                bf16* rowp = QKV + (size_t)(b * LX + xin) * 3072 + col0;
                const bool halo = (m == 3) && (fr >= 13) && ((xin >> 6) + 1 <= 32);
                bf16* hp = HALO + ((size_t)((b * NCH + (xin >> 6) + 1) * 3 + (fr - 13))) * 3072 + col0;
#pragma unroll
                for (int bj = 0; bj < 2; ++bj) { const pg8::f32x4 v0 = acc[ai][bj][m][0], v1 = acc[ai][bj][m][1];
                    v4u w; w.x = pk2(v0[0], v0[1]); w.y = pk2(v0[2], v0[3]); w.z = pk2(v1[0], v1[1]); w.w = pk2(v1[2], v1[3]);
                    *(v4u*)(rowp + bj * 128) = w; if (halo) *(v4u*)(hp + bj * 128) = w; } }
    }
};
struct EpiPZG {
    static constexpr bool PERM = true;
    bf16 *PM, *ZS, *GP, *GD;
    __device__ __forceinline__ void operator()(const pg8::f32x4 (&acc)[2][2][4][2], const pg8::Unit& u, int wr, int wc, int fr, int fq) const {
        const int kind = u.pn >> 2, col0 = (u.pn & 3) * 256 + wc * 32 + 8 * fq;
        bf16* base = kind == 0 ? PM : (kind == 1 ? ZS : (kind == 2 ? GP : GD));
#pragma unroll
        for (int ai = 0; ai < 2; ++ai)
#pragma unroll
            for (int m = 0; m < 4; ++m) {
                const int r = u.pm * 256 + ai * 128 + wr * 64 + m * 16 + fr; const int orow = kind == 0 ? xrow_of(r) : r;
                bf16* rowp = base + (size_t)orow * D + col0;
#pragma unroll
                for (int bj = 0; bj < 2; ++bj) { pg8::f32x4 v0 = acc[ai][bj][m][0], v1 = acc[ai][bj][m][1];
                    if (kind == 1) {
#pragma unroll
                        for (int e = 0; e < 4; ++e) { v0[e] = siluf_(v0[e]); v1[e] = siluf_(v1[e]); } }
                    else if (kind >= 2) {
#pragma unroll
                        for (int e = 0; e < 4; ++e) { v0[e] = sigmoidf_(v0[e]); v1[e] = sigmoidf_(v1[e]); } }
                    v4u w; w.x = pk2(v0[0], v0[1]); w.y = pk2(v0[2], v0[3]); w.z = pk2(v1[0], v1[1]); w.w = pk2(v1[2], v1[3]);
                    *(v4u*)(rowp + bj * 128) = w; } }
    }
};
struct EpiOut {
    static constexpr bool PERM = false;
    const float* X; float* H1;
    __device__ __forceinline__ void operator()(const pg8::f32x4 (&acc)[2][2][4][2], const pg8::Unit& u, int wr, int wc, int fr, int fq) const {
        const int row0 = u.pm * 256 + wr * 64 + fr, col0 = u.pn * 256 + wc * 32 + 4 * fq;
#pragma unroll
        for (int ai = 0; ai < 2; ++ai)
#pragma unroll
            for (int m = 0; m < 4; ++m) { const size_t off = (size_t)(row0 + ai * 128 + m * 16) * D + col0;
#pragma unroll
                for (int bj = 0; bj < 2; ++bj)
#pragma unroll
                    for (int n = 0; n < 2; ++n) { const pg8::f32x4 xv = *(const pg8::f32x4*)(X + off + bj * 128 + n * 16); *(pg8::f32x4*)(H1 + off + bj * 128 + n * 16) = acc[ai][bj][m][n] + xv; } }
    }
};
struct EpiGU {
    static constexpr bool PERM = true;
    bf16* HDN; const float* ROWS;
    __device__ __forceinline__ void operator()(const pg8::f32x4 (&acc)[2][2][4][2], const pg8::Unit& u, int wr, int wc, int fr, int fq) const {
        const int f0 = (u.pn & 3) * 128 + wc * 16 + 4 * fq;
#pragma unroll
        for (int ai = 0; ai < 2; ++ai)
#pragma unroll
            for (int m = 0; m < 4; ++m) { const int pos = u.pm * 256 + ai * 128 + wr * 64 + m * 16 + fr; const float rs = ROWS[pos];
#pragma unroll
                for (int bj = 0; bj < 2; ++bj) { const pg8::f32x4 gt = acc[ai][bj][m][0] * rs, up = acc[ai][bj][m][1] * rs;
                    v2u w; w.x = pk2(siluf_(gt[0]) * up[0], siluf_(gt[1]) * up[1]); w.y = pk2(siluf_(gt[2]) * up[2], siluf_(gt[3]) * up[3]);
                    *(v2u*)(HDN + (size_t)pos * FF + f0 + bj * 64) = w; } }
    }
};
struct EpiDown {
    static constexpr bool PERM = true;
    bf16* Y; const float* ROWW;
    __device__ __forceinline__ void operator()(const pg8::f32x4 (&acc)[2][2][4][2], const pg8::Unit& u, int wr, int wc, int fr, int fq) const {
        const int col0 = (u.pn & 3) * 256 + wc * 32 + 8 * fq;
#pragma unroll
        for (int ai = 0; ai < 2; ++ai)
#pragma unroll
            for (int m = 0; m < 4; ++m) { const int pos = u.pm * 256 + ai * 128 + wr * 64 + m * 16 + fr; const float cw = ROWW[pos];
#pragma unroll
                for (int bj = 0; bj < 2; ++bj) { const pg8::f32x4 v0 = acc[ai][bj][m][0] * cw, v1 = acc[ai][bj][m][1] * cw;
                    v4u w; w.x = pk2(v0[0], v0[1]); w.y = pk2(v0[2], v0[3]); w.z = pk2(v1[0], v1[1]); w.w = pk2(v1[2], v1[3]);
                    *(v4u*)(Y + (size_t)pos * D + col0 + bj * 128) = w; } }
    }
};
struct MoeOrder {
    int ntiles, G, c; const int* tile_e; const LAS int* idx;
    __device__ __forceinline__ bool next(int i, pg8::Unit& u) const {
        const int L = i * G + c; if (L >= 4 * ntiles) return false;
        u.pm = L >> 2; u.pn = tile_e[L >> 2] * 4 + (L & 3); return true;
    }
    __device__ __forceinline__ int gather_row(const pg8::Unit& u, int r) const { const int i = (u.pm * 4 + (u.pn & 3) - c) / G; return idx[i * 256 + r]; }
};

__device__ __forceinline__ void meta_rows_job(Frame& F, const bf16* BT, int ncols, bf16* OUTX, int ld, bf16* HALO) {
    const bf16* UM = (const bf16*)(F.ws + WS_UMETA);
    const int lane = F.lane, m = lane & 15, q = lane >> 4;
    for (int tile = F.vcu * NWAVES + F.wave; tile < ncols / 16; tile += F.G * NWAVES) {
        const bf16* ap = UM + (size_t)m * D + 8 * q; const bf16* bp = BT + (size_t)(16 * tile + m) * D + 8 * q;
        f32x4 acc = {0.f, 0.f, 0.f, 0.f};
#pragma unroll 4
        for (int s = 0; s < 32; ++s) acc = MFMA16(*(const bf16x8*)(ap + 32 * s), *(const bf16x8*)(bp + 32 * s), acc);
#pragma unroll
        for (int i = 0; i < 4; ++i) { const int j = 4 * q + i; const bf16 v = f2bf(acc[i]);
#pragma unroll
            for (int b = 0; b < BATCH; ++b) { OUTX[(size_t)(b * LX + 48 + j) * ld + 16 * tile + m] = v;
                if (HALO && j >= 13) HALO[((size_t)((b * NCH + 1) * 3 + (j - 13))) * 3072 + 16 * tile + m] = v; } }
    }
}

constexpr int P2_KN = 0, P2_QN = 17408, P2_KBT = 34816, P2_VBT = 53248, P2_KDT = 71680, P2_QDI = 90112, P2_AM = 107520, P2_TM = 124928, P2_QKM = 134144, P2_SC = 143360;
constexpr int RS = 272, TS = 144;
__device__ __forceinline__ size_t inplace_off(int xr0, int mat, int h, int f, int lane) {
    return ((size_t)(xr0 + 4 * f + (lane >> 4)) * 3072 + mat * 1024 + h * 128) * 2 + (lane & 15) * 16;
}
__device__ __forceinline__ void p2_chunk_local(Frame& F) {
    LAS unsigned char* L = F.lds; const int wave = F.wave;
    LAS float* SC = (LAS float*)(L + P2_SC);
    unsigned char* QKV = F.ws + WS_QKV; const bf16* HALO = (const bf16*)(F.ws + WS_HALO); const float* GB = (const float*)(F.ws + WS_GB);
    unsigned char* CLX = F.ws + WS_CLX; float* CD = (float*)(F.ws + WS_CD);
    for (int cid = F.vcu; cid < NCHUNKS; cid += F.G) {
        const int c = cid % NCH, bh = cid / NCH, h = bh & 7, b = bh >> 3, xr0 = b * LX + 64 * c;
        int tid = F.tid; asm volatile("" : "+v"(tid)); const int lane = tid & 63;
        if (wave == 0) {
            const bool nul = (c == 0) && (lane < 48);
            float g = nul ? 0.f : GB[(size_t)(xr0 + lane) * 16 + h], be = nul ? 0.f : GB[(size_t)(xr0 + lane) * 16 + 8 + h];
            float gam = g;
#pragma unroll
            for (int o = 1; o < 64; o <<= 1) { const float t = __shfl_up(gam, o); if (lane >= o) gam += t; }
            const float gl = __shfl(gam, 63);
            SC[lane] = gam; SC[64 + lane] = be; const float eg = __expf(gam); SC[128 + lane] = eg; SC[192 + lane] = __expf(gl - gam); SC[256 + lane] = be * eg;
            if (lane == 0) CD[cid] = __expf(gl);
        }
        float val[8][8];
        const int grp = tid >> 4, mat = grp >> 3, rg = grp & 7, cg = lane & 15;
        if (tid < 384) {
            const int ch0 = mat * 1024 + h * 128 + 8 * cg;
            v4u raww[11];
#pragma unroll
            for (int i = 0; i < 11; ++i) {
                const int li = 8 * rg - 3 + i;
                v4u w = {0u, 0u, 0u, 0u};
                if (li < 0) { if (c > 0) w = *(const v4u*)(HALO + ((size_t)((b * NCH + c) * 3 + (li + 3))) * 3072 + ch0); }
                else if (!(c == 0 && li < 48)) w = *(const v4u*)(QKV + ((size_t)(xr0 + li) * 3072 + ch0) * 2);
                raww[i] = w;
            }
#define RAWV(i, e) (((e) & 1) ? bfhi(raww[i][(e) >> 1]) : bflo(raww[i][(e) >> 1]))
            float cw[4][8];
#pragma unroll
            for (int kk = 0; kk < 4; ++kk) { const f32x4 a = *(const f32x4*)(F.conv_w + (size_t)kk * 3072 + ch0), bq = *(const f32x4*)(F.conv_w + (size_t)kk * 3072 + ch0 + 4);
                cw[kk][0] = a.x; cw[kk][1] = a.y; cw[kk][2] = a.z; cw[kk][3] = a.w; cw[kk][4] = bq.x; cw[kk][5] = bq.y; cw[kk][6] = bq.z; cw[kk][7] = bq.w; }
#pragma unroll
            for (int i = 0; i < 8; ++i) {
                float ss = 0.f;
#pragma unroll
                for (int e = 0; e < 8; ++e) { const float cv = cw[0][e] * RAWV(i, e) + cw[1][e] * RAWV(i + 1, e) + cw[2][e] * RAWV(i + 2, e) + cw[3][e] * RAWV(i + 3, e);
                    const float sv = siluf_(cv); val[i][e] = sv; ss += sv * sv; }
                if (mat < 2) { ss += __shfl_xor(ss, 1); ss += __shfl_xor(ss, 2); ss += __shfl_xor(ss, 4); ss += __shfl_xor(ss, 8);
                    const float inv = (1.f / sqrtf(ss + EPS)) * (mat == 0 ? 0.08838834764831845f : 1.f);
#pragma unroll
                    for (int e = 0; e < 8; ++e) val[i][e] *= inv; }
            }
        }
        __syncthreads();
        if (tid < 384) {
            if (mat == 0) {
#pragma unroll
                for (int i = 0; i < 8; ++i) { const int t = 8 * rg + i; const float eg = SC[128 + t];
                    v4u w; w.x = pk2(val[i][0], val[i][1]); w.y = pk2(val[i][2], val[i][3]); w.z = pk2(val[i][4], val[i][5]); w.w = pk2(val[i][6], val[i][7]);
                    *(LAS v4u*)(L + P2_QN + t * RS + cg * 16) = w;
                    w.x = pk2(val[i][0] * eg, val[i][1] * eg); w.y = pk2(val[i][2] * eg, val[i][3] * eg); w.z = pk2(val[i][4] * eg, val[i][5] * eg); w.w = pk2(val[i][6] * eg, val[i][7] * eg);
                    *(LAS v4u*)(L + P2_QDI + t * RS + cg * 16) = w; }
            } else if (mat == 1) {
                float beg[8], egl[8];
#pragma unroll
                for (int i = 0; i < 8; ++i) { beg[i] = SC[256 + 8 * rg + i]; egl[i] = SC[192 + 8 * rg + i]; }
#pragma unroll
                for (int i = 0; i < 8; ++i) { const int t = 8 * rg + i;
                    v4u w; w.x = pk2(val[i][0], val[i][1]); w.y = pk2(val[i][2], val[i][3]); w.z = pk2(val[i][4], val[i][5]); w.w = pk2(val[i][6], val[i][7]);
                    *(LAS v4u*)(L + P2_KN + t * RS + cg * 16) = w; }
#pragma unroll
                for (int e = 0; e < 8; ++e) { const int k = 8 * cg + e;
                    v4u w; w.x = pk2(val[0][e] * beg[0], val[1][e] * beg[1]); w.y = pk2(val[2][e] * beg[2], val[3][e] * beg[3]); w.z = pk2(val[4][e] * beg[4], val[5][e] * beg[5]); w.w = pk2(val[6][e] * beg[6], val[7][e] * beg[7]);
                    *(LAS v4u*)(L + P2_KBT + k * TS + rg * 16) = w;
                    w.x = pk2(val[0][e] * egl[0], val[1][e] * egl[1]); w.y = pk2(val[2][e] * egl[2], val[3][e] * egl[3]); w.z = pk2(val[4][e] * egl[4], val[5][e] * egl[5]); w.w = pk2(val[6][e] * egl[6], val[7][e] * egl[7]);
                    *(LAS v4u*)(L + P2_KDT + k * TS + rg * 16) = w; }
            } else {
                float be[8];
#pragma unroll
                for (int i = 0; i < 8; ++i) be[i] = SC[64 + 8 * rg + i];
#pragma unroll
                for (int e = 0; e < 8; ++e) { const int k = 8 * cg + e;
                    v4u w; w.x = pk2(val[0][e] * be[0], val[1][e] * be[1]); w.y = pk2(val[2][e] * be[2], val[3][e] * be[3]); w.z = pk2(val[4][e] * be[4], val[5][e] * be[5]); w.w = pk2(val[6][e] * be[6], val[7][e] * be[7]);
                    *(LAS v4u*)(L + P2_VBT + k * TS + rg * 16) = w; }
            }
        }
        __syncthreads();
        {
            const int mq = wave >> 2, tm = (wave >> 1) & 1, tn = wave & 1, r = lane & 31, hh = lane >> 5;
            f32x16 acc; for (int i = 0; i < 16; ++i) acc[i] = 0.f;
            if (tm >= tn) {
                LAS unsigned char* ab = L + (mq ? P2_QN : P2_KN) + (32 * tm + r) * RS + hh * 16; LAS unsigned char* bb = L + P2_KN + (32 * tn + r) * RS + hh * 16;
#pragma unroll
                for (int s = 0; s < 8; ++s) acc = MFMA32(*(const LAS bf16x8*)(ab + 32 * s), *(const LAS bf16x8*)(bb + 32 * s), acc);
            }
            const int tc = 32 * tn + r; const float gc = SC[tc];
#pragma unroll
            for (int i = 0; i < 16; ++i) { const int t = 32 * tm + crow(i, hh); const float dec = __expf(SC[t] - gc);
                if (mq == 0) *(LAS float*)(L + P2_AM + t * RS + tc * 4) = (t > tc) ? SC[64 + t] * acc[i] * dec : 0.f;
                else *(LAS bf16*)(L + P2_QKM + t * TS + tc * 2) = f2bf((t >= tc) ? acc[i] * dec : 0.f); }
        }
        __syncthreads();
        if (wave == 0) {
            float T[64];
#pragma unroll
            for (int i = 0; i < 64; ++i) T[i] = 0.f;
#pragma unroll
            for (int i = 1; i < 64; ++i) {
                float a0 = -*(const LAS float*)(L + P2_AM + i * RS + lane * 4), a1 = 0.f, a2 = 0.f, a3 = 0.f;
#pragma unroll
                for (int j = 0; j < i; j += 4) { const f32x4 av = *(const LAS f32x4*)(L + P2_AM + i * RS + j * 4);
                    a0 -= av.x * T[j]; a1 -= av.y * T[j + 1]; a2 -= av.z * T[j + 2]; a3 -= av.w * T[j + 3]; }
                T[i] = (a0 + a1) + (a2 + a3);
            }
#pragma unroll
            for (int i = 0; i < 64; ++i) *(LAS bf16*)(L + P2_TM + i * TS + lane * 2) = f2bf(T[i]);
            LDS_WAIT(); asm volatile("" ::: "memory");
            *(LAS bf16*)(L + P2_TM + lane * TS + lane * 2) = (bf16)0x3F80;
        } else {
            const int r = lane & 31, hh = lane >> 5;
            for (int f = wave - 1; f < 40; f += 7) {
                LAS unsigned char* src; unsigned char* dst;
                if (f < 16)      { src = L + P2_QDI + (32 * (f >> 3) + r) * RS + (16 * (f & 7) + 4 * hh) * 2; dst = QKV + inplace_off(xr0, 0, h, f, lane); }
                else if (f < 32) { const int g = f - 16; src = L + P2_KDT + (32 * (g >> 2) + r) * TS + (16 * (g & 3) + 4 * hh) * 2; dst = QKV + inplace_off(xr0, 1, h, g, lane); }
                else             { const int g = f - 32; src = L + P2_QKM + (32 * (g >> 2) + r) * TS + (16 * (g & 3) + 4 * hh) * 2; dst = CLX + (size_t)cid * 24576 + 16384 + g * 1024 + lane * 16; }
                const v2u lo = *(const LAS v2u*)src, hi = *(const LAS v2u*)(src + 16);
                v4u w; w.x = lo.x; w.y = lo.y; w.z = hi.x; w.w = hi.y;
                *(v4u*)dst = w;
            }
        }
        __syncthreads();
        f32x16 accW, accU;
        {
            const int tm = wave >> 2, tn = wave & 3, r = lane & 31, hh = lane >> 5;
            for (int i = 0; i < 16; ++i) { accW[i] = 0.f; accU[i] = 0.f; }
            LAS unsigned char* ab = L + P2_TM + (32 * tm + r) * TS + hh * 16; LAS unsigned char* bk = L + P2_KBT + (32 * tn + r) * TS + hh * 16; LAS unsigned char* bv = L + P2_VBT + (32 * tn + r) * TS + hh * 16;
#pragma unroll
            for (int s = 0; s < 4; ++s) { const bf16x8 a = *(const LAS bf16x8*)(ab + 32 * s);
                accW = MFMA32(a, *(const LAS bf16x8*)(bk + 32 * s), accW); accU = MFMA32(a, *(const LAS bf16x8*)(bv + 32 * s), accU); }
        }
        __syncthreads();
        {
            const int tm = wave >> 2, tn = wave & 3, r = lane & 31, hh = lane >> 5;
#pragma unroll
            for (int i = 0; i < 16; ++i) { const int t = 32 * tm + crow(i, hh), n = 32 * tn + r;
                *(LAS bf16*)(L + P2_KBT + t * RS + n * 2) = f2bf(-accW[i]); *(LAS bf16*)(L + P2_VBT + t * RS + n * 2) = f2bf(accU[i]); }
        }
        __syncthreads();
        {
            const int r = lane & 31, hh = lane >> 5;
            for (int f = wave; f < 32; f += 8) {
                if (f < 16) {
                    LAS unsigned char* src = L + P2_KBT + (32 * (f >> 3) + r) * RS + (16 * (f & 7) + 4 * hh) * 2;
                    const v2u lo = *(const LAS v2u*)src, hi = *(const LAS v2u*)(src + 16);
                    v4u w; w.x = lo.x; w.y = lo.y; w.z = hi.x; w.w = hi.y;
                    *(v4u*)(CLX + (size_t)cid * 24576 + f * 1024 + lane * 16) = w;
                } else {
                    const int g = f - 16, s = g >> 2, mt = (g >> 1) & 1, p = g & 1;
                    unsigned short v[8];
#pragma unroll
                    for (int e = 0; e < 8; ++e) { const int t = 32 * mt + crow(8 * p + e, hh); v[e] = *(const LAS bf16*)(L + P2_VBT + t * RS + (32 * s + r) * 2); }
                    v4u w; w.x = v[0] | ((unsigned)v[1] << 16); w.y = v[2] | ((unsigned)v[3] << 16); w.z = v[4] | ((unsigned)v[5] << 16); w.w = v[6] | ((unsigned)v[7] << 16);
                    *(v4u*)(QKV + inplace_off(xr0, 2, h, g, lane)) = w;
                }
            }
        }
        __syncthreads();
    }
}

constexpr int SC_BUF = 61440;
__device__ __forceinline__ void scan_issue(Frame& F, int b, int h, int s, int c, LAS unsigned char* buf) {
    const int lane = F.lane, cid = (b * NH + h) * NCH + c, xr0 = b * LX + 64 * c;
    const unsigned char* QKV = F.ws + WS_QKV; const unsigned char* clx = F.ws + WS_CLX + (size_t)cid * 24576 + lane * 16;
#pragma unroll
    for (int f = 0; f < 16; ++f) __builtin_amdgcn_global_load_lds((const unsigned*)(clx + f * 1024), (LAS unsigned*)(buf + f * 1024), 16, 0, 0);
#pragma unroll
    for (int f = 0; f < 16; ++f) __builtin_amdgcn_global_load_lds((const unsigned*)(QKV + inplace_off(xr0, 0, h, f, lane)), (LAS unsigned*)(buf + 16384 + f * 1024), 16, 0, 0);
#pragma unroll
    for (int f = 0; f < 16; ++f) __builtin_amdgcn_global_load_lds((const unsigned*)(QKV + inplace_off(xr0, 1, h, f, lane)), (LAS unsigned*)(buf + 32768 + f * 1024), 16, 0, 0);
#pragma unroll
    for (int f = 0; f < 8; ++f) __builtin_amdgcn_global_load_lds((const unsigned*)(clx + 16384 + f * 1024), (LAS unsigned*)(buf + 49152 + f * 1024), 16, 0, 0);
#pragma unroll
    for (int f = 0; f < 4; ++f) __builtin_amdgcn_global_load_lds((const unsigned*)(QKV + inplace_off(xr0, 2, h, 4 * s + f, lane)), (LAS unsigned*)(buf + 57344 + f * 1024), 16, 0, 0);
}
__device__ __forceinline__ void p3_scan(Frame& F) {
    if (F.wave != 0) return;
    const int lane = F.lane, r = lane & 31, hh = lane >> 5;
    const float* CD = (const float*)(F.ws + WS_CD); bf16* O = (bf16*)(F.ws + WS_O);
    for (int task = F.vcu; task < BATCH * NH * 4; task += F.G) {
        const int s = task & 3, bh = task >> 2, h = bh & 7, b = bh >> 3;
        f32x16 S[4];
#pragma unroll
        for (int kt = 0; kt < 4; ++kt) for (int i = 0; i < 16; ++i) S[kt][i] = 0.f;
        scan_issue(F, b, h, s, 0, F.lds);
        for (int c = 0; c < NCH; ++c) {
            LAS unsigned char* buf = F.lds + (c & 1) * SC_BUF;
            VM_WAIT();
            if (c + 1 < NCH) scan_issue(F, b, h, s, c + 1, F.lds + ((c + 1) & 1) * SC_BUF);
            const float cd = CD[(b * NH + h) * NCH + c];
            const LAS unsigned char* fb = buf + lane * 16;
            bf16x8 Sb[4][2];
#pragma unroll
            for (int kt = 0; kt < 4; ++kt) { Sb[kt][0] = pack_step(S[kt], 0); Sb[kt][1] = pack_step(S[kt], 1); }
            f32x16 aV[2], aO[2];
#pragma unroll
            for (int mt = 0; mt < 2; ++mt) {
                const v4u u0 = *(const LAS v4u*)(fb + 57344 + (2 * mt) * 1024), u1 = *(const LAS v4u*)(fb + 57344 + (2 * mt + 1) * 1024);
                aV[mt][0] = bflo(u0.x); aV[mt][1] = bfhi(u0.x); aV[mt][2] = bflo(u0.y); aV[mt][3] = bfhi(u0.y); aV[mt][4] = bflo(u0.z); aV[mt][5] = bfhi(u0.z); aV[mt][6] = bflo(u0.w); aV[mt][7] = bfhi(u0.w);
                aV[mt][8] = bflo(u1.x); aV[mt][9] = bfhi(u1.x); aV[mt][10] = bflo(u1.y); aV[mt][11] = bfhi(u1.y); aV[mt][12] = bflo(u1.z); aV[mt][13] = bfhi(u1.z); aV[mt][14] = bflo(u1.w); aV[mt][15] = bfhi(u1.w);
                for (int i = 0; i < 16; ++i) aO[mt][i] = 0.f;
            }
#pragma unroll
            for (int ks = 0; ks < 8; ++ks)
#pragma unroll
                for (int mt = 0; mt < 2; ++mt) {
                    aV[mt] = MFMA32(*(const LAS bf16x8*)(fb + (mt * 8 + ks) * 1024), Sb[ks >> 1][ks & 1], aV[mt]);
                    aO[mt] = MFMA32(*(const LAS bf16x8*)(fb + 16384 + (mt * 8 + ks) * 1024), Sb[ks >> 1][ks & 1], aO[mt]);
                }
            bf16x8 Vb[2][2];
#pragma unroll
            for (int mt = 0; mt < 2; ++mt) { Vb[mt][0] = pack_step(aV[mt], 0); Vb[mt][1] = pack_step(aV[mt], 1); }
#pragma unroll
            for (int kt = 0; kt < 4; ++kt) S[kt] = S[kt] * cd;
#pragma unroll
            for (int ts = 0; ts < 4; ++ts) {
#pragma unroll
                for (int kt = 0; kt < 4; ++kt) S[kt] = MFMA32(*(const LAS bf16x8*)(fb + 32768 + (kt * 4 + ts) * 1024), Vb[ts >> 1][ts & 1], S[kt]);
#pragma unroll
                for (int mt = 0; mt < 2; ++mt) aO[mt] = MFMA32(*(const LAS bf16x8*)(fb + 49152 + (mt * 4 + ts) * 1024), Vb[ts >> 1][ts & 1], aO[mt]);
            }
            if (c > 0) {
                bf16* orow = O + (size_t)(b * SEQ + 64 * (c - 1)) * D + h * HD + 32 * s + r;
#pragma unroll
                for (int mt = 0; mt < 2; ++mt)
#pragma unroll
                    for (int i = 0; i < 16; ++i) orow[(size_t)(32 * mt + crow(i, hh)) * D] = f2bf(aO[mt][i]);
            }
            LDS_WAIT();
        }
        VM_WAIT();
    }
}

__device__ __forceinline__ void load16(const bf16* p, float (&v)[16]) {
    const v4u a = *(const v4u*)p, b = *(const v4u*)(p + 8);
    v[0] = bflo(a.x); v[1] = bfhi(a.x); v[2] = bflo(a.y); v[3] = bfhi(a.y); v[4] = bflo(a.z); v[5] = bfhi(a.z); v[6] = bflo(a.w); v[7] = bfhi(a.w);
    v[8] = bflo(b.x); v[9] = bfhi(b.x); v[10] = bflo(b.y); v[11] = bfhi(b.y); v[12] = bflo(b.z); v[13] = bfhi(b.z); v[14] = bflo(b.w); v[15] = bfhi(b.w);
}
__device__ __forceinline__ void p5_merge(Frame& F) {
    const int gw = F.vcu * NWAVES + F.wave, NGW = F.G * NWAVES, lane = F.lane;
    const bf16* O = (const bf16*)(F.ws + WS_O); const bf16* PM = (const bf16*)(F.ws + WS_PM); const bf16* ZS = (const bf16*)(F.ws + WS_ZS);
    const bf16* GP = (const bf16*)(F.ws + WS_GP); const bf16* GD = (const bf16*)(F.ws + WS_GD); bf16* MG = (bf16*)(F.ws + WS_MERGED);
    const int n0 = 16 * lane, win = 2 << (lane >> 4); const float rwin = 1.f / (float)win;
    float psc[16], dnw[16];
#pragma unroll
    for (int e = 0; e < 16; ++e) { psc[e] = F.pool_scale[n0 + e]; dnw[e] = F.dn_norm_w[(n0 + e) & 127]; }
    for (int r0 = gw * 8; r0 < MR; r0 += NGW * 8) {
        for (int rr = 0; rr < 8; ++rr) {
            const int r = r0 + rr, xr = xrow_of(r);
            float o[16], z[16], gp[16], gd[16], pm[16], sum[16];
            load16(O + (size_t)r * D + n0, o); load16(ZS + (size_t)r * D + n0, z); load16(GP + (size_t)r * D + n0, gp); load16(GD + (size_t)r * D + n0, gd);
            load16(PM + (size_t)xr * D + n0, pm);
#pragma unroll
            for (int e = 0; e < 16; ++e) sum[e] = pm[e];
            for (int j = 1; j < win; ++j) { float t[16]; load16(PM + (size_t)(xr - j) * D + n0, t);
#pragma unroll
                for (int e = 0; e < 16; ++e) sum[e] += t[e]; }
            float ss = 0.f;
#pragma unroll
            for (int e = 0; e < 16; ++e) ss += o[e] * o[e];
            ss += __shfl_xor(ss, 1); ss += __shfl_xor(ss, 2); ss += __shfl_xor(ss, 4);
            const float rstd = 1.f / sqrtf(ss * (1.f / HD) + EPS);
            float m[16];
#pragma unroll
            for (int e = 0; e < 16; ++e) m[e] = gp[e] * psc[e] * (sum[e] * rwin - pm[e]) + gd[e] * (o[e] * rstd * dnw[e]) * z[e];
            v4u w0, w1; w0.x = pk2(m[0], m[1]); w0.y = pk2(m[2], m[3]); w0.z = pk2(m[4], m[5]); w0.w = pk2(m[6], m[7]);
            w1.x = pk2(m[8], m[9]); w1.y = pk2(m[10], m[11]); w1.z = pk2(m[12], m[13]); w1.w = pk2(m[14], m[15]);
            *(v4u*)(MG + (size_t)r * D + n0) = w0; *(v4u*)(MG + (size_t)r * D + n0 + 8) = w1;
        }
    }
}

struct TokRec { int e0, e1, s0, s1; float w0, w1, rstd, pad; };
constexpr int P7_WS = 1032, P7_WH = 0, P7_WL = 74304, P7_LG = 148608, P7_CNT = 148608 + 4 * 2560;
__device__ __forceinline__ void p7_router(Frame& F) {
    LAS unsigned char* L = F.lds; const int tid = F.tid, lane = F.lane, wave = F.wave;
    for (int idx = tid; idx < 36 * D; idx += NWAVES * 64) {
        const int k = idx / 36, o = idx - k * 36;
        const float w = (o < 4 ? F.rg_w[k * 4 + o] : F.re_w[k * 32 + (o - 4)]) * F.norm_ffn_w[k];
        const unsigned short hi = f2bf(w); const unsigned short lo = f2bf(w - bf2f(hi));
        *(LAS bf16*)(L + P7_WH + (o * P7_WS + k) * 2) = hi; *(LAS bf16*)(L + P7_WL + (o * P7_WS + k) * 2) = lo;
    }
    LAS int* lcnt = (LAS int*)(L + P7_CNT);
    if (tid < 32) lcnt[tid] = 0;
    __syncthreads();
    const float* H1 = (const float*)(F.ws + WS_H1); bf16* XN = (bf16*)(F.ws + WS_XN); TokRec* TOK = (TokRec*)(F.ws + WS_TOK);
    if (wave < 4) {
        const int m = lane & 15, q = lane >> 4, row = 64 * F.vcu + 16 * wave + m;
        const float* hp = H1 + (size_t)row * D + 8 * q; const float* nwp = F.norm_ffn_w + 8 * q;
        f32x4 acc[3] = {{0.f, 0.f, 0.f, 0.f}, {0.f, 0.f, 0.f, 0.f}, {0.f, 0.f, 0.f, 0.f}};
        float ss = 0.f;
        const int orow[3] = {m, 16 + m, (32 + m) < 36 ? 32 + m : 35};
        for (int s = 0; s < 32; ++s) {
            const f32x4 a0 = *(const f32x4*)(hp + 32 * s), a1 = *(const f32x4*)(hp + 32 * s + 4);
            const f32x4 n0 = *(const f32x4*)(nwp + 32 * s), n1 = *(const f32x4*)(nwp + 32 * s + 4);
            const float x[8] = {a0.x, a0.y, a0.z, a0.w, a1.x, a1.y, a1.z, a1.w};
            v4u xh, xl; unsigned hh[4], ll[4];
#pragma unroll
            for (int j = 0; j < 4; ++j) { const unsigned ph = pk2(x[2 * j], x[2 * j + 1]); hh[j] = ph; ll[j] = pk2(x[2 * j] - bflo(ph), x[2 * j + 1] - bfhi(ph)); ss += x[2 * j] * x[2 * j] + x[2 * j + 1] * x[2 * j + 1]; }
            xh.x = hh[0]; xh.y = hh[1]; xh.z = hh[2]; xh.w = hh[3]; xl.x = ll[0]; xl.y = ll[1]; xl.z = ll[2]; xl.w = ll[3];
            v4u xo; xo.x = pk2(a0.x * n0.x, a0.y * n0.y); xo.y = pk2(a0.z * n0.z, a0.w * n0.w); xo.z = pk2(a1.x * n1.x, a1.y * n1.y); xo.w = pk2(a1.z * n1.z, a1.w * n1.w);
            *(v4u*)(XN + (size_t)row * D + 32 * s + 8 * q) = xo;
#pragma unroll
            for (int t = 0; t < 3; ++t) {
                const bf16x8 wh = *(const LAS bf16x8*)(L + P7_WH + (orow[t] * P7_WS + 32 * s + 8 * q) * 2), wl = *(const LAS bf16x8*)(L + P7_WL + (orow[t] * P7_WS + 32 * s + 8 * q) * 2);
                acc[t] = MFMA16(__builtin_bit_cast(bf16x8, xh), wh, acc[t]); acc[t] = MFMA16(__builtin_bit_cast(bf16x8, xl), wh, acc[t]); acc[t] = MFMA16(__builtin_bit_cast(bf16x8, xh), wl, acc[t]);
            }
        }
        ss += __shfl_xor(ss, 16); ss += __shfl_xor(ss, 32);
        LAS float* lg = (LAS float*)(L + P7_LG + wave * 2560);
#pragma unroll
        for (int t = 0; t < 3; ++t)
#pragma unroll
            for (int i = 0; i < 4; ++i) if (16 * t + m < 36) lg[(4 * q + i) * 40 + 16 * t + m] = acc[t][i];
        LDS_WAIT(); asm volatile("" ::: "memory");
        if (lane < 16) {
            const float rstd = 1.f / sqrtf(ss * (1.f / D) + EPS);
            float gl[4];
#pragma unroll
            for (int o = 0; o < 4; ++o) gl[o] = lg[lane * 40 + o] * rstd + F.rg_b[o];
            int gi = 0; float gm = gl[0];
#pragma unroll
            for (int o = 1; o < 4; ++o) if (gl[o] > gm) { gm = gl[o]; gi = o; }
            float den = 0.f;
#pragma unroll
            for (int o = 0; o < 4; ++o) den += __expf(gl[o] - gm);
            const float pg = 1.f / den;
            float el[8];
#pragma unroll
            for (int e = 0; e < 8; ++e) el[e] = lg[lane * 40 + 4 + 8 * gi + e] * rstd + F.re_b[8 * gi + e];
            int i0 = 0; float m0 = el[0];
#pragma unroll
            for (int e = 1; e < 8; ++e) if (el[e] > m0) { m0 = el[e]; i0 = e; }
            int i1 = -1; float m1 = -3.0e38f;
#pragma unroll
            for (int e = 0; e < 8; ++e) if (e != i0 && el[e] > m1) { m1 = el[e]; i1 = e; }
            const float w0 = 1.f / (1.f + __expf(m1 - m0)), w1 = 1.f - w0;
            const int e0 = gi * 8 + i0, e1 = gi * 8 + i1;
            TokRec t; t.e0 = e0; t.e1 = e1; t.s0 = __hip_atomic_fetch_add(&lcnt[e0], 1, __ATOMIC_RELAXED, __HIP_MEMORY_SCOPE_WORKGROUP); t.s1 = __hip_atomic_fetch_add(&lcnt[e1], 1, __ATOMIC_RELAXED, __HIP_MEMORY_SCOPE_WORKGROUP); t.w0 = pg * w0; t.w1 = pg * w1; t.rstd = rstd; t.pad = 0.f;
            TOK[64 * F.vcu + 16 * wave + lane] = t;
        }
    }
    __syncthreads();
    if (tid < 32) ((int*)(F.ws + WS_CNT))[F.vcu * 32 + tid] = lcnt[tid];
    __syncthreads();
    const int gw = F.vcu * NWAVES + wave, NGW = F.G * NWAVES;
    LAS float* scr = (LAS float*)(L + wave * 8448);
    bf16* BTGU = (bf16*)(F.ws + WS_BTGU); bf16* BTDN = (bf16*)(F.ws + WS_BTDN);
    for (int it = gw; it < NEXP * 512 + NEXP * 256; it += NGW) {
        if (it < NEXP * 512) { const int e = it >> 9, nb = (it >> 4) & 31, kb = it & 15;
            transpose_item_gu(F.w_gate + (size_t)e * D * FF, F.w_up + (size_t)e * D * FF, BTGU + (size_t)e * 1024 * D, 32 * nb, 64 * kb, scr, lane); }
        else { const int jt = it - NEXP * 512, e = jt >> 8, nb = (jt >> 3) & 31, kb = jt & 7;
            transpose_item(F.w_down + (size_t)e * FF * D, D, 32 * nb, BTDN + (size_t)e * 1024 * FF, FF, 32 * nb, 64 * kb, scr, lane); }
    }
}

__device__ __forceinline__ void p8_index(Frame& F) {
    LAS int* tot = (LAS int*)F.lds; LAS int* mine = tot + 32; LAS int* base = tot + 64; LAS int* part = tot + 128;
    const int tid = F.tid; const int* CNT = (const int*)(F.ws + WS_CNT);
    { const int e = tid & 31, seg = tid >> 5;
        int st = 0, sm = 0;
        for (int w = seg * 16; w < seg * 16 + 16; ++w) { const int v = CNT[w * 32 + e]; st += v; if (w < F.vcu) sm += v; }
        part[seg * 32 + e] = st; part[512 + seg * 32 + e] = sm; }
    __syncthreads();
    if (tid < 32) { int st = 0, sm = 0; for (int s = 0; s < 16; ++s) { st += part[s * 32 + tid]; sm += part[512 + s * 32 + tid]; } tot[tid] = st; mine[tid] = sm; }
    __syncthreads();
    if (tid == 0) { int acc = 0; for (int e = 0; e < 32; ++e) { base[e] = acc; acc += ((tot[e] + 255) >> 8) << 8; } base[32] = acc; }
    __syncthreads();
    int* ROWIDX = (int*)(F.ws + WS_ROWIDX); float* ROWS = (float*)(F.ws + WS_ROWS); float* ROWW = (float*)(F.ws + WS_ROWW); int* TOKPOS = (int*)(F.ws + WS_TOKPOS);
    const TokRec* TOK = (const TokRec*)(F.ws + WS_TOK);
    if (tid < 128) { const int tk = 64 * F.vcu + (tid >> 1), sl = tid & 1; const TokRec t = TOK[tk];
        const int e = sl ? t.e1 : t.e0, s = sl ? t.s1 : t.s0; const int pos = base[e] + mine[e] + s;
        ROWIDX[pos] = tk; ROWS[pos] = t.rstd; ROWW[pos] = sl ? t.w1 : t.w0; TOKPOS[tk * 2 + sl] = pos; }
    if (F.vcu < 32) { const int e = F.vcu, lo = base[e] + tot[e], hi = base[e + 1];
        for (int p = lo + tid; p < hi; p += NWAVES * 64) { ROWIDX[p] = 0; ROWS[p] = 0.f; ROWW[p] = 0.f; } }
    if (F.vcu == 0 && tid < MAXT + 1) { int* TILEE = (int*)(F.ws + WS_TILEE);
        const int nt = base[32] >> 8;
        if (tid == MAXT) TILEE[MAXT] = nt;
        else { int e = 0; for (int q = 1; q < 32; ++q) if ((base[q] >> 8) <= tid) e = q; TILEE[tid] = (tid < nt) ? e : 0; } }
}

__device__ __forceinline__ void p11_final(Frame& F) {
    const int gw = F.vcu * NWAVES + F.wave, NGW = F.G * NWAVES, lane = F.lane;
    const float* H1 = (const float*)(F.ws + WS_H1); const bf16* Y = (const bf16*)(F.ws + WS_Y); const int* TOKPOS = (const int*)(F.ws + WS_TOKPOS);
    f32x4 nw[4];
#pragma unroll
    for (int j = 0; j < 4; ++j) nw[j] = ((const f32x4*)F.norm_final_w)[64 * j + lane];
    for (int r = gw; r < MR; r += NGW) {
        const int p0 = TOKPOS[r * 2], p1 = TOKPOS[r * 2 + 1];
        const f32x4* hr = (const f32x4*)(H1 + (size_t)r * D) + lane;
        const v2u* y0 = (const v2u*)(Y + (size_t)p0 * D) + lane; const v2u* y1 = (const v2u*)(Y + (size_t)p1 * D) + lane;
        f32x4 v[4]; float s = 0.f;
#pragma unroll
        for (int j = 0; j < 4; ++j) { v[j] = hr[64 * j]; const v2u a = y0[64 * j], b = y1[64 * j];
            v[j].x += bflo(a.x) + bflo(b.x); v[j].y += bfhi(a.x) + bfhi(b.x); v[j].z += bflo(a.y) + bflo(b.y); v[j].w += bfhi(a.y) + bfhi(b.y);
            s += (v[j].x * v[j].x + v[j].y * v[j].y) + (v[j].z * v[j].z + v[j].w * v[j].w); }
        const float rstd = 1.f / sqrtf(wave_sum(s) * (1.f / D) + EPS);
        f32x4* orow = (f32x4*)(F.out + (size_t)r * D) + lane;
#pragma unroll
        for (int j = 0; j < 4; ++j) orow[64 * j] = v[j] * rstd * nw[j];
    }
}

constexpr int NPHASES = 12;
#ifndef MK_ONE_LAUNCH
#define MK_ONE_LAUNCH 1
#endif
struct Args { const float* in[20]; float* out; unsigned char* ws; int ph_lo, ph_hi; };
__global__ void __launch_bounds__(NWAVES * 64, 2) hybrid_fwd(Args args) {
    extern __shared__ __attribute__((aligned(16))) unsigned char lds[];
    Frame F;
    F.lds = (LAS unsigned char*)lds;
    F.MISC = (volatile LAS unsigned*)(F.lds + MISC_OFF);
    F.tid = threadIdx.x; F.lane = F.tid & 63; F.wave = __builtin_amdgcn_readfirstlane(F.tid >> 6);
    F.G = gridDim.x; { const int bx = blockIdx.x; F.vcu = (F.G % 8 == 0) ? (bx % 8) * (F.G / 8) + bx / 8 : bx; }
    F.ws = args.ws; F.out = args.out;
    F.x = args.in[0]; F.meta = args.in[1]; F.norm_mix_w = args.in[2]; F.w_in = args.in[3]; F.conv_w = args.in[4]; F.pool_w = args.in[5]; F.pool_scale = args.in[6];
    F.a_log = args.in[7]; F.dt_bias = args.in[8]; F.dn_norm_w = args.in[9]; F.w_out = args.in[10]; F.norm_ffn_w = args.in[11]; F.rg_w = args.in[12]; F.rg_b = args.in[13];
    F.re_w = args.in[14]; F.re_b = args.in[15]; F.w_gate = args.in[16]; F.w_up = args.in[17]; F.w_down = args.in[18]; F.norm_final_w = args.in[19];
    if (F.tid < 64) F.MISC[F.tid] = 0u;
    __syncthreads();
    const int lo = args.ph_lo, hi = args.ph_hi;
    XcdBarrier bar; bar.bar = (unsigned*)(F.ws + WS_CTL); bar.x = 0; bar.st = nullptr;
    if (hi - lo > 1) bar = xcd_barrier_post((unsigned*)(F.ws + WS_CTL), F.MISC + 8);
#ifndef PHMASK
#define PHMASK 0xFFF
#endif
#define IN(k) ((((PHMASK) >> (k)) & 1) && lo <= (k) && (k) < hi)
#define SEAM(k) do { if (IN(k) && IN((k) + 1)) xcd_barrier(bar); } while (0)

    if (IN(0)) { p0_prologue(F); } SEAM(0);

    if (IN(1)) {
        pg8::Gemm g{(const bf16*)(F.ws + WS_U), (const bf16*)(F.ws + WS_BTIN), MR, 3072, D}; pg8::StaticOrder S; S.init(MR, 3072, F.G, (int)blockIdx.x);
        EpiQKV E{(bf16*)(F.ws + WS_QKV), (bf16*)(F.ws + WS_HALO)};
        pg8::gemm_phase<EpiQKV, pg8::StaticOrder, true, false>(F.lds, g, S, E);
        meta_rows_job(F, (const bf16*)(F.ws + WS_BTIN), 3072, (bf16*)(F.ws + WS_QKV), 3072, (bf16*)(F.ws + WS_HALO));
    } SEAM(1);

    if (IN(2)) { p2_chunk_local(F); } SEAM(2);

    if (IN(3)) { p3_scan(F); } SEAM(3);

    if (IN(4)) {
        pg8::Gemm g{(const bf16*)(F.ws + WS_U), (const bf16*)(F.ws + WS_BTIN) + (size_t)3072 * D, MR, 4096, D}; pg8::StaticOrder S; S.init(MR, 4096, F.G, (int)blockIdx.x);
        EpiPZG E{(bf16*)(F.ws + WS_PM), (bf16*)(F.ws + WS_ZS), (bf16*)(F.ws + WS_GP), (bf16*)(F.ws + WS_GD)};
        pg8::gemm_phase<EpiPZG, pg8::StaticOrder, true, false>(F.lds, g, S, E);
        meta_rows_job(F, (const bf16*)(F.ws + WS_BTIN) + (size_t)3072 * D, 1024, (bf16*)(F.ws + WS_PM), 1024, nullptr);
    } SEAM(4);

    if (IN(5)) { p5_merge(F); } SEAM(5);

    if (IN(6)) {
        pg8::Gemm g{(const bf16*)(F.ws + WS_MERGED), (const bf16*)(F.ws + WS_BTOUT), MR, D, D}; pg8::StaticOrder S; S.init(MR, D, F.G, (int)blockIdx.x);
        EpiOut E{F.x, (float*)(F.ws + WS_H1)};
        pg8::gemm_phase<EpiOut, pg8::StaticOrder, false, false>(F.lds, g, S, E);
    } SEAM(6);

    if (IN(7)) { p7_router(F); } SEAM(7);

    if (IN(8)) { p8_index(F); } SEAM(8);

    if (IN(9) || IN(10)) {
        const int* TILEE = (const int*)(F.ws + WS_TILEE); const int ntiles = TILEE[MAXT];
        LAS int* idx = (LAS int*)(F.lds + 131072);
        if (IN(9)) {
            const int* ROWIDX = (const int*)(F.ws + WS_ROWIDX);
            for (int i = 0; i < 3; ++i) { const int Lu = i * F.G + F.vcu; if (Lu < 4 * ntiles) for (int t = F.tid; t < 256; t += NWAVES * 64) idx[i * 256 + t] = ROWIDX[(Lu >> 2) * 256 + t]; }
            __syncthreads();
            pg8::Gemm g{(const bf16*)(F.ws + WS_XN), (const bf16*)(F.ws + WS_BTGU), 0, 0, D};
            MoeOrder S{ntiles, F.G, F.vcu, TILEE, idx};
            EpiGU E{(bf16*)(F.ws + WS_HDN), (const float*)(F.ws + WS_ROWS)};
            pg8::gemm_phase<EpiGU, MoeOrder, true, true>(F.lds, g, S, E);
        }
        SEAM(9);
        if (IN(10)) {
            pg8::Gemm g{(const bf16*)(F.ws + WS_HDN), (const bf16*)(F.ws + WS_BTDN), 0, 0, FF};
            MoeOrder S{ntiles, F.G, F.vcu, TILEE, idx};
            EpiDown E{(bf16*)(F.ws + WS_Y), (const float*)(F.ws + WS_ROWW)};
            pg8::gemm_phase<EpiDown, MoeOrder, true, false>(F.lds, g, S, E);
        }
    }
    SEAM(10);

    if (IN(11)) { p11_final(F); }
#undef IN
#undef SEAM
}

extern "C" void kernel_launch(void* const* d_in, const int* in_sizes, int n_in, void* d_out, int out_size, void* d_ws, size_t ws_size, hipStream_t stream) {
    static int ready = 0;
    if (ready == 0) {
        if (n_in != 20 || in_sizes[0] != MR * D || out_size != MR * D || ws_size < WS_END) {
            fprintf(stderr, "kernel_launch: unexpected problem (n_in %d, in0 %d, out %d, ws %zu)\n", n_in, n_in > 0 ? in_sizes[0] : -1, out_size, ws_size); ready = -1; return; }
        if (hipFuncSetAttribute((const void*)hybrid_fwd, hipFuncAttributeMaxDynamicSharedMemorySize, LDS_BYTES) != hipSuccess) { fprintf(stderr, "kernel_launch: hipFuncSetAttribute failed\n"); ready = -1; return; }
        int per_cu = 0;
        if (hipOccupancyMaxActiveBlocksPerMultiprocessor(&per_cu, (const void*)hybrid_fwd, NWAVES * 64, LDS_BYTES) != hipSuccess || per_cu < 1)
            fprintf(stderr, "kernel_launch: note: occupancy query reports %d workgroups per CU\n", per_cu);
        (void)hipGetLastError();
        ready = 1;
    }
    if (ready < 0) return;
    (void)hipMemsetAsync((char*)d_ws + WS_CTL, 0, CTL_ZERO_BYTES, stream);
    Args a{};
    for (int i = 0; i < 20; ++i) a.in[i] = (const float*)d_in[i];
    a.out = (float*)d_out; a.ws = (unsigned char*)d_ws;
#if MK_ONE_LAUNCH
    a.ph_lo = 0; a.ph_hi = NPHASES;
    hipLaunchKernelGGL(hybrid_fwd, dim3(256), dim3(NWAVES * 64), LDS_BYTES, stream, a);
#else
    for (int p = 0; p < NPHASES; ++p) { a.ph_lo = p; a.ph_hi = p + 1; hipLaunchKernelGGL(hybrid_fwd, dim3(256), dim3(NWAVES * 64), LDS_BYTES, stream, a); }
#endif
}
```

```cpp
#include <hip/hip_runtime.h>
#include <cstdio>
#include <cstdint>

namespace pg8 {
#define PG8_LAS __attribute__((address_space(3)))
typedef unsigned short bf16_t;
typedef short bf16x8 __attribute__((ext_vector_type(8)));
typedef float f32x4 __attribute__((ext_vector_type(4)));
typedef unsigned u32x4 __attribute__((ext_vector_type(4)));
typedef unsigned u32x2 __attribute__((ext_vector_type(2)));
constexpr int BM = 256, BK = 64, HALF = 128, HTB = HALF * BK * 2  , STAGE_BYTES = 8 * HTB, NXCD = 8, WGM = 8;

__host__ __device__ __forceinline__ int lds_byte(int r, int c) { const int st = (r >> 4) * 2 + (c >> 5), rr = r & 15, cc = c & 31, ob = rr * 64 + cc * 2; return st * 1024 + (ob ^ (((ob >> 9) & 1) << 5)); }
__host__ __device__ __forceinline__ void stage_rc(int b, int& R, int& C) { const int st = b / 1024, sb = b % 1024, swz = sb ^ (((sb >> 9) & 1) << 5); R = (st >> 1) * 16 + swz / 64; C = (st & 1) * 32 + (swz % 64) / 2; }
__host__ __device__ __forceinline__ int perm32(int rho) { const int n = rho >> 4, i = rho & 15; return 8 * (i >> 2) + 4 * n + (i & 3); }

struct Unit { int pm, pn; };
struct Gemm { const bf16_t* A; const bf16_t* Bt; int M, N, K; };

struct StaticOrder {
    int nM, nN, nwg, G, c;
    __host__ __device__ void init(int M, int N, int G_, int c_) { nM = M / BM; nN = N / BM; nwg = nM * nN; G = G_; c = c_; }
    __host__ __device__ bool next(int i, Unit& u) const {
        const long L = (long)i * G + c; if (L >= nwg) return false;
        int wgid = (int)L; { const int q = nwg / NXCD, r = nwg % NXCD, xcd = wgid % NXCD, off = wgid / NXCD; wgid = (xcd < r ? xcd * (q + 1) : r * (q + 1) + (xcd - r) * q) + off; }
        const int nig = WGM * nN, gid = wgid / nig, fm = gid * WGM, gsz = (nM - fm) < WGM ? (nM - fm) : WGM;
        u.pm = fm + ((wgid % nig) % gsz); u.pn = (wgid % nig) / gsz; return true;
    }
    __device__ __forceinline__ int gather_row(const Unit&, int) const { return 0; }
};

template <class Epi, class Sched, bool ALIGN_EPI, bool GATHER>
__device__ __forceinline__ void gemm_phase(PG8_LAS unsigned char* lds, const Gemm g, const Sched& S, const Epi& E) {
    const int tid = threadIdx.x, wid = __builtin_amdgcn_readfirstlane(tid >> 6), lane = tid & 63, wr = wid >> 2, wc = wid & 3, fr = lane & 15, fq = lane >> 4;
    const int K = g.K, nt = K / BK;
    unsigned voffA[2], voffB[2]; int RA[2], CA[2];
#pragma unroll
    for (int i = 0; i < 2; ++i) { int R, C; stage_rc(tid * 16 + i * 8192, R, C); const int Rb = Epi::PERM ? ((R & ~31) + perm32(R & 31)) : R;
        RA[i] = R; CA[i] = C; voffA[i] = (unsigned)(R * K + C) * 2u; voffB[i] = (unsigned)(Rb * K + C) * 2u; }
    const size_t kstep = (size_t)(BK * 2);
    const size_t hstep = (size_t)HALF * K * 2;
    const size_t tstep = 2 * hstep;
    const unsigned ldsw = (unsigned)wid * 1024u;
    const int aoff = lds_byte(wr * 64 + fr, fq * 8), boff = lds_byte(wc * 32 + fr, fq * 8);
#define PG8_SA(b, h) (((b) * 2 + (h)) * HTB)
#define PG8_SB(b, h) ((4 + (b) * 2 + (h)) * HTB)
#define PG8_STAGE(bufoff, gbase, voff) do { _Pragma("unroll") for (int _i = 0; _i < 2; ++_i) \
        __builtin_amdgcn_global_load_lds((const unsigned*)((const char*)(gbase) + (voff)[_i]), (PG8_LAS unsigned*)(lds + (bufoff) + ldsw + _i * 8192), 16, 0, 0); } while (0)
#define PG8_STAGE_A(b, h, gbase, NEXT) do { if constexpr (GATHER) { unsigned _vo[2] = { (NEXT) ? nvo[h][0] : cvo[h][0], (NEXT) ? nvo[h][1] : cvo[h][1] }; PG8_STAGE(PG8_SA(b, h), (gbase), _vo); } \
        else { PG8_STAGE(PG8_SA(b, h), (gbase) + (h) * hstep, voffA); } } while (0)
#define PG8_LDA(dst, b, h) do { _Pragma("unroll") for (int m = 0; m < 4; ++m) _Pragma("unroll") for (int k = 0; k < 2; ++k) dst[m][k] = *(const PG8_LAS bf16x8*)(lds + PG8_SA(b, h) + aoff + m * 2048 + k * 1024); } while (0)
#define PG8_LDB(dst, b, h) do { _Pragma("unroll") for (int n = 0; n < 2; ++n) _Pragma("unroll") for (int k = 0; k < 2; ++k) dst[n][k] = *(const PG8_LAS bf16x8*)(lds + PG8_SB(b, h) + boff + n * 2048 + k * 1024); } while (0)
#define PG8_MMA(ai, bj, At, Bt) do { __builtin_amdgcn_s_setprio(1); _Pragma("unroll") for (int m = 0; m < 4; ++m) _Pragma("unroll") for (int n = 0; n < 2; ++n) _Pragma("unroll") for (int k = 0; k < 2; ++k) \
        acc[ai][bj][m][n] = __builtin_amdgcn_mfma_f32_16x16x32_bf16(Bt[n][k], At[m][k], acc[ai][bj][m][n], 0, 0, 0); __builtin_amdgcn_s_setprio(0); } while (0)
#define PG8_WAIT_V(n) asm volatile("s_waitcnt vmcnt(" #n ")" ::: "memory")
#define PG8_WAIT_L(n) asm volatile("s_waitcnt lgkmcnt(" #n ")" ::: "memory")
#define PG8_BAR __builtin_amdgcn_s_barrier()
#define PG8_SCHED __builtin_amdgcn_sched_barrier(0)
    Unit cur, nxt; int ui = 0;
    if (!S.next(0, cur)) return;
    f32x4 acc[2][2][4][2];
#pragma unroll
    for (int a = 0; a < 2; ++a)
#pragma unroll
        for (int b = 0; b < 2; ++b)
#pragma unroll
            for (int m = 0; m < 4; ++m)
#pragma unroll
                for (int n = 0; n < 2; ++n) acc[a][b][m][n] = (f32x4){0.f, 0.f, 0.f, 0.f};
    bf16x8 At[4][2], B0[2][2], B1[2][2];
    unsigned cvo[2][2] = {{0u, 0u}, {0u, 0u}}, nvo[2][2] = {{0u, 0u}, {0u, 0u}};
    if constexpr (GATHER) {
#pragma unroll
        for (int h = 0; h < 2; ++h)
#pragma unroll
            for (int i = 0; i < 2; ++i) cvo[h][i] = (unsigned)(S.gather_row(cur, h * HALF + RA[i]) * K + CA[i]) * 2u;
    }
    const char* cA = GATHER ? (const char*)g.A : (const char*)g.A + (size_t)cur.pm * tstep; const char* cB = (const char*)g.Bt + (size_t)cur.pn * tstep;
    PG8_STAGE(PG8_SB(0, 0), cB, voffB); PG8_STAGE(PG8_SB(0, 1), cB + hstep, voffB); PG8_STAGE_A(0, 0, cA, false); PG8_STAGE_A(0, 1, cA, false);
    if (wr == 1) PG8_BAR;
    PG8_WAIT_V(2); PG8_BAR;
    PG8_STAGE(PG8_SB(1, 0), cB + kstep, voffB); PG8_STAGE_A(1, 0, cA + kstep, false); PG8_STAGE(PG8_SB(1, 1), cB + hstep + kstep, voffB);
    PG8_WAIT_V(6); PG8_BAR;
    for (;;) {
        const bool has_next = S.next(ui + 1, nxt);
        const char* nA = GATHER ? (const char*)g.A : (has_next ? (const char*)g.A + (size_t)nxt.pm * tstep : cA);
        const char* nB = has_next ? (const char*)g.Bt + (size_t)nxt.pn * tstep : cB;
        for (int t = 0; t < nt; t += 2) {
            const bool last = (t == nt - 2);
            const char* a1 = cA + (size_t)(t + 1) * kstep;
            const char* a2 = last ? nA : cA + (size_t)(t + 2) * kstep; const char* b2 = last ? nB : cB + (size_t)(t + 2) * kstep;
            const char* a3 = a2 + kstep; const char* b3 = b2 + kstep;
            if constexpr (GATHER) { if (last) {
#pragma unroll
                for (int h = 0; h < 2; ++h)
#pragma unroll
                    for (int i = 0; i < 2; ++i) nvo[h][i] = has_next ? (unsigned)(S.gather_row(nxt, h * HALF + RA[i]) * K + CA[i]) * 2u : cvo[h][i];
            } }
            PG8_LDB(B0, 0, 0); PG8_LDB(B1, 0, 1); PG8_SCHED; PG8_LDA(At, 0, 0); PG8_STAGE_A(1, 1, a1, false);
            PG8_WAIT_V(8); PG8_WAIT_L(0); PG8_BAR; PG8_MMA(0, 0, At, B0); PG8_MMA(0, 1, At, B1); PG8_BAR; PG8_SCHED;
            PG8_LDA(At, 0, 1); PG8_STAGE(PG8_SB(0, 0), b2, voffB); PG8_STAGE(PG8_SB(0, 1), b2 + hstep, voffB); PG8_STAGE_A(0, 0, a2, last);
            PG8_WAIT_V(8); PG8_WAIT_L(0); PG8_BAR; PG8_MMA(1, 0, At, B0); PG8_MMA(1, 1, At, B1); PG8_BAR; PG8_SCHED;
            PG8_LDB(B0, 1, 0); PG8_LDB(B1, 1, 1); PG8_SCHED; PG8_LDA(At, 1, 0); PG8_STAGE_A(0, 1, a2, last);
            PG8_WAIT_V(8); PG8_WAIT_L(0); PG8_BAR; PG8_MMA(0, 0, At, B0); PG8_MMA(0, 1, At, B1); PG8_BAR; PG8_SCHED;
            PG8_LDA(At, 1, 1); PG8_STAGE(PG8_SB(1, 0), b3, voffB); PG8_STAGE(PG8_SB(1, 1), b3 + hstep, voffB); PG8_STAGE_A(1, 0, a3, last);
            PG8_WAIT_V(8); PG8_WAIT_L(0); PG8_BAR; PG8_MMA(1, 0, At, B0); PG8_MMA(1, 1, At, B1); PG8_BAR; PG8_SCHED;
        }
        if constexpr (ALIGN_EPI) { if (wr == 0) PG8_BAR; }
        E(acc, cur, wr, wc, fr, fq);
        if (!has_next) break;
#pragma unroll
        for (int a = 0; a < 2; ++a)
#pragma unroll
            for (int b = 0; b < 2; ++b)
#pragma unroll
                for (int m = 0; m < 4; ++m)
#pragma unroll
                    for (int n = 0; n < 2; ++n) acc[a][b][m][n] = (f32x4){0.f, 0.f, 0.f, 0.f};
        cur = nxt; cA = nA; cB = nB; ++ui;
        if constexpr (GATHER) {
#pragma unroll
            for (int h = 0; h < 2; ++h)
#pragma unroll
                for (int i = 0; i < 2; ++i) cvo[h][i] = nvo[h][i];
        }
        if constexpr (ALIGN_EPI) { if (wr == 1) PG8_BAR; }
    }
    PG8_WAIT_V(0);
    if constexpr (!ALIGN_EPI) { if (wr == 0) PG8_BAR; }
    PG8_BAR;
#undef PG8_SA
#undef PG8_SB
#undef PG8_STAGE
#undef PG8_STAGE_A
#undef PG8_LDA
#undef PG8_LDB
#undef PG8_MMA
#undef PG8_WAIT_V
#undef PG8_WAIT_L
#undef PG8_BAR
#undef PG8_SCHED
}
}

#define GAS __attribute__((address_space(1)))
#define LAS __attribute__((address_space(3)))
typedef unsigned short bf16;
typedef unsigned v4u __attribute__((ext_vector_type(4)));
typedef unsigned v2u __attribute__((ext_vector_type(2)));
typedef float f32x4 __attribute__((ext_vector_type(4)));
typedef float f32x16 __attribute__((ext_vector_type(16)));
typedef short bf16x8 __attribute__((ext_vector_type(8)));
typedef __bf16 bf16x2_t __attribute__((ext_vector_type(2)));
typedef float f32x2_t __attribute__((ext_vector_type(2)));
typedef GAS unsigned gu32;
#define RLX_AGENT __ATOMIC_RELAXED, __HIP_MEMORY_SCOPE_AGENT
#define LDS_WAIT() asm volatile("s_waitcnt lgkmcnt(0)" ::: "memory")
#define VM_WAIT() asm volatile("s_waitcnt vmcnt(0)" ::: "memory")
__device__ __forceinline__ unsigned pk2(float lo, float hi) { f32x2_t v = {lo, hi}; bf16x2_t r = __builtin_convertvector(v, bf16x2_t); return __builtin_bit_cast(unsigned, r); }
__device__ __forceinline__ unsigned short f2bf(float f) { return (unsigned short)(pk2(f, 0.f) & 0xffffu); }
__device__ __forceinline__ float bf2f(unsigned short b) { return __builtin_bit_cast(float, ((unsigned)b) << 16); }
__device__ __forceinline__ float bflo(unsigned w) { return __builtin_bit_cast(float, w << 16); }
__device__ __forceinline__ float bfhi(unsigned w) { return __builtin_bit_cast(float, w & 0xffff0000u); }
__device__ __forceinline__ float sigmoidf_(float x) { return 1.f / (1.f + __expf(-x)); }
__device__ __forceinline__ float siluf_(float x) { return x / (1.f + __expf(-x)); }
__device__ __forceinline__ float wave_sum(float v) {
#pragma unroll
    for (int o = 1; o < 64; o <<= 1) v += __shfl_xor(v, o);
    return v;
}
__device__ __forceinline__ int crow(int reg, int h) { return (reg & 3) + 8 * (reg >> 2) + 4 * h; }
#define MFMA32(a, b, c) __builtin_amdgcn_mfma_f32_32x32x16_bf16((a), (b), (c), 0, 0, 0)
#define MFMA16(a, b, c) __builtin_amdgcn_mfma_f32_16x16x32_bf16((a), (b), (c), 0, 0, 0)
__device__ __forceinline__ bf16x8 pack_step(const f32x16& x, int s) {
    v4u p; p.x = pk2(x[8 * s], x[8 * s + 1]); p.y = pk2(x[8 * s + 2], x[8 * s + 3]); p.z = pk2(x[8 * s + 4], x[8 * s + 5]); p.w = pk2(x[8 * s + 6], x[8 * s + 7]);
    return __builtin_bit_cast(bf16x8, p);
}

#define XB_TMO      128
#define XB_XCNT(j)  (256  + 64 * (j))
#define XB_XSUB(j)  (1280 + 64 * (j))
#define XB_XGEN(j)  (2304 + 64 * (j))
#define XB_TOP      3328
#define XB_TOPGEN   3392
#define XCD_BAR_WORDS 3456
#define XB_SPIN_CAP (1u << 18)

__device__ __forceinline__ unsigned xb_ld(unsigned* p)              { return __hip_atomic_load(p, __ATOMIC_RELAXED, __HIP_MEMORY_SCOPE_AGENT); }
__device__ __forceinline__ unsigned xb_add(unsigned* p, unsigned v) { return __hip_atomic_fetch_add(p, v, __ATOMIC_RELAXED, __HIP_MEMORY_SCOPE_AGENT); }
__device__ __forceinline__ unsigned xb_xcc_id() { return (unsigned)__builtin_amdgcn_s_getreg((3 << 11) | 20) & 0xFu; }
#define XB_SPIN(cond, bar) do { unsigned _sp = 0; while (cond) { __builtin_amdgcn_s_sleep(1); \
    if ((++_sp & 255u) == 0u) { if (xb_ld(&(bar)[XB_TMO])) break; if (_sp > XB_SPIN_CAP) { atomicAdd(&(bar)[XB_TMO], 1u); break; } } } } while (0)

struct XcdBarrier {
    unsigned* bar; unsigned x;
    volatile LAS unsigned* st;
};

__device__ __forceinline__ XcdBarrier xcd_barrier_post(unsigned* bar, volatile LAS unsigned* st) {
    XcdBarrier b; b.bar = bar; b.x = xb_xcc_id(); b.st = st;
    if (threadIdx.x == 0) (void)xb_add(&bar[XB_XCNT(b.x)], 1u);
    return b;
}
__device__ __forceinline__ void xcd_barrier_complete(unsigned* bar, unsigned x, unsigned& nloc, unsigned& nx) {
    const unsigned G = gridDim.x * gridDim.y * gridDim.z;
    unsigned sum, cnt, mine, sp = 0u;
    for (;;) {
        sum = 0u; cnt = 0u; mine = 0u;
#pragma unroll
        for (unsigned j = 0; j < 16; ++j) { const unsigned c = xb_ld(&bar[XB_XCNT(j)]); sum += c; cnt += (c > 0u) ? 1u : 0u; mine = (j == x) ? c : mine; }
        if (sum == G) break;
        __builtin_amdgcn_s_sleep(1);
        if ((++sp & 255u) == 0u) { if (xb_ld(&bar[XB_TMO])) break; if (sp > XB_SPIN_CAP) { atomicAdd(&bar[XB_TMO], 1u); break; } }
    }
    nloc = mine > 0u ? mine : 1u; nx = cnt > 0u ? cnt : 1u;
}

__device__ __forceinline__ void xcd_barrier(const XcdBarrier& b) {
    asm volatile("s_waitcnt vmcnt(0)" ::: "memory");
    __syncthreads();
    if (threadIdx.x == 0) {
        unsigned* bar = b.bar;
        __builtin_amdgcn_s_waitcnt(0);
        unsigned nloc = b.st[0], nx = b.st[1];
        if (nloc == 0u) { xcd_barrier_complete(bar, b.x, nloc, nx); b.st[0] = nloc; b.st[1] = nx; }
        const unsigned old = xb_add(&bar[XB_XSUB(b.x)], 1u);
        const unsigned gen = old / nloc;
        if (old + 1u == (gen + 1u) * nloc) {
            __builtin_amdgcn_fence(__ATOMIC_RELEASE, "agent");
            asm volatile("s_waitcnt vmcnt(0)" ::: "memory");
            const unsigned og = xb_add(&bar[XB_TOP], 1u);
            const unsigned tg = og / nx;
            if (og + 1u == (tg + 1u) * nx) xb_add(&bar[XB_TOPGEN], 1u);
            else XB_SPIN(xb_ld(&bar[XB_TOPGEN]) == tg, bar);
            __builtin_amdgcn_fence(__ATOMIC_ACQUIRE, "agent");
            xb_add(&bar[XB_XGEN(b.x)], 1u);
            asm volatile("s_waitcnt vmcnt(0)" ::: "memory");
        } else {
            XB_SPIN(xb_ld(&bar[XB_XGEN(b.x)]) == gen, bar);
            __builtin_amdgcn_fence(__ATOMIC_ACQUIRE, "agent");
            asm volatile("s_waitcnt vmcnt(0)" ::: "memory");
        }
    }
    __syncthreads();
}

constexpr int NWAVES = 8;
constexpr int BATCH = 8, SEQ = 2048, D = 1024, NMETA = 16, NH = 8, HD = 128;
constexpr int MR = BATCH * SEQ;
constexpr int LX = 2112, NX = BATCH * LX;
constexpr int NCH = 33, NCHUNKS = BATCH * NH * NCH;
constexpr int PROJ = 7184;
constexpr int NEXP = 32, FF = 512;
constexpr int MAXT = 160;
constexpr float EPS = 1e-6f;

constexpr size_t MiB = 1u << 20;
constexpr size_t WS_CTL = 0, CTL_ZERO_BYTES = 64 * 1024;
constexpr size_t WS_GB     = 1 * MiB;
constexpr size_t WS_UMETA  = WS_GB + 1152 * 1024;
constexpr size_t WS_HALO   = WS_UMETA + 64 * 1024;
constexpr size_t WS_CD     = 7 * MiB;
constexpr size_t WS_CNT    = 7 * MiB + 64 * 1024;
constexpr size_t WS_TILEE  = WS_CNT + 64 * 1024;
constexpr size_t WS_TOK    = WS_TILEE + 4096;
constexpr size_t WS_ROWIDX = 8 * MiB;
constexpr size_t WS_ROWS   = WS_ROWIDX + 256 * 1024;
constexpr size_t WS_ROWW   = WS_ROWS + 256 * 1024;
constexpr size_t WS_TOKPOS = WS_ROWW + 256 * 1024;
constexpr size_t WS_BTIN   = 10 * MiB;
constexpr size_t WS_BTOUT  = 24 * MiB;
constexpr size_t WS_U      = 26 * MiB;
constexpr size_t WS_O      = 58 * MiB;
constexpr size_t WS_QKV    = 90 * MiB;
constexpr size_t WS_CLX    = 189 * MiB;
constexpr size_t WS_PM     = 90 * MiB;
constexpr size_t WS_ZS     = 123 * MiB;
constexpr size_t WS_GP     = 155 * MiB;
constexpr size_t WS_GD     = 187 * MiB;
constexpr size_t WS_MERGED = 219 * MiB;
constexpr size_t WS_H1     = 90 * MiB;
constexpr size_t WS_XN     = 10 * MiB;
constexpr size_t WS_HDN    = 42 * MiB;
constexpr size_t WS_BTGU   = 154 * MiB;
constexpr size_t WS_BTDN   = 250 * MiB;
constexpr size_t WS_Y      = 154 * MiB;
constexpr size_t WS_END    = 289 * MiB;

constexpr int LDS_BYTES = 163840;
constexpr int MISC_OFF = 163840 - 256;

struct Frame {
    LAS unsigned char* lds;
    volatile LAS unsigned* MISC;
    int tid, lane, wave;
    int vcu, G;
    unsigned char* ws;
    const float *x, *meta, *norm_mix_w, *w_in, *conv_w, *pool_w, *pool_scale, *a_log, *dt_bias, *dn_norm_w, *w_out, *norm_ffn_w,
                *rg_w, *rg_b, *re_w, *re_b, *w_gate, *w_up, *w_down, *norm_final_w;
    float* out;
};
__device__ __forceinline__ int xrow_of(int r) { return (r >> 11) * LX + 64 + (r & 2047); }

__device__ __forceinline__ void transpose_item(const float* W, int ldw, int c0, bf16* WT, int ldk, int r0, int k0, LAS float* scr, int lane) {
    float tv[32];
#pragma unroll
    for (int i = 0; i < 32; ++i) { const int kk = 2 * i + (lane >> 5); tv[i] = W[(size_t)(k0 + kk) * ldw + c0 + (lane & 31)]; }
#pragma unroll
    for (int i = 0; i < 32; ++i) { const int kk = 2 * i + (lane >> 5); scr[kk * 33 + (lane & 31)] = tv[i]; }
    LDS_WAIT(); asm volatile("" ::: "memory");
    const int c = lane & 7;
#pragma unroll
    for (int j = 0; j < 4; ++j) { const int n = (lane >> 3) + 8 * j; const LAS float* s = scr + (8 * c) * 33 + n;
        v4u o; o.x = pk2(s[0 * 33], s[1 * 33]); o.y = pk2(s[2 * 33], s[3 * 33]); o.z = pk2(s[4 * 33], s[5 * 33]); o.w = pk2(s[6 * 33], s[7 * 33]);
        *(GAS v4u*)(WT + (size_t)(r0 + n) * ldk + k0 + 8 * c) = o; }
    LDS_WAIT(); asm volatile("" ::: "memory");
}
__device__ __forceinline__ void transpose_item_gu(const float* Wg, const float* Wu, bf16* WT, int r0, int k0, LAS float* scr, int lane) {
    const int d = lane & 31, cdst = r0 + d, f = (cdst >> 3) * 4 + (cdst & 3); const float* src = ((cdst >> 2) & 1) ? Wu : Wg;
    float tv[32];
#pragma unroll
    for (int i = 0; i < 32; ++i) { const int kk = 2 * i + (lane >> 5); tv[i] = src[(size_t)(k0 + kk) * FF + f]; }
#pragma unroll
    for (int i = 0; i < 32; ++i) { const int kk = 2 * i + (lane >> 5); scr[kk * 33 + d] = tv[i]; }
    LDS_WAIT(); asm volatile("" ::: "memory");
    const int c = lane & 7;
#pragma unroll
    for (int j = 0; j < 4; ++j) { const int n = (lane >> 3) + 8 * j; const LAS float* s = scr + (8 * c) * 33 + n;
        v4u o; o.x = pk2(s[0 * 33], s[1 * 33]); o.y = pk2(s[2 * 33], s[3 * 33]); o.z = pk2(s[4 * 33], s[5 * 33]); o.w = pk2(s[6 * 33], s[7 * 33]);
        *(GAS v4u*)(WT + (size_t)(r0 + n) * D + k0 + 8 * c) = o; }
    LDS_WAIT(); asm volatile("" ::: "memory");
}

__device__ __forceinline__ void p0_prologue(Frame& F) {
    const int gw = F.vcu * NWAVES + F.wave, NGW = F.G * NWAVES, lane = F.lane;
    LAS float* WabT = (LAS float*)F.lds;
    for (int k = F.tid; k < D; k += NWAVES * 64) {
        const f32x4* src = (const f32x4*)(F.w_in + (size_t)k * PROJ + 5120);
#pragma unroll
        for (int q = 0; q < 4; ++q) { const f32x4 v = src[q]; WabT[(4 * q + 0) * D + k] = v.x; WabT[(4 * q + 1) * D + k] = v.y; WabT[(4 * q + 2) * D + k] = v.z; WabT[(4 * q + 3) * D + k] = v.w; }
    }
    __syncthreads();
    bf16* U = (bf16*)(F.ws + WS_U); bf16* UM = (bf16*)(F.ws + WS_UMETA); float* GB = (float*)(F.ws + WS_GB);
    f32x4 nw[4];
#pragma unroll
    for (int j = 0; j < 4; ++j) nw[j] = ((const f32x4*)F.norm_mix_w)[64 * j + lane];
    for (int r = gw; r < MR + NMETA; r += NGW) {
        const bool ismeta = r >= MR; const int mj = r - MR;
        const f32x4* xr = (const f32x4*)(ismeta ? F.meta + (size_t)mj * D : F.x + (size_t)r * D) + lane;
        f32x4 v[4]; float s = 0.f;
#pragma unroll
        for (int j = 0; j < 4; ++j) { v[j] = xr[64 * j]; s += (v[j].x * v[j].x + v[j].y * v[j].y) + (v[j].z * v[j].z + v[j].w * v[j].w); }
        const float rstd = 1.f / sqrtf(wave_sum(s) * (1.f / D) + EPS);
#pragma unroll
        for (int j = 0; j < 4; ++j) v[j] = v[j] * rstd * nw[j];
        unsigned long long* o8 = (unsigned long long*)(ismeta ? UM + (size_t)mj * D : U + (size_t)r * D) + lane;
#pragma unroll
        for (int j = 0; j < 4; ++j) o8[64 * j] = (unsigned long long)pk2(v[j].x, v[j].y) | ((unsigned long long)pk2(v[j].z, v[j].w) << 32);
        float mine = 0.f;
#pragma unroll 2
        for (int o = 0; o < 16; ++o) {
            float p = 0.f;
#pragma unroll
            for (int j = 0; j < 4; ++j) { const f32x4 w = *(const LAS f32x4*)(WabT + o * D + 256 * j + 4 * lane); p += (v[j].x * w.x + v[j].y * w.y) + (v[j].z * w.z + v[j].w * w.w); }
            p = wave_sum(p);
            mine = (lane == o) ? p : mine;
        }
        if (lane < 16) {
            float val;
            if (lane < 8) { const float xx = mine + F.dt_bias[lane]; const float sp = xx > 20.f ? xx : log1pf(__expf(xx)); val = -__expf(F.a_log[lane]) * sp; }
            else val = 1.f / (1.f + __expf(-mine));
            if (!ismeta) GB[(size_t)xrow_of(r) * 16 + lane] = val;
            else {
#pragma unroll
                for (int b = 0; b < BATCH; ++b) GB[(size_t)(b * LX + 48 + mj) * 16 + lane] = val; }
        }
    }
    __syncthreads();
    bf16* BTIN = (bf16*)(F.ws + WS_BTIN); bf16* BTOUT = (bf16*)(F.ws + WS_BTOUT);
    LAS float* scr = (LAS float*)(F.lds + 65536 + F.wave * 8448);
    constexpr int NB_TOT = 96 + 32 + 32 + 32 + 32;
    for (int it = gw; it < NB_TOT * 16; it += NGW) {
        const int kb = it & 15; int nb = it >> 4;
        if (nb < 96) { transpose_item(F.w_in, PROJ, 1024 + 32 * nb, BTIN, D, 32 * nb, 64 * kb, scr, lane); continue; } nb -= 96;
        if (nb < 32) { transpose_item(F.w_in, PROJ, 4096 + 32 * nb, BTIN, D, 4096 + 32 * nb, 64 * kb, scr, lane); continue; } nb -= 32;
        if (nb < 32) { transpose_item(F.w_in, PROJ, 5136 + 32 * nb, BTIN, D, 5120 + 32 * nb, 64 * kb, scr, lane); continue; } nb -= 32;
        if (nb < 32) { transpose_item(F.w_in, PROJ, 6160 + 32 * nb, BTIN, D, 6144 + 32 * nb, 64 * kb, scr, lane); continue; } nb -= 32;
        transpose_item(F.w_out, D, 32 * nb, BTOUT, D, 32 * nb, 64 * kb, scr, lane);
    }
    for (int tile = gw; tile < 4 * 64 * 16; tile += NGW) {
        const int g = tile >> 10, kt = (tile >> 4) & 63, ntl = tile & 15;
        const int m = lane & 15, q = lane >> 4;
        const float* arow = F.w_in + (size_t)(16 * kt + m) * PROJ + 256 * g + 8 * q;
        const float* bcol = F.pool_w + (size_t)g * 65536 + (size_t)(8 * q) * 256 + 16 * ntl + m;
        f32x4 acc = {0.f, 0.f, 0.f, 0.f};
#pragma unroll 2
        for (int s = 0; s < 8; ++s) {
            const f32x4 a0 = *(const f32x4*)(arow + 32 * s), a1 = *(const f32x4*)(arow + 32 * s + 4);
            float bv[8];
#pragma unroll
            for (int j = 0; j < 8; ++j) bv[j] = bcol[(size_t)(32 * s + j) * 256];
            v4u ap, bp; ap.x = pk2(a0.x, a0.y); ap.y = pk2(a0.z, a0.w); ap.z = pk2(a1.x, a1.y); ap.w = pk2(a1.z, a1.w);
            bp.x = pk2(bv[0], bv[1]); bp.y = pk2(bv[2], bv[3]); bp.z = pk2(bv[4], bv[5]); bp.w = pk2(bv[6], bv[7]);
            acc = MFMA16(__builtin_bit_cast(bf16x8, ap), __builtin_bit_cast(bf16x8, bp), acc);
        }
        v2u o; o.x = pk2(acc[0], acc[1]); o.y = pk2(acc[2], acc[3]);
        *(GAS v2u*)(BTIN + (size_t)(3072 + 256 * g + 16 * ntl + m) * D + 16 * kt + 4 * q) = o;
    }
}

typedef pg8::f32x4 (&AccRef)[2][2][4][2];
struct EpiQKV {
    static constexpr bool PERM = true;
    bf16* QKV; bf16* HALO;
    __device__ __forceinline__ void operator()(const pg8::f32x4 (&acc)[2][2][4][2], const pg8::Unit& u, int wr, int wc, int fr, int fq) const {
        const int col0 = u.pn * 256 + wc * 32 + 8 * fq;
#pragma unroll
        for (int ai = 0; ai < 2; ++ai)
#pragma unroll
            for (int m = 0; m < 4; ++m) {
                const int r = u.pm * 256 + ai * 128 + wr * 64 + m * 16 + fr; const int b = r >> 11, xin = 64 + (r & 2047);
                bf16* rowp = QKV + (size_t)(b * LX + xin) * 3072 + col0;
                const bool halo = (m == 3) && (fr >= 13) && ((xin >> 6) + 1 <= 32);
                bf16* hp = HALO + ((size_t)((b * NCH + (xin >> 6) + 1) * 3 + (fr - 13))) * 3072 + col0;
#pragma unroll
                for (int bj = 0; bj < 2; ++bj) { const pg8::f32x4 v0 = acc[ai][bj][m][0], v1 = acc[ai][bj][m][1];
                    v4u w; w.x = pk2(v0[0], v0[1]); w.y = pk2(v0[2], v0[3]); w.z = pk2(v1[0], v1[1]); w.w = pk2(v1[2], v1[3]);
                    *(v4u*)(rowp + bj * 128) = w; if (halo) *(v4u*)(hp + bj * 128) = w; } }
    }
};
struct EpiPZG {
    static constexpr bool PERM = true;
    bf16 *PM, *ZS, *GP, *GD;
    __device__ __forceinline__ void operator()(const pg8::f32x4 (&acc)[2][2][4][2], const pg8::Unit& u, int wr, int wc, int fr, int fq) const {
        const int kind = u.pn >> 2, col0 = (u.pn & 3) * 256 + wc * 32 + 8 * fq;
        bf16* base = kind == 0 ? PM : (kind == 1 ? ZS : (kind == 2 ? GP : GD));
#pragma unroll
        for (int ai = 0; ai < 2; ++ai)
#pragma unroll
            for (int m = 0; m < 4; ++m) {
                const int r = u.pm * 256 + ai * 128 + wr * 64 + m * 16 + fr; const int orow = kind == 0 ? xrow_of(r) : r;
                bf16* rowp = base + (size_t)orow * D + col0;
#pragma unroll
                for (int bj = 0; bj < 2; ++bj) { pg8::f32x4 v0 = acc[ai][bj][m][0], v1 = acc[ai][bj][m][1];
                    if (kind == 1) {
#pragma unroll
                        for (int e = 0; e < 4; ++e) { v0[e] = siluf_(v0[e]); v1[e] = siluf_(v1[e]); } }
                    else if (kind >= 2) {
#pragma unroll
                        for (int e = 0; e < 4; ++e) { v0[e] = sigmoidf_(v0[e]); v1[e] = sigmoidf_(v1[e]); } }
                    v4u w; w.x = pk2(v0[0], v0[1]); w.y = pk2(v0[2], v0[3]); w.z = pk2(v1[0], v1[1]); w.w = pk2(v1[2], v1[3]);
                    *(v4u*)(rowp + bj * 128) = w; } }
    }
};
struct EpiOut {
    static constexpr bool PERM = false;
    const float* X; float* H1;
    __device__ __forceinline__ void operator()(const pg8::f32x4 (&acc)[2][2][4][2], const pg8::Unit& u, int wr, int wc, int fr, int fq) const {
        const int row0 = u.pm * 256 + wr * 64 + fr, col0 = u.pn * 256 + wc * 32 + 4 * fq;
#pragma unroll
        for (int ai = 0; ai < 2; ++ai)
#pragma unroll
            for (int m = 0; m < 4; ++m) { const size_t off = (size_t)(row0 + ai * 128 + m * 16) * D + col0;
#pragma unroll
                for (int bj = 0; bj < 2; ++bj)
#pragma unroll
                    for (int n = 0; n < 2; ++n) { const pg8::f32x4 xv = *(const pg8::f32x4*)(X + off + bj * 128 + n * 16); *(pg8::f32x4*)(H1 + off + bj * 128 + n * 16) = acc[ai][bj][m][n] + xv; } }
    }
};
struct EpiGU {
    static constexpr bool PERM = true;
    bf16* HDN; const float* ROWS;
    __device__ __forceinline__ void operator()(const pg8::f32x4 (&acc)[2][2][4][2], const pg8::Unit& u, int wr, int wc, int fr, int fq) const {
        const int f0 = (u.pn & 3) * 128 + wc * 16 + 4 * fq;
#pragma unroll
        for (int ai = 0; ai < 2; ++ai)
#pragma unroll
            for (int m = 0; m < 4; ++m) { const int pos = u.pm * 256 + ai * 128 + wr * 64 + m * 16 + fr; const float rs = ROWS[pos];
#pragma unroll
                for (int bj = 0; bj < 2; ++bj) { const pg8::f32x4 gt = acc[ai][bj][m][0] * rs, up = acc[ai][bj][m][1] * rs;
                    v2u w; w.x = pk2(siluf_(gt[0]) * up[0], siluf_(gt[1]) * up[1]); w.y = pk2(siluf_(gt[2]) * up[2], siluf_(gt[3]) * up[3]);
                    *(v2u*)(HDN + (size_t)pos * FF + f0 + bj * 64) = w; } }
    }
};
struct EpiDown {
    static constexpr bool PERM = true;
    bf16* Y; const float* ROWW;
    __device__ __forceinline__ void operator()(const pg8::f32x4 (&acc)[2][2][4][2], const pg8::Unit& u, int wr, int wc, int fr, int fq) const {
        const int col0 = (u.pn & 3) * 256 + wc * 32 + 8 * fq;
#pragma unroll
        for (int ai = 0; ai < 2; ++ai)
#pragma unroll
            for (int m = 0; m < 4; ++m) { const int pos = u.pm * 256 + ai * 128 + wr * 64 + m * 16 + fr; const float cw = ROWW[pos];
#pragma unroll
                for (int bj = 0; bj < 2; ++bj) { const pg8::f32x4 v0 = acc[ai][bj][m][0] * cw, v1 = acc[ai][bj][m][1] * cw;
                    v4u w; w.x = pk2(v0[0], v0[1]); w.y = pk2(v0[2], v0[3]); w.z = pk2(v1[0], v1[1]); w.w = pk2(v1[2], v1[3]);
                    *(v4u*)(Y + (size_t)pos * D + col0 + bj * 128) = w; } }
    }
};
struct MoeOrder {
    int ntiles, G, c; const int* tile_e; const LAS int* idx;
    __device__ __forceinline__ bool next(int i, pg8::Unit& u) const {
        const int L = i * G + c; if (L >= 4 * ntiles) return false;
        u.pm = L >> 2; u.pn = tile_e[L >> 2] * 4 + (L & 3); return true;
    }
    __device__ __forceinline__ int gather_row(const pg8::Unit& u, int r) const { const int i = (u.pm * 4 + (u.pn & 3) - c) / G; return idx[i * 256 + r]; }
};

__device__ __forceinline__ void meta_rows_job(Frame& F, const bf16* BT, int ncols, bf16* OUTX, int ld, bf16* HALO) {
    const bf16* UM = (const bf16*)(F.ws + WS_UMETA);
    const int lane = F.lane, m = lane & 15, q = lane >> 4;
    for (int tile = F.vcu * NWAVES + F.wave; tile < ncols / 16; tile += F.G * NWAVES) {
        const bf16* ap = UM + (size_t)m * D + 8 * q; const bf16* bp = BT + (size_t)(16 * tile + m) * D + 8 * q;
        f32x4 acc = {0.f, 0.f, 0.f, 0.f};
#pragma unroll 4
        for (int s = 0; s < 32; ++s) acc = MFMA16(*(const bf16x8*)(ap + 32 * s), *(const bf16x8*)(bp + 32 * s), acc);
#pragma unroll
        for (int i = 0; i < 4; ++i) { const int j = 4 * q + i; const bf16 v = f2bf(acc[i]);
#pragma unroll
            for (int b = 0; b < BATCH; ++b) { OUTX[(size_t)(b * LX + 48 + j) * ld + 16 * tile + m] = v;
                if (HALO && j >= 13) HALO[((size_t)((b * NCH + 1) * 3 + (j - 13))) * 3072 + 16 * tile + m] = v; } }
    }
}

constexpr int P2_KN = 0, P2_QN = 17408, P2_KBT = 34816, P2_VBT = 53248, P2_KDT = 71680, P2_QDI = 90112, P2_AM = 107520, P2_TM = 124928, P2_QKM = 134144, P2_SC = 143360, P2_AB21 = 144640;
constexpr int RS = 272, TS = 144;
__device__ __forceinline__ size_t inplace_off(int xr0, int mat, int h, int f, int lane) {
    return ((size_t)(xr0 + 4 * f + (lane >> 4)) * 3072 + mat * 1024 + h * 128) * 2 + (lane & 15) * 16;
}
__device__ __forceinline__ void p2_chunk_local(Frame& F) {
    LAS unsigned char* L = F.lds; const int wave = F.wave;
    LAS float* SC = (LAS float*)(L + P2_SC);
    unsigned char* QKV = F.ws + WS_QKV; const bf16* HALO = (const bf16*)(F.ws + WS_HALO); const float* GB = (const float*)(F.ws + WS_GB);
    unsigned char* CLX = F.ws + WS_CLX; float* CD = (float*)(F.ws + WS_CD);
    for (int cid = F.vcu; cid < NCHUNKS; cid += F.G) {
        const int c = cid % NCH, bh = cid / NCH, h = bh & 7, b = bh >> 3, xr0 = b * LX + 64 * c;
        int tid = F.tid; asm volatile("" : "+v"(tid)); const int lane = tid & 63;
        if (wave == 0) {
            const bool nul = (c == 0) && (lane < 48);
            float g = nul ? 0.f : GB[(size_t)(xr0 + lane) * 16 + h], be = nul ? 0.f : GB[(size_t)(xr0 + lane) * 16 + 8 + h];
            float gam = g;
#pragma unroll
            for (int o = 1; o < 64; o <<= 1) { const float t = __shfl_up(gam, o); if (lane >= o) gam += t; }
            const float gl = __shfl(gam, 63);
            SC[lane] = gam; SC[64 + lane] = be; const float eg = __expf(gam); SC[128 + lane] = eg; SC[192 + lane] = __expf(gl - gam); SC[256 + lane] = be * eg;
            if (lane == 0) CD[cid] = __expf(gl);
        }
        float val[8][8];
        const int grp = tid >> 4, mat = grp >> 3, rg = grp & 7, cg = lane & 15;
        if (tid < 384) {
            const int ch0 = mat * 1024 + h * 128 + 8 * cg;
            v4u raww[11];
#pragma unroll
            for (int i = 0; i < 11; ++i) {
                const int li = 8 * rg - 3 + i;
                v4u w = {0u, 0u, 0u, 0u};
                if (li < 0) { if (c > 0) w = *(const v4u*)(HALO + ((size_t)((b * NCH + c) * 3 + (li + 3))) * 3072 + ch0); }
                else if (!(c == 0 && li < 48)) w = *(const v4u*)(QKV + ((size_t)(xr0 + li) * 3072 + ch0) * 2);
                raww[i] = w;
            }
#define RAWV(i, e) (((e) & 1) ? bfhi(raww[i][(e) >> 1]) : bflo(raww[i][(e) >> 1]))
            float cw[4][8];
#pragma unroll
            for (int kk = 0; kk < 4; ++kk) { const f32x4 a = *(const f32x4*)(F.conv_w + (size_t)kk * 3072 + ch0), bq = *(const f32x4*)(F.conv_w + (size_t)kk * 3072 + ch0 + 4);
                cw[kk][0] = a.x; cw[kk][1] = a.y; cw[kk][2] = a.z; cw[kk][3] = a.w; cw[kk][4] = bq.x; cw[kk][5] = bq.y; cw[kk][6] = bq.z; cw[kk][7] = bq.w; }
#pragma unroll
            for (int i = 0; i < 8; ++i) {
                float ss = 0.f;
#pragma unroll
                for (int e = 0; e < 8; ++e) { const float cv = cw[0][e] * RAWV(i, e) + cw[1][e] * RAWV(i + 1, e) + cw[2][e] * RAWV(i + 2, e) + cw[3][e] * RAWV(i + 3, e);
                    const float sv = siluf_(cv); val[i][e] = sv; ss += sv * sv; }
                if (mat < 2) { ss += __shfl_xor(ss, 1); ss += __shfl_xor(ss, 2); ss += __shfl_xor(ss, 4); ss += __shfl_xor(ss, 8);
                    const float inv = (1.f / sqrtf(ss + EPS)) * (mat == 0 ? 0.08838834764831845f : 1.f);
#pragma unroll
                    for (int e = 0; e < 8; ++e) val[i][e] *= inv; }
            }
        }
        __syncthreads();
        if (tid < 384) {
            if (mat == 0) {
#pragma unroll
                for (int i = 0; i < 8; ++i) { const int t = 8 * rg + i; const float eg = SC[128 + t];
                    v4u w; w.x = pk2(val[i][0], val[i][1]); w.y = pk2(val[i][2], val[i][3]); w.z = pk2(val[i][4], val[i][5]); w.w = pk2(val[i][6], val[i][7]);
                    *(LAS v4u*)(L + P2_QN + t * RS + cg * 16) = w;
                    w.x = pk2(val[i][0] * eg, val[i][1] * eg); w.y = pk2(val[i][2] * eg, val[i][3] * eg); w.z = pk2(val[i][4] * eg, val[i][5] * eg); w.w = pk2(val[i][6] * eg, val[i][7] * eg);
                    *(LAS v4u*)(L + P2_QDI + t * RS + cg * 16) = w; }
            } else if (mat == 1) {
                float beg[8], egl[8];
#pragma unroll
                for (int i = 0; i < 8; ++i) { beg[i] = SC[256 + 8 * rg + i]; egl[i] = SC[192 + 8 * rg + i]; }
#pragma unroll
                for (int i = 0; i < 8; ++i) { const int t = 8 * rg + i;
                    v4u w; w.x = pk2(val[i][0], val[i][1]); w.y = pk2(val[i][2], val[i][3]); w.z = pk2(val[i][4], val[i][5]); w.w = pk2(val[i][6], val[i][7]);
                    *(LAS v4u*)(L + P2_KN + t * RS + cg * 16) = w; }
#pragma unroll
                for (int e = 0; e < 8; ++e) { const int k = 8 * cg + e;
                    v4u w; w.x = pk2(val[0][e] * beg[0], val[1][e] * beg[1]); w.y = pk2(val[2][e] * beg[2], val[3][e] * beg[3]); w.z = pk2(val[4][e] * beg[4], val[5][e] * beg[5]); w.w = pk2(val[6][e] * beg[6], val[7][e] * beg[7]);
                    *(LAS v4u*)(L + P2_KBT + k * TS + rg * 16) = w;
                    w.x = pk2(val[0][e] * egl[0], val[1][e] * egl[1]); w.y = pk2(val[2][e] * egl[2], val[3][e] * egl[3]); w.z = pk2(val[4][e] * egl[4], val[5][e] * egl[5]); w.w = pk2(val[6][e] * egl[6], val[7][e] * egl[7]);
                    *(LAS v4u*)(L + P2_KDT + k * TS + rg * 16) = w; }
            } else {
                float be[8];
#pragma unroll
                for (int i = 0; i < 8; ++i) be[i] = SC[64 + 8 * rg + i];
#pragma unroll
                for (int e = 0; e < 8; ++e) { const int k = 8 * cg + e;
                    v4u w; w.x = pk2(val[0][e] * be[0], val[1][e] * be[1]); w.y = pk2(val[2][e] * be[2], val[3][e] * be[3]); w.z = pk2(val[4][e] * be[4], val[5][e] * be[5]); w.w = pk2(val[6][e] * be[6], val[7][e] * be[7]);
                    *(LAS v4u*)(L + P2_VBT + k * TS + rg * 16) = w; }
            }
        }
        __syncthreads();
        {
            const int mq = wave >> 2, tm = (wave >> 1) & 1, tn = wave & 1, r = lane & 31, hh = lane >> 5;
            f32x16 acc; for (int i = 0; i < 16; ++i) acc[i] = 0.f;
            if (tm >= tn) {
                LAS unsigned char* ab = L + (mq ? P2_QN : P2_KN) + (32 * tm + r) * RS + hh * 16; LAS unsigned char* bb = L + P2_KN + (32 * tn + r) * RS + hh * 16;
#pragma unroll
                for (int s = 0; s < 8; ++s) acc = MFMA32(*(const LAS bf16x8*)(ab + 32 * s), *(const LAS bf16x8*)(bb + 32 * s), acc);
            }
            const int tc = 32 * tn + r; const float gc = SC[tc];
#pragma unroll
            for (int i = 0; i < 16; ++i) { const int t = 32 * tm + crow(i, hh); const float dec = __expf(SC[t] - gc);
                if (mq == 0) { const float av = (t > tc) ? SC[64 + t] * acc[i] * dec : 0.f; *(LAS float*)(L + P2_AM + t * RS + tc * 4) = av;
                    if (tm == 1 && tn == 0) *(LAS bf16*)(L + P2_AB21 + (t - 32) * 80 + tc * 2) = f2bf(av); }
                else *(LAS bf16*)(L + P2_QKM + t * TS + tc * 2) = f2bf((t >= tc) ? acc[i] * dec : 0.f); }
        }
        __syncthreads();
        if (wave == 0) {
            const int half = lane >> 5, cb = lane & 31;
            float X[32];
#pragma unroll
            for (int i = 0; i < 32; ++i) X[i] = 0.f;
            const LAS unsigned char* am = L + P2_AM + (32 * half) * RS + (32 * half) * 4;
            f32x4 cu[8]; float cdg = *(const LAS float*)(am + 1 * RS + cb * 4);
            cu[0] = *(const LAS f32x4*)(am + 1 * RS);
#pragma unroll
            for (int i = 1; i < 32; ++i) {
                f32x4 nx[8]; float ndg = 0.f;
                if (i + 1 < 32) {
#pragma unroll
                    for (int j4 = 0; j4 < (i + 4) / 4; ++j4) nx[j4] = *(const LAS f32x4*)(am + (i + 1) * RS + j4 * 16);
                    ndg = *(const LAS float*)(am + (i + 1) * RS + cb * 4);
                }
                __builtin_amdgcn_sched_barrier(0);
                float a0 = -cdg, a1 = 0.f, a2 = 0.f, a3 = 0.f;
#pragma unroll
                for (int j4 = 0; j4 < (i + 3) / 4; ++j4) { a0 -= cu[j4].x * X[4 * j4]; a1 -= cu[j4].y * X[4 * j4 + 1]; a2 -= cu[j4].z * X[4 * j4 + 2]; a3 -= cu[j4].w * X[4 * j4 + 3]; }
                X[i] = (a0 + a1) + (a2 + a3);
                __builtin_amdgcn_sched_barrier(0);
                if (i + 1 < 32) {
#pragma unroll
                    for (int j4 = 0; j4 < (i + 4) / 4; ++j4) cu[j4] = nx[j4];
                    cdg = ndg;
                }
            }
            LAS unsigned char* tm = L + P2_TM;
#pragma unroll
            for (int i = 0; i < 32; ++i) *(LAS bf16*)(tm + (32 * half + i) * TS + lane * 2) = f2bf(X[i]);
            if (half == 0) {
#pragma unroll
                for (int i = 0; i < 32; ++i) *(LAS bf16*)(tm + i * TS + (32 + cb) * 2) = (bf16)0;
            }
            LDS_WAIT(); asm volatile("" ::: "memory");
            *(LAS bf16*)(tm + lane * TS + lane * 2) = (bf16)0x3F80;
            LDS_WAIT(); asm volatile("" ::: "memory");
            {
                const int r = cb, hh = half;
                f32x16 M; for (int i = 0; i < 16; ++i) M[i] = 0.f;
#pragma unroll
                for (int s2 = 0; s2 < 2; ++s2) {
                    const bf16x8 a = *(const LAS bf16x8*)(L + P2_AB21 + r * 80 + (16 * s2 + 8 * hh) * 2);
                    unsigned short e[8];
#pragma unroll
                    for (int j = 0; j < 8; ++j) e[j] = *(const LAS bf16*)(tm + (16 * s2 + 8 * hh + j) * TS + r * 2);
                    v4u bw; bw.x = e[0] | ((unsigned)e[1] << 16); bw.y = e[2] | ((unsigned)e[3] << 16); bw.z = e[4] | ((unsigned)e[5] << 16); bw.w = e[6] | ((unsigned)e[7] << 16);
                    M = MFMA32(a, __builtin_bit_cast(bf16x8, bw), M);
                }
                f32x16 T21; for (int i = 0; i < 16; ++i) T21[i] = 0.f;
#pragma unroll
                for (int s2 = 0; s2 < 2; ++s2) {
                    const LAS unsigned char* src = tm + (32 + r) * TS + (32 + 16 * s2 + 4 * hh) * 2;
                    const v2u lo = *(const LAS v2u*)src, hi = *(const LAS v2u*)(src + 16);
                    v4u aw; aw.x = lo.x; aw.y = lo.y; aw.z = hi.x; aw.w = hi.y;
                    T21 = MFMA32(__builtin_bit_cast(bf16x8, aw), pack_step(M, s2), T21);
                }
#pragma unroll
                for (int i = 0; i < 16; ++i) *(LAS bf16*)(tm + (32 + crow(i, hh)) * TS + r * 2) = f2bf(-T21[i]);
            }
        } else {
            const int r = lane & 31, hh = lane >> 5;
            for (int f = wave - 1; f < 40; f += 7) {
                LAS unsigned char* src; unsigned char* dst;
                if (f < 16)      { src = L + P2_QDI + (32 * (f >> 3) + r) * RS + (16 * (f & 7) + 4 * hh) * 2; dst = QKV + inplace_off(xr0, 0, h, f, lane); }
                else if (f < 32) { const int g = f - 16; src = L + P2_KDT + (32 * (g >> 2) + r) * TS + (16 * (g & 3) + 4 * hh) * 2; dst = QKV + inplace_off(xr0, 1, h, g, lane); }
                else             { const int g = f - 32; src = L + P2_QKM + (32 * (g >> 2) + r) * TS + (16 * (g & 3) + 4 * hh) * 2; dst = CLX + (size_t)cid * 24576 + 16384 + g * 1024 + lane * 16; }
                const v2u lo = *(const LAS v2u*)src, hi = *(const LAS v2u*)(src + 16);
                v4u w; w.x = lo.x; w.y = lo.y; w.z = hi.x; w.w = hi.y;
                *(v4u*)dst = w;
            }
        }
        __syncthreads();
        f32x16 accW, accU;
        {
            const int tm = wave >> 2, tn = wave & 3, r = lane & 31, hh = lane >> 5;
            for (int i = 0; i < 16; ++i) { accW[i] = 0.f; accU[i] = 0.f; }
            LAS unsigned char* ab = L + P2_TM + (32 * tm + r) * TS + hh * 16; LAS unsigned char* bk = L + P2_KBT + (32 * tn + r) * TS + hh * 16; LAS unsigned char* bv = L + P2_VBT + (32 * tn + r) * TS + hh * 16;
#pragma unroll
            for (int s = 0; s < 4; ++s) { const bf16x8 a = *(const LAS bf16x8*)(ab + 32 * s);
                accW = MFMA32(a, *(const LAS bf16x8*)(bk + 32 * s), accW); accU = MFMA32(a, *(const LAS bf16x8*)(bv + 32 * s), accU); }
        }
        __syncthreads();
        {
            const int tm = wave >> 2, tn = wave & 3, r = lane & 31, hh = lane >> 5;
#pragma unroll
            for (int i = 0; i < 16; ++i) { const int t = 32 * tm + crow(i, hh), n = 32 * tn + r;
                *(LAS bf16*)(L + P2_KBT + t * RS + n * 2) = f2bf(-accW[i]); *(LAS bf16*)(L + P2_VBT + t * RS + n * 2) = f2bf(accU[i]); }
        }
        __syncthreads();
        {
            const int r = lane & 31, hh = lane >> 5;
            for (int f = wave; f < 32; f += 8) {
                if (f < 16) {
                    LAS unsigned char* src = L + P2_KBT + (32 * (f >> 3) + r) * RS + (16 * (f & 7) + 4 * hh) * 2;
                    const v2u lo = *(const LAS v2u*)src, hi = *(const LAS v2u*)(src + 16);
                    v4u w; w.x = lo.x; w.y = lo.y; w.z = hi.x; w.w = hi.y;
                    *(v4u*)(CLX + (size_t)cid * 24576 + f * 1024 + lane * 16) = w;
                } else {
                    const int g = f - 16, s = g >> 2, mt = (g >> 1) & 1, p = g & 1;
                    unsigned short v[8];
#pragma unroll
                    for (int e = 0; e < 8; ++e) { const int t = 32 * mt + crow(8 * p + e, hh); v[e] = *(const LAS bf16*)(L + P2_VBT + t * RS + (32 * s + r) * 2); }
                    v4u w; w.x = v[0] | ((unsigned)v[1] << 16); w.y = v[2] | ((unsigned)v[3] << 16); w.z = v[4] | ((unsigned)v[5] << 16); w.w = v[6] | ((unsigned)v[7] << 16);
                    *(v4u*)(QKV + inplace_off(xr0, 2, h, g, lane)) = w;
                }
            }
        }
        __syncthreads();
    }
}

constexpr int SC_BUF = 61440;
__device__ __forceinline__ void scan_issue(Frame& F, int b, int h, int s, int c, LAS unsigned char* buf) {
    const int lane = F.lane, cid = (b * NH + h) * NCH + c, xr0 = b * LX + 64 * c;
    const unsigned char* QKV = F.ws + WS_QKV; const unsigned char* clx = F.ws + WS_CLX + (size_t)cid * 24576 + lane * 16;
#pragma unroll
    for (int f = 0; f < 16; ++f) __builtin_amdgcn_global_load_lds((const unsigned*)(clx + f * 1024), (LAS unsigned*)(buf + f * 1024), 16, 0, 0);
#pragma unroll
    for (int f = 0; f < 16; ++f) __builtin_amdgcn_global_load_lds((const unsigned*)(QKV + inplace_off(xr0, 0, h, f, lane)), (LAS unsigned*)(buf + 16384 + f * 1024), 16, 0, 0);
#pragma unroll
    for (int f = 0; f < 16; ++f) __builtin_amdgcn_global_load_lds((const unsigned*)(QKV + inplace_off(xr0, 1, h, f, lane)), (LAS unsigned*)(buf + 32768 + f * 1024), 16, 0, 0);
#pragma unroll
    for (int f = 0; f < 8; ++f) __builtin_amdgcn_global_load_lds((const unsigned*)(clx + 16384 + f * 1024), (LAS unsigned*)(buf + 49152 + f * 1024), 16, 0, 0);
#pragma unroll
    for (int f = 0; f < 4; ++f) __builtin_amdgcn_global_load_lds((const unsigned*)(QKV + inplace_off(xr0, 2, h, 4 * s + f, lane)), (LAS unsigned*)(buf + 57344 + f * 1024), 16, 0, 0);
}
#define DSR(dst, base, off) asm volatile("ds_read_b128 %0, %1" : "=v"(dst) : "v"((unsigned)(size_t)(base) + (unsigned)(off)))
#define LWAIT4(n, g) asm volatile("s_waitcnt lgkmcnt(" #n ")" : "+v"(g[0]), "+v"(g[1]), "+v"(g[2]), "+v"(g[3]))
#define LWAIT6(n, g) asm volatile("s_waitcnt lgkmcnt(" #n ")" : "+v"(g[0]), "+v"(g[1]), "+v"(g[2]), "+v"(g[3]), "+v"(g[4]), "+v"(g[5]))
#define BF8(x) __builtin_bit_cast(bf16x8, x)
__device__ __forceinline__ void p3_scan(Frame& F) {
    if (F.wave != 0) return;
    const int lane = F.lane, r = lane & 31, hh = lane >> 5;
    const float* CD = (const float*)(F.ws + WS_CD); bf16* O = (bf16*)(F.ws + WS_O);
    for (int task = F.vcu; task < BATCH * NH * 4; task += F.G) {
        const int s = task & 3, bh = task >> 2, h = bh & 7, b = bh >> 3;
        f32x16 S[4];
#pragma unroll
        for (int kt = 0; kt < 4; ++kt) for (int i = 0; i < 16; ++i) S[kt][i] = 0.f;
        const float cdv = (lane < NCH) ? CD[(b * NH + h) * NCH + lane] : 0.f;
        scan_issue(F, b, h, s, 0, F.lds);
        for (int c = 0; c < NCH; ++c) {
            LAS unsigned char* buf = F.lds + (c & 1) * SC_BUF;
            VM_WAIT();
            if (c + 1 < NCH) scan_issue(F, b, h, s, c + 1, F.lds + ((c + 1) & 1) * SC_BUF);
            const float cd = __builtin_bit_cast(float, __builtin_amdgcn_readlane(__builtin_bit_cast(int, cdv), c));
            const LAS unsigned char* fb = buf + lane * 16;
            v4u G[3][6];
#define ISSUE1(ks, g) do { DSR(G[g][0], fb, (0 * 8 + (ks)) * 1024); DSR(G[g][1], fb, (1 * 8 + (ks)) * 1024); DSR(G[g][2], fb, 16384 + (0 * 8 + (ks)) * 1024); DSR(G[g][3], fb, 16384 + (1 * 8 + (ks)) * 1024); } while (0)
            ISSUE1(0, 0); ISSUE1(1, 1);
            f32x16 aV[2], aO[2];
#pragma unroll
            for (int mt = 0; mt < 2; ++mt) {
                const v4u u0 = *(const LAS v4u*)(fb + 57344 + (2 * mt) * 1024), u1 = *(const LAS v4u*)(fb + 57344 + (2 * mt + 1) * 1024);
                aV[mt][0] = bflo(u0.x); aV[mt][1] = bfhi(u0.x); aV[mt][2] = bflo(u0.y); aV[mt][3] = bfhi(u0.y); aV[mt][4] = bflo(u0.z); aV[mt][5] = bfhi(u0.z); aV[mt][6] = bflo(u0.w); aV[mt][7] = bfhi(u0.w);
                aV[mt][8] = bflo(u1.x); aV[mt][9] = bfhi(u1.x); aV[mt][10] = bflo(u1.y); aV[mt][11] = bfhi(u1.y); aV[mt][12] = bflo(u1.z); aV[mt][13] = bfhi(u1.z); aV[mt][14] = bflo(u1.w); aV[mt][15] = bfhi(u1.w);
                for (int i = 0; i < 16; ++i) aO[mt][i] = 0.f;
            }
            LDS_WAIT();
#pragma unroll
            for (int ks = 0; ks < 8; ++ks) {
                const int g = ks % 3;
                if (ks + 2 < 8) { ISSUE1(ks + 2, (ks + 2) % 3); LWAIT4(8, G[g]); }
                else if (ks + 1 < 8) { LWAIT4(4, G[g]); }
                else { LWAIT4(0, G[g]); }
                const bf16x8 sb = pack_step(S[ks >> 1], ks & 1);
                aV[0] = MFMA32(BF8(G[g][0]), sb, aV[0]); aV[1] = MFMA32(BF8(G[g][1]), sb, aV[1]);
                aO[0] = MFMA32(BF8(G[g][2]), sb, aO[0]); aO[1] = MFMA32(BF8(G[g][3]), sb, aO[1]);
            }
#define ISSUE2(ts, g) do { DSR(G[g][0], fb, 32768 + (0 * 4 + (ts)) * 1024); DSR(G[g][1], fb, 32768 + (1 * 4 + (ts)) * 1024); DSR(G[g][2], fb, 32768 + (2 * 4 + (ts)) * 1024); DSR(G[g][3], fb, 32768 + (3 * 4 + (ts)) * 1024); \
                               DSR(G[g][4], fb, 49152 + (0 * 4 + (ts)) * 1024); DSR(G[g][5], fb, 49152 + (1 * 4 + (ts)) * 1024); } while (0)
            ISSUE2(0, 2);
            bf16x8 Vb[2][2];
#pragma unroll
            for (int mt = 0; mt < 2; ++mt) { Vb[mt][0] = pack_step(aV[mt], 0); Vb[mt][1] = pack_step(aV[mt], 1); }
#pragma unroll
            for (int kt = 0; kt < 4; ++kt) S[kt] = S[kt] * cd;
#pragma unroll
            for (int ts = 0; ts < 4; ++ts) {
                const int g = (ts + 2) % 3;
                if (ts + 1 < 4) { ISSUE2(ts + 1, (ts + 3) % 3); LWAIT6(6, G[g]); }
                else { LWAIT6(0, G[g]); }
#pragma unroll
                for (int kt = 0; kt < 4; ++kt) S[kt] = MFMA32(BF8(G[g][kt]), Vb[ts >> 1][ts & 1], S[kt]);
                aO[0] = MFMA32(BF8(G[g][4]), Vb[ts >> 1][ts & 1], aO[0]); aO[1] = MFMA32(BF8(G[g][5]), Vb[ts >> 1][ts & 1], aO[1]);
            }
#undef ISSUE1
#undef ISSUE2
            if (c > 0) {
                bf16* orow = O + (size_t)(b * SEQ + 64 * (c - 1)) * D + h * HD + 32 * s + r;
#pragma unroll
                for (int mt = 0; mt < 2; ++mt)
#pragma unroll
                    for (int i = 0; i < 16; ++i) orow[(size_t)(32 * mt + crow(i, hh)) * D] = f2bf(aO[mt][i]);
            }
        }
        VM_WAIT();
    }
}

__device__ __forceinline__ void load16(const bf16* p, float (&v)[16]) {
    const v4u a = *(const v4u*)p, b = *(const v4u*)(p + 8);
    v[0] = bflo(a.x); v[1] = bfhi(a.x); v[2] = bflo(a.y); v[3] = bfhi(a.y); v[4] = bflo(a.z); v[5] = bfhi(a.z); v[6] = bflo(a.w); v[7] = bfhi(a.w);
    v[8] = bflo(b.x); v[9] = bfhi(b.x); v[10] = bflo(b.y); v[11] = bfhi(b.y); v[12] = bflo(b.z); v[13] = bfhi(b.z); v[14] = bflo(b.w); v[15] = bfhi(b.w);
}
__device__ __forceinline__ void p5_merge(Frame& F) {
    const int gw = F.vcu * NWAVES + F.wave, NGW = F.G * NWAVES, lane = F.lane;
    const bf16* O = (const bf16*)(F.ws + WS_O); const bf16* PM = (const bf16*)(F.ws + WS_PM); const bf16* ZS = (const bf16*)(F.ws + WS_ZS);
    const bf16* GP = (const bf16*)(F.ws + WS_GP); const bf16* GD = (const bf16*)(F.ws + WS_GD); bf16* MG = (bf16*)(F.ws + WS_MERGED);
    const int n0 = 16 * lane, win = 2 << (lane >> 4); const float rwin = 1.f / (float)win;
    float psc[16], dnw[16];
#pragma unroll
    for (int e = 0; e < 16; ++e) { psc[e] = F.pool_scale[n0 + e]; dnw[e] = F.dn_norm_w[(n0 + e) & 127]; }
    for (int r0 = gw * 8; r0 < MR; r0 += NGW * 8) {
        for (int rr = 0; rr < 8; ++rr) {
            const int r = r0 + rr, xr = xrow_of(r);
            float o[16], z[16], gp[16], gd[16], pm[16], sum[16];
            load16(O + (size_t)r * D + n0, o); load16(ZS + (size_t)r * D + n0, z); load16(GP + (size_t)r * D + n0, gp); load16(GD + (size_t)r * D + n0, gd);
            load16(PM + (size_t)xr * D + n0, pm);
#pragma unroll
            for (int e = 0; e < 16; ++e) sum[e] = pm[e];
            for (int j = 1; j < win; ++j) { float t[16]; load16(PM + (size_t)(xr - j) * D + n0, t);
#pragma unroll
                for (int e = 0; e < 16; ++e) sum[e] += t[e]; }
            float ss = 0.f;
#pragma unroll
            for (int e = 0; e < 16; ++e) ss += o[e] * o[e];
            ss += __shfl_xor(ss, 1); ss += __shfl_xor(ss, 2); ss += __shfl_xor(ss, 4);
            const float rstd = 1.f / sqrtf(ss * (1.f / HD) + EPS);
            float m[16];
#pragma unroll
            for (int e = 0; e < 16; ++e) m[e] = gp[e] * psc[e] * (sum[e] * rwin - pm[e]) + gd[e] * (o[e] * rstd * dnw[e]) * z[e];
            v4u w0, w1; w0.x = pk2(m[0], m[1]); w0.y = pk2(m[2], m[3]); w0.z = pk2(m[4], m[5]); w0.w = pk2(m[6], m[7]);
            w1.x = pk2(m[8], m[9]); w1.y = pk2(m[10], m[11]); w1.z = pk2(m[12], m[13]); w1.w = pk2(m[14], m[15]);
            *(v4u*)(MG + (size_t)r * D + n0) = w0; *(v4u*)(MG + (size_t)r * D + n0 + 8) = w1;
        }
    }
}

struct TokRec { int e0, e1, s0, s1; float w0, w1, rstd, pad; };
constexpr int P7_WS = 1032, P7_WH = 0, P7_WL = 74304, P7_LG = 148608, P7_CNT = 148608 + 4 * 2560;
__device__ __forceinline__ void p7_router(Frame& F) {
    LAS unsigned char* L = F.lds; const int tid = F.tid, lane = F.lane, wave = F.wave;
    for (int idx = tid; idx < 36 * D; idx += NWAVES * 64) {
        const int k = idx / 36, o = idx - k * 36;
        const float w = (o < 4 ? F.rg_w[k * 4 + o] : F.re_w[k * 32 + (o - 4)]) * F.norm_ffn_w[k];
        const unsigned short hi = f2bf(w); const unsigned short lo = f2bf(w - bf2f(hi));
        *(LAS bf16*)(L + P7_WH + (o * P7_WS + k) * 2) = hi; *(LAS bf16*)(L + P7_WL + (o * P7_WS + k) * 2) = lo;
    }
    LAS int* lcnt = (LAS int*)(L + P7_CNT);
    if (tid < 32) lcnt[tid] = 0;
    __syncthreads();
    const float* H1 = (const float*)(F.ws + WS_H1); bf16* XN = (bf16*)(F.ws + WS_XN); TokRec* TOK = (TokRec*)(F.ws + WS_TOK);
    if (wave < 4) {
        const int m = lane & 15, q = lane >> 4, row = 64 * F.vcu + 16 * wave + m;
        const float* hp = H1 + (size_t)row * D + 8 * q; const float* nwp = F.norm_ffn_w + 8 * q;
        f32x4 acc[3] = {{0.f, 0.f, 0.f, 0.f}, {0.f, 0.f, 0.f, 0.f}, {0.f, 0.f, 0.f, 0.f}};
        float ss = 0.f;
        const int orow[3] = {m, 16 + m, (32 + m) < 36 ? 32 + m : 35};
        for (int s = 0; s < 32; ++s) {
            const f32x4 a0 = *(const f32x4*)(hp + 32 * s), a1 = *(const f32x4*)(hp + 32 * s + 4);
            const f32x4 n0 = *(const f32x4*)(nwp + 32 * s), n1 = *(const f32x4*)(nwp + 32 * s + 4);
            const float x[8] = {a0.x, a0.y, a0.z, a0.w, a1.x, a1.y, a1.z, a1.w};
            v4u xh, xl; unsigned hh[4], ll[4];
#pragma unroll
            for (int j = 0; j < 4; ++j) { const unsigned ph = pk2(x[2 * j], x[2 * j + 1]); hh[j] = ph; ll[j] = pk2(x[2 * j] - bflo(ph), x[2 * j + 1] - bfhi(ph)); ss += x[2 * j] * x[2 * j] + x[2 * j + 1] * x[2 * j + 1]; }
            xh.x = hh[0]; xh.y = hh[1]; xh.z = hh[2]; xh.w = hh[3]; xl.x = ll[0]; xl.y = ll[1]; xl.z = ll[2]; xl.w = ll[3];
            v4u xo; xo.x = pk2(a0.x * n0.x, a0.y * n0.y); xo.y = pk2(a0.z * n0.z, a0.w * n0.w); xo.z = pk2(a1.x * n1.x, a1.y * n1.y); xo.w = pk2(a1.z * n1.z, a1.w * n1.w);
            *(v4u*)(XN + (size_t)row * D + 32 * s + 8 * q) = xo;
#pragma unroll
            for (int t = 0; t < 3; ++t) {
                const bf16x8 wh = *(const LAS bf16x8*)(L + P7_WH + (orow[t] * P7_WS + 32 * s + 8 * q) * 2), wl = *(const LAS bf16x8*)(L + P7_WL + (orow[t] * P7_WS + 32 * s + 8 * q) * 2);
                acc[t] = MFMA16(__builtin_bit_cast(bf16x8, xh), wh, acc[t]); acc[t] = MFMA16(__builtin_bit_cast(bf16x8, xl), wh, acc[t]); acc[t] = MFMA16(__builtin_bit_cast(bf16x8, xh), wl, acc[t]);
            }
        }
        ss += __shfl_xor(ss, 16); ss += __shfl_xor(ss, 32);
        LAS float* lg = (LAS float*)(L + P7_LG + wave * 2560);
#pragma unroll
        for (int t = 0; t < 3; ++t)
#pragma unroll
            for (int i = 0; i < 4; ++i) if (16 * t + m < 36) lg[(4 * q + i) * 40 + 16 * t + m] = acc[t][i];
        LDS_WAIT(); asm volatile("" ::: "memory");
        if (lane < 16) {
            const float rstd = 1.f / sqrtf(ss * (1.f / D) + EPS);
            float gl[4];
#pragma unroll
            for (int o = 0; o < 4; ++o) gl[o] = lg[lane * 40 + o] * rstd + F.rg_b[o];
            int gi = 0; float gm = gl[0];
#pragma unroll
            for (int o = 1; o < 4; ++o) if (gl[o] > gm) { gm = gl[o]; gi = o; }
            float den = 0.f;
#pragma unroll
            for (int o = 0; o < 4; ++o) den += __expf(gl[o] - gm);
            const float pg = 1.f / den;
            float el[8];
#pragma unroll
            for (int e = 0; e < 8; ++e) el[e] = lg[lane * 40 + 4 + 8 * gi + e] * rstd + F.re_b[8 * gi + e];
            int i0 = 0; float m0 = el[0];
#pragma unroll
            for (int e = 1; e < 8; ++e) if (el[e] > m0) { m0 = el[e]; i0 = e; }
            int i1 = -1; float m1 = -3.0e38f;
#pragma unroll
            for (int e = 0; e < 8; ++e) if (e != i0 && el[e] > m1) { m1 = el[e]; i1 = e; }
            const float w0 = 1.f / (1.f + __expf(m1 - m0)), w1 = 1.f - w0;
            const int e0 = gi * 8 + i0, e1 = gi * 8 + i1;
            TokRec t; t.e0 = e0; t.e1 = e1; t.s0 = __hip_atomic_fetch_add(&lcnt[e0], 1, __ATOMIC_RELAXED, __HIP_MEMORY_SCOPE_WORKGROUP); t.s1 = __hip_atomic_fetch_add(&lcnt[e1], 1, __ATOMIC_RELAXED, __HIP_MEMORY_SCOPE_WORKGROUP); t.w0 = pg * w0; t.w1 = pg * w1; t.rstd = rstd; t.pad = 0.f;
            TOK[64 * F.vcu + 16 * wave + lane] = t;
        }
    }
    __syncthreads();
    if (tid < 32) ((int*)(F.ws + WS_CNT))[F.vcu * 32 + tid] = lcnt[tid];
    __syncthreads();
    const int gw = F.vcu * NWAVES + wave, NGW = F.G * NWAVES;
    LAS float* scr = (LAS float*)(L + wave * 8448);
    bf16* BTGU = (bf16*)(F.ws + WS_BTGU); bf16* BTDN = (bf16*)(F.ws + WS_BTDN);
    for (int it = gw; it < NEXP * 512 + NEXP * 256; it += NGW) {
        if (it < NEXP * 512) { const int e = it >> 9, nb = (it >> 4) & 31, kb = it & 15;
            transpose_item_gu(F.w_gate + (size_t)e * D * FF, F.w_up + (size_t)e * D * FF, BTGU + (size_t)e * 1024 * D, 32 * nb, 64 * kb, scr, lane); }
        else { const int jt = it - NEXP * 512, e = jt >> 8, nb = (jt >> 3) & 31, kb = jt & 7;
            transpose_item(F.w_down + (size_t)e * FF * D, D, 32 * nb, BTDN + (size_t)e * 1024 * FF, FF, 32 * nb, 64 * kb, scr, lane); }
    }
}

__device__ __forceinline__ void p8_index(Frame& F) {
    LAS int* tot = (LAS int*)F.lds; LAS int* mine = tot + 32; LAS int* base = tot + 64; LAS int* part = tot + 128;
    const int tid = F.tid; const int* CNT = (const int*)(F.ws + WS_CNT);
    { const int e = tid & 31, seg = tid >> 5;
        int st = 0, sm = 0;
        for (int w = seg * 16; w < seg * 16 + 16; ++w) { const int v = CNT[w * 32 + e]; st += v; if (w < F.vcu) sm += v; }
        part[seg * 32 + e] = st; part[512 + seg * 32 + e] = sm; }
    __syncthreads();
    if (tid < 32) { int st = 0, sm = 0; for (int s = 0; s < 16; ++s) { st += part[s * 32 + tid]; sm += part[512 + s * 32 + tid]; } tot[tid] = st; mine[tid] = sm; }
    __syncthreads();
    if (tid == 0) { int acc = 0; for (int e = 0; e < 32; ++e) { base[e] = acc; acc += ((tot[e] + 255) >> 8) << 8; } base[32] = acc; }
    __syncthreads();
    int* ROWIDX = (int*)(F.ws + WS_ROWIDX); float* ROWS = (float*)(F.ws + WS_ROWS); float* ROWW = (float*)(F.ws + WS_ROWW); int* TOKPOS = (int*)(F.ws + WS_TOKPOS);
    const TokRec* TOK = (const TokRec*)(F.ws + WS_TOK);
    if (tid < 128) { const int tk = 64 * F.vcu + (tid >> 1), sl = tid & 1; const TokRec t = TOK[tk];
        const int e = sl ? t.e1 : t.e0, s = sl ? t.s1 : t.s0; const int pos = base[e] + mine[e] + s;
        ROWIDX[pos] = tk; ROWS[pos] = t.rstd; ROWW[pos] = sl ? t.w1 : t.w0; TOKPOS[tk * 2 + sl] = pos; }
    if (F.vcu < 32) { const int e = F.vcu, lo = base[e] + tot[e], hi = base[e + 1];
        for (int p = lo + tid; p < hi; p += NWAVES * 64) { ROWIDX[p] = 0; ROWS[p] = 0.f; ROWW[p] = 0.f; } }
    if (F.vcu == 0 && tid < MAXT + 1) { int* TILEE = (int*)(F.ws + WS_TILEE);
        const int nt = base[32] >> 8;
        if (tid == MAXT) TILEE[MAXT] = nt;
        else { int e = 0; for (int q = 1; q < 32; ++q) if ((base[q] >> 8) <= tid) e = q; TILEE[tid] = (tid < nt) ? e : 0; } }
}

__device__ __forceinline__ void p11_final(Frame& F) {
    const int gw = F.vcu * NWAVES + F.wave, NGW = F.G * NWAVES, lane = F.lane;
    const float* H1 = (const float*)(F.ws + WS_H1); const bf16* Y = (const bf16*)(F.ws + WS_Y); const int* TOKPOS = (const int*)(F.ws + WS_TOKPOS);
    f32x4 nw[4];
#pragma unroll
    for (int j = 0; j < 4; ++j) nw[j] = ((const f32x4*)F.norm_final_w)[64 * j + lane];
    for (int r = gw; r < MR; r += NGW) {
        const int p0 = TOKPOS[r * 2], p1 = TOKPOS[r * 2 + 1];
        const f32x4* hr = (const f32x4*)(H1 + (size_t)r * D) + lane;
        const v2u* y0 = (const v2u*)(Y + (size_t)p0 * D) + lane; const v2u* y1 = (const v2u*)(Y + (size_t)p1 * D) + lane;
        f32x4 v[4]; float s = 0.f;
#pragma unroll
        for (int j = 0; j < 4; ++j) { v[j] = hr[64 * j]; const v2u a = y0[64 * j], b = y1[64 * j];
            v[j].x += bflo(a.x) + bflo(b.x); v[j].y += bfhi(a.x) + bfhi(b.x); v[j].z += bflo(a.y) + bflo(b.y); v[j].w += bfhi(a.y) + bfhi(b.y);
            s += (v[j].x * v[j].x + v[j].y * v[j].y) + (v[j].z * v[j].z + v[j].w * v[j].w); }
        const float rstd = 1.f / sqrtf(wave_sum(s) * (1.f / D) + EPS);
        f32x4* orow = (f32x4*)(F.out + (size_t)r * D) + lane;
#pragma unroll
        for (int j = 0; j < 4; ++j) orow[64 * j] = v[j] * rstd * nw[j];
    }
}

constexpr int NPHASES = 12;
#ifndef MK_ONE_LAUNCH
#define MK_ONE_LAUNCH 1
#endif
struct Args { const float* in[20]; float* out; unsigned char* ws; int ph_lo, ph_hi; };
__global__ void __launch_bounds__(NWAVES * 64, 2) hybrid_fwd(Args args) {
    extern __shared__ __attribute__((aligned(16))) unsigned char lds[];
    Frame F;
    F.lds = (LAS unsigned char*)lds;
    F.MISC = (volatile LAS unsigned*)(F.lds + MISC_OFF);
    F.tid = threadIdx.x; F.lane = F.tid & 63; F.wave = __builtin_amdgcn_readfirstlane(F.tid >> 6);
    F.G = gridDim.x; { const int bx = blockIdx.x; F.vcu = (F.G % 8 == 0) ? (bx % 8) * (F.G / 8) + bx / 8 : bx; }
    F.ws = args.ws; F.out = args.out;
    F.x = args.in[0]; F.meta = args.in[1]; F.norm_mix_w = args.in[2]; F.w_in = args.in[3]; F.conv_w = args.in[4]; F.pool_w = args.in[5]; F.pool_scale = args.in[6];
    F.a_log = args.in[7]; F.dt_bias = args.in[8]; F.dn_norm_w = args.in[9]; F.w_out = args.in[10]; F.norm_ffn_w = args.in[11]; F.rg_w = args.in[12]; F.rg_b = args.in[13];
    F.re_w = args.in[14]; F.re_b = args.in[15]; F.w_gate = args.in[16]; F.w_up = args.in[17]; F.w_down = args.in[18]; F.norm_final_w = args.in[19];
    if (F.tid < 64) F.MISC[F.tid] = 0u;
    __syncthreads();
    const int lo = args.ph_lo, hi = args.ph_hi;
    XcdBarrier bar; bar.bar = (unsigned*)(F.ws + WS_CTL); bar.x = 0; bar.st = nullptr;
    if (hi - lo > 1) bar = xcd_barrier_post((unsigned*)(F.ws + WS_CTL), F.MISC + 8);
#ifndef PHMASK
#define PHMASK 0xFFF
#endif
#define IN(k) ((((PHMASK) >> (k)) & 1) && lo <= (k) && (k) < hi)
#define SEAM(k) do { if (IN(k) && IN((k) + 1)) xcd_barrier(bar); } while (0)

    if (IN(0)) { p0_prologue(F); } SEAM(0);

    if (IN(1)) {
        pg8::Gemm g{(const bf16*)(F.ws + WS_U), (const bf16*)(F.ws + WS_BTIN), MR, 3072, D}; pg8::StaticOrder S; S.init(MR, 3072, F.G, (int)blockIdx.x);
        EpiQKV E{(bf16*)(F.ws + WS_QKV), (bf16*)(F.ws + WS_HALO)};
        pg8::gemm_phase<EpiQKV, pg8::StaticOrder, true, false>(F.lds, g, S, E);
        meta_rows_job(F, (const bf16*)(F.ws + WS_BTIN), 3072, (bf16*)(F.ws + WS_QKV), 3072, (bf16*)(F.ws + WS_HALO));
    } SEAM(1);

    if (IN(2)) { p2_chunk_local(F); } SEAM(2);

    if (IN(3)) { p3_scan(F); } SEAM(3);

    if (IN(4)) {
        pg8::Gemm g{(const bf16*)(F.ws + WS_U), (const bf16*)(F.ws + WS_BTIN) + (size_t)3072 * D, MR, 4096, D}; pg8::StaticOrder S; S.init(MR, 4096, F.G, (int)blockIdx.x);
        EpiPZG E{(bf16*)(F.ws + WS_PM), (bf16*)(F.ws + WS_ZS), (bf16*)(F.ws + WS_GP), (bf16*)(F.ws + WS_GD)};
        pg8::gemm_phase<EpiPZG, pg8::StaticOrder, true, false>(F.lds, g, S, E);
        meta_rows_job(F, (const bf16*)(F.ws + WS_BTIN) + (size_t)3072 * D, 1024, (bf16*)(F.ws + WS_PM), 1024, nullptr);
    } SEAM(4);

    if (IN(5)) { p5_merge(F); } SEAM(5);

    if (IN(6)) {
        pg8::Gemm g{(const bf16*)(F.ws + WS_MERGED), (const bf16*)(F.ws + WS_BTOUT), MR, D, D}; pg8::StaticOrder S; S.init(MR, D, F.G, (int)blockIdx.x);
        EpiOut E{F.x, (float*)(F.ws + WS_H1)};
        pg8::gemm_phase<EpiOut, pg8::StaticOrder, false, false>(F.lds, g, S, E);
    } SEAM(6);

    if (IN(7)) { p7_router(F); } SEAM(7);

    if (IN(8)) { p8_index(F); } SEAM(8);

    if (IN(9) || IN(10)) {
        const int* TILEE = (const int*)(F.ws + WS_TILEE); const int ntiles = TILEE[MAXT];
        LAS int* idx = (LAS int*)(F.lds + 131072);
        if (IN(9)) {
            const int* ROWIDX = (const int*)(F.ws + WS_ROWIDX);
            for (int i = 0; i < 3; ++i) { const int Lu = i * F.G + F.vcu; if (Lu < 4 * ntiles) for (int t = F.tid; t < 256; t += NWAVES * 64) idx[i * 256 + t] = ROWIDX[(Lu >> 2) * 256 + t]; }
            __syncthreads();
            pg8::Gemm g{(const bf16*)(F.ws + WS_XN), (const bf16*)(F.ws + WS_BTGU), 0, 0, D};
            MoeOrder S{ntiles, F.G, F.vcu, TILEE, idx};
            EpiGU E{(bf16*)(F.ws + WS_HDN), (const float*)(F.ws + WS_ROWS)};
            pg8::gemm_phase<EpiGU, MoeOrder, true, true>(F.lds, g, S, E);
        }
        SEAM(9);
        if (IN(10)) {
            pg8::Gemm g{(const bf16*)(F.ws + WS_HDN), (const bf16*)(F.ws + WS_BTDN), 0, 0, FF};
            MoeOrder S{ntiles, F.G, F.vcu, TILEE, idx};
            EpiDown E{(bf16*)(F.ws + WS_Y), (const float*)(F.ws + WS_ROWW)};
            pg8::gemm_phase<EpiDown, MoeOrder, true, false>(F.lds, g, S, E);
        }
    }
    SEAM(10);

    if (IN(11)) { p11_final(F); }
#undef IN
#undef SEAM
}

extern "C" void kernel_launch(void* const* d_in, const int* in_sizes, int n_in, void* d_out, int out_size, void* d_ws, size_t ws_size, hipStream_t stream) {
    static int ready = 0;
    if (ready == 0) {
        if (n_in != 20 || in_sizes[0] != MR * D || out_size != MR * D || ws_size < WS_END) {
            fprintf(stderr, "kernel_launch: unexpected problem (n_in %d, in0 %d, out %d, ws %zu)\n", n_in, n_in > 0 ? in_sizes[0] : -1, out_size, ws_size); ready = -1; return; }
        if (hipFuncSetAttribute((const void*)hybrid_fwd, hipFuncAttributeMaxDynamicSharedMemorySize, LDS_BYTES) != hipSuccess) { fprintf(stderr, "kernel_launch: hipFuncSetAttribute failed\n"); ready = -1; return; }
        int per_cu = 0;
        if (hipOccupancyMaxActiveBlocksPerMultiprocessor(&per_cu, (const void*)hybrid_fwd, NWAVES * 64, LDS_BYTES) != hipSuccess || per_cu < 1)
            fprintf(stderr, "kernel_launch: note: occupancy query reports %d workgroups per CU\n", per_cu);
        (void)hipGetLastError();
        ready = 1;
    }
    if (ready < 0) return;
    (void)hipMemsetAsync((char*)d_ws + WS_CTL, 0, CTL_ZERO_BYTES, stream);
    Args a{};
    for (int i = 0; i < 20; ++i) a.in[i] = (const float*)d_in[i];
    a.out = (float*)d_out; a.ws = (unsigned char*)d_ws;
#if defined(PROBE_LO)
    a.ph_lo = 0; a.ph_hi = PROBE_HI; hipLaunchKernelGGL(hybrid_fwd, dim3(256), dim3(NWAVES * 64), LDS_BYTES, stream, a);
    (void)hipMemsetAsync((char*)d_ws + WS_CTL, 0, CTL_ZERO_BYTES, stream);
    a.ph_lo = PROBE_LO; a.ph_hi = PROBE_HI; hipLaunchKernelGGL(hybrid_fwd, dim3(256), dim3(NWAVES * 64), LDS_BYTES, stream, a);
    (void)hipMemsetAsync((char*)d_ws + WS_CTL, 0, CTL_ZERO_BYTES, stream);
    if (PROBE_HI < NPHASES) { a.ph_lo = PROBE_HI; a.ph_hi = NPHASES; hipLaunchKernelGGL(hybrid_fwd, dim3(256), dim3(NWAVES * 64), LDS_BYTES, stream, a); }
#elif MK_ONE_LAUNCH
    a.ph_lo = 0; a.ph_hi = NPHASES;
    hipLaunchKernelGGL(hybrid_fwd, dim3(256), dim3(NWAVES * 64), LDS_BYTES, stream, a);
#else
    for (int p = 0; p < NPHASES; ++p) { a.ph_lo = p; a.ph_hi = p + 1; hipLaunchKernelGGL(hybrid_fwd, dim3(256), dim3(NWAVES * 64), LDS_BYTES, stream, a); }
#endif
}
```

```cpp
#include <hip/hip_runtime.h>
#include <cstdio>
#include <cstdint>

namespace pg8 {
#define PG8_LAS __attribute__((address_space(3)))
typedef unsigned short bf16_t;
typedef short bf16x8 __attribute__((ext_vector_type(8)));
typedef float f32x4 __attribute__((ext_vector_type(4)));
typedef unsigned u32x4 __attribute__((ext_vector_type(4)));
typedef unsigned u32x2 __attribute__((ext_vector_type(2)));
constexpr int BM = 256, BK = 64, HALF = 128, HTB = HALF * BK * 2  , STAGE_BYTES = 8 * HTB, NXCD = 8, WGM = 8;

__host__ __device__ __forceinline__ int lds_byte(int r, int c) { const int st = (r >> 4) * 2 + (c >> 5), rr = r & 15, cc = c & 31, ob = rr * 64 + cc * 2; return st * 1024 + (ob ^ (((ob >> 9) & 1) << 5)); }
__host__ __device__ __forceinline__ void stage_rc(int b, int& R, int& C) { const int st = b / 1024, sb = b % 1024, swz = sb ^ (((sb >> 9) & 1) << 5); R = (st >> 1) * 16 + swz / 64; C = (st & 1) * 32 + (swz % 64) / 2; }
__host__ __device__ __forceinline__ int perm32(int rho) { const int n = rho >> 4, i = rho & 15; return 8 * (i >> 2) + 4 * n + (i & 3); }

struct Unit { int pm, pn; };
struct Gemm { const bf16_t* A; const bf16_t* Bt; int M, N, K; };

struct StaticOrder {
    int nM, nN, nwg, G, c;
    __host__ __device__ void init(int M, int N, int G_, int c_) { nM = M / BM; nN = N / BM; nwg = nM * nN; G = G_; c = c_; }
    __host__ __device__ bool next(int i, Unit& u) const {
        const long L = (long)i * G + c; if (L >= nwg) return false;
        int wgid = (int)L; { const int q = nwg / NXCD, r = nwg % NXCD, xcd = wgid % NXCD, off = wgid / NXCD; wgid = (xcd < r ? xcd * (q + 1) : r * (q + 1) + (xcd - r) * q) + off; }
        const int nig = WGM * nN, gid = wgid / nig, fm = gid * WGM, gsz = (nM - fm) < WGM ? (nM - fm) : WGM;
        u.pm = fm + ((wgid % nig) % gsz); u.pn = (wgid % nig) / gsz; return true;
    }
    __device__ __forceinline__ int gather_row(const Unit&, int) const { return 0; }
};

template <class Epi, class Sched, bool ALIGN_EPI, bool GATHER>
__device__ __forceinline__ void gemm_phase(PG8_LAS unsigned char* lds, const Gemm g, const Sched& S, const Epi& E) {
    const int tid = threadIdx.x, wid = __builtin_amdgcn_readfirstlane(tid >> 6), lane = tid & 63, wr = wid >> 2, wc = wid & 3, fr = lane & 15, fq = lane >> 4;
    const int K = g.K, nt = K / BK;
    unsigned voffA[2], voffB[2]; int RA[2], CA[2];
#pragma unroll
    for (int i = 0; i < 2; ++i) { int R, C; stage_rc(tid * 16 + i * 8192, R, C); const int Rb = Epi::PERM ? ((R & ~31) + perm32(R & 31)) : R;
        RA[i] = R; CA[i] = C; voffA[i] = (unsigned)(R * K + C) * 2u; voffB[i] = (unsigned)(Rb * K + C) * 2u; }
    const size_t kstep = (size_t)(BK * 2);
    const size_t hstep = (size_t)HALF * K * 2;
    const size_t tstep = 2 * hstep;
    const unsigned ldsw = (unsigned)wid * 1024u;
    const int aoff = lds_byte(wr * 64 + fr, fq * 8), boff = lds_byte(wc * 32 + fr, fq * 8);
#define PG8_SA(b, h) (((b) * 2 + (h)) * HTB)
#define PG8_SB(b, h) ((4 + (b) * 2 + (h)) * HTB)
#define PG8_STAGE(bufoff, gbase, voff) do { _Pragma("unroll") for (int _i = 0; _i < 2; ++_i) \
        __builtin_amdgcn_global_load_lds((const unsigned*)((const char*)(gbase) + (voff)[_i]), (PG8_LAS unsigned*)(lds + (bufoff) + ldsw + _i * 8192), 16, 0, 0); } while (0)
#define PG8_STAGE_A(b, h, gbase, NEXT) do { if constexpr (GATHER) { unsigned _vo[2] = { (NEXT) ? nvo[h][0] : cvo[h][0], (NEXT) ? nvo[h][1] : cvo[h][1] }; PG8_STAGE(PG8_SA(b, h), (gbase), _vo); } \
        else { PG8_STAGE(PG8_SA(b, h), (gbase) + (h) * hstep, voffA); } } while (0)
#define PG8_LDA(dst, b, h) do { _Pragma("unroll") for (int m = 0; m < 4; ++m) _Pragma("unroll") for (int k = 0; k < 2; ++k) dst[m][k] = *(const PG8_LAS bf16x8*)(lds + PG8_SA(b, h) + aoff + m * 2048 + k * 1024); } while (0)
#define PG8_LDB(dst, b, h) do { _Pragma("unroll") for (int n = 0; n < 2; ++n) _Pragma("unroll") for (int k = 0; k < 2; ++k) dst[n][k] = *(const PG8_LAS bf16x8*)(lds + PG8_SB(b, h) + boff + n * 2048 + k * 1024); } while (0)
#define PG8_MMA(ai, bj, At, Bt) do { __builtin_amdgcn_s_setprio(1); _Pragma("unroll") for (int m = 0; m < 4; ++m) _Pragma("unroll") for (int n = 0; n < 2; ++n) _Pragma("unroll") for (int k = 0; k < 2; ++k) \
        acc[ai][bj][m][n] = __builtin_amdgcn_mfma_f32_16x16x32_bf16(Bt[n][k], At[m][k], acc[ai][bj][m][n], 0, 0, 0); __builtin_amdgcn_s_setprio(0); } while (0)
#define PG8_WAIT_V(n) asm volatile("s_waitcnt vmcnt(" #n ")" ::: "memory")
#define PG8_WAIT_L(n) asm volatile("s_waitcnt lgkmcnt(" #n ")" ::: "memory")
#define PG8_BAR __builtin_amdgcn_s_barrier()
#define PG8_SCHED __builtin_amdgcn_sched_barrier(0)
    Unit cur, nxt; int ui = 0;
    if (!S.next(0, cur)) return;
    f32x4 acc[2][2][4][2];
#pragma unroll
    for (int a = 0; a < 2; ++a)
#pragma unroll
        for (int b = 0; b < 2; ++b)
#pragma unroll
            for (int m = 0; m < 4; ++m)
#pragma unroll
                for (int n = 0; n < 2; ++n) acc[a][b][m][n] = (f32x4){0.f, 0.f, 0.f, 0.f};
    bf16x8 At[4][2], B0[2][2], B1[2][2];
    unsigned cvo[2][2] = {{0u, 0u}, {0u, 0u}}, nvo[2][2] = {{0u, 0u}, {0u, 0u}};
    if constexpr (GATHER) {
#pragma unroll
        for (int h = 0; h < 2; ++h)
#pragma unroll
            for (int i = 0; i < 2; ++i) cvo[h][i] = (unsigned)(S.gather_row(cur, h * HALF + RA[i]) * K + CA[i]) * 2u;
    }
    const char* cA = GATHER ? (const char*)g.A : (const char*)g.A + (size_t)cur.pm * tstep; const char* cB = (const char*)g.Bt + (size_t)cur.pn * tstep;
    PG8_STAGE(PG8_SB(0, 0), cB, voffB); PG8_STAGE(PG8_SB(0, 1), cB + hstep, voffB); PG8_STAGE_A(0, 0, cA, false); PG8_STAGE_A(0, 1, cA, false);
    if (wr == 1) PG8_BAR;
    PG8_WAIT_V(2); PG8_BAR;
    PG8_STAGE(PG8_SB(1, 0), cB + kstep, voffB); PG8_STAGE_A(1, 0, cA + kstep, false); PG8_STAGE(PG8_SB(1, 1), cB + hstep + kstep, voffB);
    PG8_WAIT_V(6); PG8_BAR;
    for (;;) {
        const bool has_next = S.next(ui + 1, nxt);
        const char* nA = GATHER ? (const char*)g.A : (has_next ? (const char*)g.A + (size_t)nxt.pm * tstep : cA);
        const char* nB = has_next ? (const char*)g.Bt + (size_t)nxt.pn * tstep : cB;
        for (int t = 0; t < nt; t += 2) {
            const bool last = (t == nt - 2);
            const char* a1 = cA + (size_t)(t + 1) * kstep;
            const char* a2 = last ? nA : cA + (size_t)(t + 2) * kstep; const char* b2 = last ? nB : cB + (size_t)(t + 2) * kstep;
            const char* a3 = a2 + kstep; const char* b3 = b2 + kstep;
            if constexpr (GATHER) { if (last) {
#pragma unroll
                for (int h = 0; h < 2; ++h)
#pragma unroll
                    for (int i = 0; i < 2; ++i) nvo[h][i] = has_next ? (unsigned)(S.gather_row(nxt, h * HALF + RA[i]) * K + CA[i]) * 2u : cvo[h][i];
            } }
            PG8_LDB(B0, 0, 0); PG8_LDB(B1, 0, 1); PG8_SCHED; PG8_LDA(At, 0, 0); PG8_STAGE_A(1, 1, a1, false);
            PG8_WAIT_V(8); PG8_WAIT_L(0); PG8_BAR; PG8_MMA(0, 0, At, B0); PG8_MMA(0, 1, At, B1); PG8_BAR; PG8_SCHED;
            PG8_LDA(At, 0, 1); PG8_STAGE(PG8_SB(0, 0), b2, voffB); PG8_STAGE(PG8_SB(0, 1), b2 + hstep, voffB); PG8_STAGE_A(0, 0, a2, last);
            PG8_WAIT_V(8); PG8_WAIT_L(0); PG8_BAR; PG8_MMA(1, 0, At, B0); PG8_MMA(1, 1, At, B1); PG8_BAR; PG8_SCHED;
            PG8_LDB(B0, 1, 0); PG8_LDB(B1, 1, 1); PG8_SCHED; PG8_LDA(At, 1, 0); PG8_STAGE_A(0, 1, a2, last);
            PG8_WAIT_V(8); PG8_WAIT_L(0); PG8_BAR; PG8_MMA(0, 0, At, B0); PG8_MMA(0, 1, At, B1); PG8_BAR; PG8_SCHED;
            PG8_LDA(At, 1, 1); PG8_STAGE(PG8_SB(1, 0), b3, voffB); PG8_STAGE(PG8_SB(1, 1), b3 + hstep, voffB); PG8_STAGE_A(1, 0, a3, last);
            PG8_WAIT_V(8); PG8_WAIT_L(0); PG8_BAR; PG8_MMA(1, 0, At, B0); PG8_MMA(1, 1, At, B1); PG8_BAR; PG8_SCHED;
        }
        if constexpr (ALIGN_EPI) { if (wr == 0) PG8_BAR; }
        E(acc, cur, wr, wc, fr, fq);
        if (!has_next) break;
#pragma unroll
        for (int a = 0; a < 2; ++a)
#pragma unroll
            for (int b = 0; b < 2; ++b)
#pragma unroll
                for (int m = 0; m < 4; ++m)
#pragma unroll
                    for (int n = 0; n < 2; ++n) acc[a][b][m][n] = (f32x4){0.f, 0.f, 0.f, 0.f};
        cur = nxt; cA = nA; cB = nB; ++ui;
        if constexpr (GATHER) {
#pragma unroll
            for (int h = 0; h < 2; ++h)
#pragma unroll
                for (int i = 0; i < 2; ++i) cvo[h][i] = nvo[h][i];
        }
        if constexpr (ALIGN_EPI) { if (wr == 1) PG8_BAR; }
    }
    PG8_WAIT_V(0);
    if constexpr (!ALIGN_EPI) { if (wr == 0) PG8_BAR; }
    PG8_BAR;
#undef PG8_SA
#undef PG8_SB
#undef PG8_STAGE
#undef PG8_STAGE_A
#undef PG8_LDA
#undef PG8_LDB
#undef PG8_MMA
#undef PG8_WAIT_V
#undef PG8_WAIT_L
#undef PG8_BAR
#undef PG8_SCHED
}
}

#define GAS __attribute__((address_space(1)))
#define LAS __attribute__((address_space(3)))
typedef unsigned short bf16;
typedef unsigned v4u __attribute__((ext_vector_type(4)));
typedef unsigned v2u __attribute__((ext_vector_type(2)));
typedef float f32x4 __attribute__((ext_vector_type(4)));
typedef float f32x16 __attribute__((ext_vector_type(16)));
typedef short bf16x8 __attribute__((ext_vector_type(8)));
typedef __bf16 bf16x2_t __attribute__((ext_vector_type(2)));
typedef float f32x2_t __attribute__((ext_vector_type(2)));
typedef GAS unsigned gu32;
#define RLX_AGENT __ATOMIC_RELAXED, __HIP_MEMORY_SCOPE_AGENT
#define LDS_WAIT() asm volatile("s_waitcnt lgkmcnt(0)" ::: "memory")
#define VM_WAIT() asm volatile("s_waitcnt vmcnt(0)" ::: "memory")
__device__ __forceinline__ unsigned pk2(float lo, float hi) { f32x2_t v = {lo, hi}; bf16x2_t r = __builtin_convertvector(v, bf16x2_t); return __builtin_bit_cast(unsigned, r); }
__device__ __forceinline__ unsigned short f2bf(float f) { return (unsigned short)(pk2(f, 0.f) & 0xffffu); }
__device__ __forceinline__ float bf2f(unsigned short b) { return __builtin_bit_cast(float, ((unsigned)b) << 16); }
__device__ __forceinline__ float bflo(unsigned w) { return __builtin_bit_cast(float, w << 16); }
__device__ __forceinline__ float bfhi(unsigned w) { return __builtin_bit_cast(float, w & 0xffff0000u); }
__device__ __forceinline__ float sigmoidf_(float x) { return 1.f / (1.f + __expf(-x)); }
__device__ __forceinline__ float siluf_(float x) { return x / (1.f + __expf(-x)); }
__device__ __forceinline__ float wave_sum(float v) {
#pragma unroll
    for (int o = 1; o < 64; o <<= 1) v += __shfl_xor(v, o);
    return v;
}
__device__ __forceinline__ int crow(int reg, int h) { return (reg & 3) + 8 * (reg >> 2) + 4 * h; }
#define MFMA32(a, b, c) __builtin_amdgcn_mfma_f32_32x32x16_bf16((a), (b), (c), 0, 0, 0)
#define MFMA16(a, b, c) __builtin_amdgcn_mfma_f32_16x16x32_bf16((a), (b), (c), 0, 0, 0)
__device__ __forceinline__ bf16x8 pack_step(const f32x16& x, int s) {
    v4u p; p.x = pk2(x[8 * s], x[8 * s + 1]); p.y = pk2(x[8 * s + 2], x[8 * s + 3]); p.z = pk2(x[8 * s + 4], x[8 * s + 5]); p.w = pk2(x[8 * s + 6], x[8 * s + 7]);
    return __builtin_bit_cast(bf16x8, p);
}

#define XB_TMO      128
#define XB_XCNT(j)  (256  + 64 * (j))
#define XB_XSUB(j)  (1280 + 64 * (j))
#define XB_XGEN(j)  (2304 + 64 * (j))
#define XB_TOP      3328
#define XB_TOPGEN   3392
#define XCD_BAR_WORDS 3456
#define XB_SPIN_CAP (1u << 18)

__device__ __forceinline__ unsigned xb_ld(unsigned* p)              { return __hip_atomic_load(p, __ATOMIC_RELAXED, __HIP_MEMORY_SCOPE_AGENT); }
__device__ __forceinline__ unsigned xb_add(unsigned* p, unsigned v) { return __hip_atomic_fetch_add(p, v, __ATOMIC_RELAXED, __HIP_MEMORY_SCOPE_AGENT); }
__device__ __forceinline__ unsigned xb_xcc_id() { return (unsigned)__builtin_amdgcn_s_getreg((3 << 11) | 20) & 0xFu; }
#define XB_SPIN(cond, bar) do { unsigned _sp = 0; while (cond) { __builtin_amdgcn_s_sleep(1); \
    if ((++_sp & 255u) == 0u) { if (xb_ld(&(bar)[XB_TMO])) break; if (_sp > XB_SPIN_CAP) { atomicAdd(&(bar)[XB_TMO], 1u); break; } } } } while (0)

struct XcdBarrier {
    unsigned* bar; unsigned x;
    volatile LAS unsigned* st;
};

__device__ __forceinline__ XcdBarrier xcd_barrier_post(unsigned* bar, volatile LAS unsigned* st) {
    XcdBarrier b; b.bar = bar; b.x = xb_xcc_id(); b.st = st;
    if (threadIdx.x == 0) (void)xb_add(&bar[XB_XCNT(b.x)], 1u);
    return b;
}
__device__ __forceinline__ void xcd_barrier_complete(unsigned* bar, unsigned x, unsigned& nloc, unsigned& nx) {
    const unsigned G = gridDim.x * gridDim.y * gridDim.z;
    unsigned sum, cnt, mine, sp = 0u;
    for (;;) {
        sum = 0u; cnt = 0u; mine = 0u;
#pragma unroll
        for (unsigned j = 0; j < 16; ++j) { const unsigned c = xb_ld(&bar[XB_XCNT(j)]); sum += c; cnt += (c > 0u) ? 1u : 0u; mine = (j == x) ? c : mine; }
        if (sum == G) break;
        __builtin_amdgcn_s_sleep(1);
        if ((++sp & 255u) == 0u) { if (xb_ld(&bar[XB_TMO])) break; if (sp > XB_SPIN_CAP) { atomicAdd(&bar[XB_TMO], 1u); break; } }
    }
    nloc = mine > 0u ? mine : 1u; nx = cnt > 0u ? cnt : 1u;
}

__device__ __forceinline__ void xcd_barrier(const XcdBarrier& b) {
    asm volatile("s_waitcnt vmcnt(0)" ::: "memory");
    __syncthreads();
    if (threadIdx.x == 0) {
        unsigned* bar = b.bar;
        __builtin_amdgcn_s_waitcnt(0);
        unsigned nloc = b.st[0], nx = b.st[1];
        if (nloc == 0u) { xcd_barrier_complete(bar, b.x, nloc, nx); b.st[0] = nloc; b.st[1] = nx; }
        const unsigned old = xb_add(&bar[XB_XSUB(b.x)], 1u);
        const unsigned gen = old / nloc;
        if (old + 1u == (gen + 1u) * nloc) {
            __builtin_amdgcn_fence(__ATOMIC_RELEASE, "agent");
            asm volatile("s_waitcnt vmcnt(0)" ::: "memory");
            const unsigned og = xb_add(&bar[XB_TOP], 1u);
            const unsigned tg = og / nx;
            if (og + 1u == (tg + 1u) * nx) xb_add(&bar[XB_TOPGEN], 1u);
            else XB_SPIN(xb_ld(&bar[XB_TOPGEN]) == tg, bar);
            __builtin_amdgcn_fence(__ATOMIC_ACQUIRE, "agent");
            xb_add(&bar[XB_XGEN(b.x)], 1u);
            asm volatile("s_waitcnt vmcnt(0)" ::: "memory");
        } else {
            XB_SPIN(xb_ld(&bar[XB_XGEN(b.x)]) == gen, bar);
            __builtin_amdgcn_fence(__ATOMIC_ACQUIRE, "agent");
            asm volatile("s_waitcnt vmcnt(0)" ::: "memory");
        }
    }
    __syncthreads();
}

constexpr int NWAVES = 8;
constexpr int BATCH = 8, SEQ = 2048, D = 1024, NMETA = 16, NH = 8, HD = 128;
constexpr int MR = BATCH * SEQ;
constexpr int LX = 2112, NX = BATCH * LX;
constexpr int NCH = 33, NCHUNKS = BATCH * NH * NCH;
constexpr int PROJ = 7184;
constexpr int NEXP = 32, FF = 512;
constexpr int MAXT = 160;
constexpr float EPS = 1e-6f;

constexpr size_t MiB = 1u << 20;
constexpr size_t WS_CTL = 0, CTL_ZERO_BYTES = 64 * 1024;
constexpr size_t WS_GB     = 1 * MiB;
constexpr size_t WS_UMETA  = WS_GB + 1152 * 1024;
constexpr size_t WS_HALO   = WS_UMETA + 64 * 1024;
constexpr size_t WS_CD     = 7 * MiB;
constexpr size_t WS_CNT    = 7 * MiB + 64 * 1024;
constexpr size_t WS_TILEE  = WS_CNT + 64 * 1024;
constexpr size_t WS_TOK    = WS_TILEE + 4096;
constexpr size_t WS_ROWIDX = 8 * MiB;
constexpr size_t WS_ROWS   = WS_ROWIDX + 256 * 1024;
constexpr size_t WS_ROWW   = WS_ROWS + 256 * 1024;
constexpr size_t WS_TOKPOS = WS_ROWW + 256 * 1024;
constexpr size_t WS_BTIN   = 10 * MiB;
constexpr size_t WS_BTOUT  = 24 * MiB;
constexpr size_t WS_U      = 26 * MiB;
constexpr size_t WS_O      = 58 * MiB;
constexpr size_t WS_QKV    = 90 * MiB;
constexpr size_t WS_CLX    = 189 * MiB;
constexpr size_t WS_PM     = 90 * MiB;
constexpr size_t WS_ZS     = 123 * MiB;
constexpr size_t WS_GP     = 155 * MiB;
constexpr size_t WS_GD     = 187 * MiB;
constexpr size_t WS_MERGED = 219 * MiB;
constexpr size_t WS_H1     = 90 * MiB;
constexpr size_t WS_XN     = 10 * MiB;
constexpr size_t WS_HDN    = 42 * MiB;
constexpr size_t WS_BTGU   = 154 * MiB;
constexpr size_t WS_BTDN   = 250 * MiB;
constexpr size_t WS_Y      = 154 * MiB;
constexpr size_t WS_END    = 289 * MiB;

constexpr int LDS_BYTES = 163840;
constexpr int MISC_OFF = 163840 - 256;

struct Frame {
    LAS unsigned char* lds;
    volatile LAS unsigned* MISC;
    int tid, lane, wave;
    int vcu, G;
    unsigned char* ws;
    const float *x, *meta, *norm_mix_w, *w_in, *conv_w, *pool_w, *pool_scale, *a_log, *dt_bias, *dn_norm_w, *w_out, *norm_ffn_w,
                *rg_w, *rg_b, *re_w, *re_b, *w_gate, *w_up, *w_down, *norm_final_w;
    float* out;
};
__device__ __forceinline__ int xrow_of(int r) { return (r >> 11) * LX + 64 + (r & 2047); }

__device__ __forceinline__ void transpose_item(const float* W, int ldw, int c0, bf16* WT, int ldk, int r0, int k0, LAS float* scr, int lane) {
    float tv[32];
#pragma unroll
    for (int i = 0; i < 32; ++i) { const int kk = 2 * i + (lane >> 5); tv[i] = W[(size_t)(k0 + kk) * ldw + c0 + (lane & 31)]; }
#pragma unroll
    for (int i = 0; i < 32; ++i) { const int kk = 2 * i + (lane >> 5); scr[kk * 33 + (lane & 31)] = tv[i]; }
    LDS_WAIT(); asm volatile("" ::: "memory");
    const int c = lane & 7;
#pragma unroll
    for (int j = 0; j < 4; ++j) { const int n = (lane >> 3) + 8 * j; const LAS float* s = scr + (8 * c) * 33 + n;
        v4u o; o.x = pk2(s[0 * 33], s[1 * 33]); o.y = pk2(s[2 * 33], s[3 * 33]); o.z = pk2(s[4 * 33], s[5 * 33]); o.w = pk2(s[6 * 33], s[7 * 33]);
        *(GAS v4u*)(WT + (size_t)(r0 + n) * ldk + k0 + 8 * c) = o; }
    LDS_WAIT(); asm volatile("" ::: "memory");
}
__device__ __forceinline__ void transpose_item_gu(const float* Wg, const float* Wu, bf16* WT, int r0, int k0, LAS float* scr, int lane) {
    const int d = lane & 31, cdst = r0 + d, f = (cdst >> 3) * 4 + (cdst & 3); const float* src = ((cdst >> 2) & 1) ? Wu : Wg;
    float tv[32];
#pragma unroll
    for (int i = 0; i < 32; ++i) { const int kk = 2 * i + (lane >> 5); tv[i] = src[(size_t)(k0 + kk) * FF + f]; }
#pragma unroll
    for (int i = 0; i < 32; ++i) { const int kk = 2 * i + (lane >> 5); scr[kk * 33 + d] = tv[i]; }
    LDS_WAIT(); asm volatile("" ::: "memory");
    const int c = lane & 7;
#pragma unroll
    for (int j = 0; j < 4; ++j) { const int n = (lane >> 3) + 8 * j; const LAS float* s = scr + (8 * c) * 33 + n;
        v4u o; o.x = pk2(s[0 * 33], s[1 * 33]); o.y = pk2(s[2 * 33], s[3 * 33]); o.z = pk2(s[4 * 33], s[5 * 33]); o.w = pk2(s[6 * 33], s[7 * 33]);
        *(GAS v4u*)(WT + (size_t)(r0 + n) * D + k0 + 8 * c) = o; }
    LDS_WAIT(); asm volatile("" ::: "memory");
}

__device__ __forceinline__ void p0_prologue(Frame& F) {
    const int gw = F.vcu * NWAVES + F.wave, NGW = F.G * NWAVES, lane = F.lane;
    LAS float* WabT = (LAS float*)F.lds;
    for (int k = F.tid; k < D; k += NWAVES * 64) {
        const f32x4* src = (const f32x4*)(F.w_in + (size_t)k * PROJ + 5120);
#pragma unroll
        for (int q = 0; q < 4; ++q) { const f32x4 v = src[q]; WabT[(4 * q + 0) * D + k] = v.x; WabT[(4 * q + 1) * D + k] = v.y; WabT[(4 * q + 2) * D + k] = v.z; WabT[(4 * q + 3) * D + k] = v.w; }
    }
    __syncthreads();
    bf16* U = (bf16*)(F.ws + WS_U); bf16* UM = (bf16*)(F.ws + WS_UMETA); float* GB = (float*)(F.ws + WS_GB);
    f32x4 nw[4];
#pragma unroll
    for (int j = 0; j < 4; ++j) nw[j] = ((const f32x4*)F.norm_mix_w)[64 * j + lane];
    for (int r = gw; r < MR + NMETA; r += NGW) {
        const bool ismeta = r >= MR; const int mj = r - MR;
        const f32x4* xr = (const f32x4*)(ismeta ? F.meta + (size_t)mj * D : F.x + (size_t)r * D) + lane;
        f32x4 v[4]; float s = 0.f;
#pragma unroll
        for (int j = 0; j < 4; ++j) { v[j] = xr[64 * j]; s += (v[j].x * v[j].x + v[j].y * v[j].y) + (v[j].z * v[j].z + v[j].w * v[j].w); }
        const float rstd = 1.f / sqrtf(wave_sum(s) * (1.f / D) + EPS);
#pragma unroll
        for (int j = 0; j < 4; ++j) v[j] = v[j] * rstd * nw[j];
        unsigned long long* o8 = (unsigned long long*)(ismeta ? UM + (size_t)mj * D : U + (size_t)r * D) + lane;
#pragma unroll
        for (int j = 0; j < 4; ++j) o8[64 * j] = (unsigned long long)pk2(v[j].x, v[j].y) | ((unsigned long long)pk2(v[j].z, v[j].w) << 32);
        float mine = 0.f;
#pragma unroll 2
        for (int o = 0; o < 16; ++o) {
            float p = 0.f;
#pragma unroll
            for (int j = 0; j < 4; ++j) { const f32x4 w = *(const LAS f32x4*)(WabT + o * D + 256 * j + 4 * lane); p += (v[j].x * w.x + v[j].y * w.y) + (v[j].z * w.z + v[j].w * w.w); }
            p = wave_sum(p);
            mine = (lane == o) ? p : mine;
        }
        if (lane < 16) {
            float val;
            if (lane < 8) { const float xx = mine + F.dt_bias[lane]; const float sp = xx > 20.f ? xx : log1pf(__expf(xx)); val = -__expf(F.a_log[lane]) * sp; }
            else val = 1.f / (1.f + __expf(-mine));
            if (!ismeta) GB[(size_t)xrow_of(r) * 16 + lane] = val;
            else {
#pragma unroll
                for (int b = 0; b < BATCH; ++b) GB[(size_t)(b * LX + 48 + mj) * 16 + lane] = val; }
        }
    }
    __syncthreads();
    bf16* BTIN = (bf16*)(F.ws + WS_BTIN); bf16* BTOUT = (bf16*)(F.ws + WS_BTOUT);
    LAS float* scr = (LAS float*)(F.lds + 65536 + F.wave * 8448);
    constexpr int NB_TOT = 96 + 32 + 32 + 32 + 32;
    for (int it = gw; it < NB_TOT * 16; it += NGW) {
        const int kb = it & 15; int nb = it >> 4;
        if (nb < 96) { transpose_item(F.w_in, PROJ, 1024 + 32 * nb, BTIN, D, 32 * nb, 64 * kb, scr, lane); continue; } nb -= 96;
        if (nb < 32) { transpose_item(F.w_in, PROJ, 4096 + 32 * nb, BTIN, D, 4096 + 32 * nb, 64 * kb, scr, lane); continue; } nb -= 32;
        if (nb < 32) { transpose_item(F.w_in, PROJ, 5136 + 32 * nb, BTIN, D, 5120 + 32 * nb, 64 * kb, scr, lane); continue; } nb -= 32;
        if (nb < 32) { transpose_item(F.w_in, PROJ, 6160 + 32 * nb, BTIN, D, 6144 + 32 * nb, 64 * kb, scr, lane); continue; } nb -= 32;
        transpose_item(F.w_out, D, 32 * nb, BTOUT, D, 32 * nb, 64 * kb, scr, lane);
    }
    for (int tile = gw; tile < 4 * 64 * 16; tile += NGW) {
        const int g = tile >> 10, kt = (tile >> 4) & 63, ntl = tile & 15;
        const int m = lane & 15, q = lane >> 4;
        const float* arow = F.w_in + (size_t)(16 * kt + m) * PROJ + 256 * g + 8 * q;
        const float* bcol = F.pool_w + (size_t)g * 65536 + (size_t)(8 * q) * 256 + 16 * ntl + m;
        f32x4 acc = {0.f, 0.f, 0.f, 0.f};
#pragma unroll 2
        for (int s = 0; s < 8; ++s) {
            const f32x4 a0 = *(const f32x4*)(arow + 32 * s), a1 = *(const f32x4*)(arow + 32 * s + 4);
            float bv[8];
#pragma unroll
            for (int j = 0; j < 8; ++j) bv[j] = bcol[(size_t)(32 * s + j) * 256];
            v4u ap, bp; ap.x = pk2(a0.x, a0.y); ap.y = pk2(a0.z, a0.w); ap.z = pk2(a1.x, a1.y); ap.w = pk2(a1.z, a1.w);
            bp.x = pk2(bv[0], bv[1]); bp.y = pk2(bv[2], bv[3]); bp.z = pk2(bv[4], bv[5]); bp.w = pk2(bv[6], bv[7]);
            acc = MFMA16(__builtin_bit_cast(bf16x8, ap), __builtin_bit_cast(bf16x8, bp), acc);
        }
        v2u o; o.x = pk2(acc[0], acc[1]); o.y = pk2(acc[2], acc[3]);
        *(GAS v2u*)(BTIN + (size_t)(3072 + 256 * g + 16 * ntl + m) * D + 16 * kt + 4 * q) = o;
    }
}

typedef pg8::f32x4 (&AccRef)[2][2][4][2];
struct EpiQKV {
    static constexpr bool PERM = true;
    bf16* QKV; bf16* HALO;
    __device__ __forceinline__ void operator()(const pg8::f32x4 (&acc)[2][2][4][2], const pg8::Unit& u, int wr, int wc, int fr, int fq) const {
        const int col0 = u.pn * 256 + wc * 32 + 8 * fq;
#pragma unroll
        for (int ai = 0; ai < 2; ++ai)
#pragma unroll
            for (int m = 0; m < 4; ++m) {
                const int r = u.pm * 256 + ai * 128 + wr * 64 + m * 16 + fr; const int b = r >> 11, xin = 64 + (r & 2047);
                bf16* rowp = QKV + (size_t)(b * LX + xin) * 3072 + col0;
                const bool halo = (m == 3) && (fr >= 13) && ((xin >> 6) + 1 <= 32);
                bf16* hp = HALO + ((size_t)((b * NCH + (xin >> 6) + 1) * 3 + (fr - 13))) * 3072 + col0;
#pragma unroll
                for (int bj = 0; bj < 2; ++bj) { const pg8::f32x4 v0 = acc[ai][bj][m][0], v1 = acc[ai][bj][m][1];
                    v4u w; w.x = pk2(v0[0], v0[1]); w.y = pk2(v0[2], v0[3]); w.z = pk2(v1[0], v1[1]); w.w = pk2(v1[2], v1[3]);
                    *(v4u*)(rowp + bj * 128) = w; if (halo) *(v4u*)(hp + bj * 128) = w; } }
    }
};
struct EpiPZG {
    static constexpr bool PERM = true;
    bf16 *PM, *ZS, *GP, *GD;
    __device__ __forceinline__ void operator()(const pg8::f32x4 (&acc)[2][2][4][2], const pg8::Unit& u, int wr, int wc, int fr, int fq) const {
        const int kind = u.pn >> 2, col0 = (u.pn & 3) * 256 + wc * 32 + 8 * fq;
        bf16* base = kind == 0 ? PM : (kind == 1 ? ZS : (kind == 2 ? GP : GD));
#pragma unroll
        for (int ai = 0; ai < 2; ++ai)
#pragma unroll
            for (int m = 0; m < 4; ++m) {
                const int r = u.pm * 256 + ai * 128 + wr * 64 + m * 16 + fr; const int orow = kind == 0 ? xrow_of(r) : r;
                bf16* rowp = base + (size_t)orow * D + col0;
#pragma unroll
                for (int bj = 0; bj < 2; ++bj) { pg8::f32x4 v0 = acc[ai][bj][m][0], v1 = acc[ai][bj][m][1];
                    if (kind == 1) {
#pragma unroll
                        for (int e = 0; e < 4; ++e) { v0[e] = siluf_(v0[e]); v1[e] = siluf_(v1[e]); } }
                    else if (kind >= 2) {
#pragma unroll
                        for (int e = 0; e < 4; ++e) { v0[e] = sigmoidf_(v0[e]); v1[e] = sigmoidf_(v1[e]); } }
                    v4u w; w.x = pk2(v0[0], v0[1]); w.y = pk2(v0[2], v0[3]); w.z = pk2(v1[0], v1[1]); w.w = pk2(v1[2], v1[3]);
                    *(v4u*)(rowp + bj * 128) = w; } }
    }
};
struct EpiOut {
    static constexpr bool PERM = false;
    const float* X; float* H1;
    __device__ __forceinline__ void operator()(const pg8::f32x4 (&acc)[2][2][4][2], const pg8::Unit& u, int wr, int wc, int fr, int fq) const {
        const int row0 = u.pm * 256 + wr * 64 + fr, col0 = u.pn * 256 + wc * 32 + 4 * fq;
#pragma unroll
        for (int ai = 0; ai < 2; ++ai)
#pragma unroll
            for (int m = 0; m < 4; ++m) { const size_t off = (size_t)(row0 + ai * 128 + m * 16) * D + col0;
#pragma unroll
                for (int bj = 0; bj < 2; ++bj)
#pragma unroll
                    for (int n = 0; n < 2; ++n) { const pg8::f32x4 xv = *(const pg8::f32x4*)(X + off + bj * 128 + n * 16); *(pg8::f32x4*)(H1 + off + bj * 128 + n * 16) = acc[ai][bj][m][n] + xv; } }
    }
};
struct EpiGU {
    static constexpr bool PERM = true;
    bf16* HDN; const float* ROWS;
    __device__ __forceinline__ void operator()(const pg8::f32x4 (&acc)[2][2][4][2], const pg8::Unit& u, int wr, int wc, int fr, int fq) const {
        const int f0 = (u.pn & 3) * 128 + wc * 16 + 4 * fq;
#pragma unroll
        for (int ai = 0; ai < 2; ++ai)
#pragma unroll
            for (int m = 0; m < 4; ++m) { const int pos = u.pm * 256 + ai * 128 + wr * 64 + m * 16 + fr; const float rs = ROWS[pos];
#pragma unroll
                for (int bj = 0; bj < 2; ++bj) { const pg8::f32x4 gt = acc[ai][bj][m][0] * rs, up = acc[ai][bj][m][1] * rs;
                    v2u w; w.x = pk2(siluf_(gt[0]) * up[0], siluf_(gt[1]) * up[1]); w.y = pk2(siluf_(gt[2]) * up[2], siluf_(gt[3]) * up[3]);
                    *(v2u*)(HDN + (size_t)pos * FF + f0 + bj * 64) = w; } }
    }
};
struct EpiDown {
    static constexpr bool PERM = true;
    bf16* Y; const float* ROWW;
    __device__ __forceinline__ void operator()(const pg8::f32x4 (&acc)[2][2][4][2], const pg8::Unit& u, int wr, int wc, int fr, int fq) const {
        const int col0 = (u.pn & 3) * 256 + wc * 32 + 8 * fq;
#pragma unroll
        for (int ai = 0; ai < 2; ++ai)
#pragma unroll
            for (int m = 0; m < 4; ++m) { const int pos = u.pm * 256 + ai * 128 + wr * 64 + m * 16 + fr; const float cw = ROWW[pos];
#pragma unroll
                for (int bj = 0; bj < 2; ++bj) { const pg8::f32x4 v0 = acc[ai][bj][m][0] * cw, v1 = acc[ai][bj][m][1] * cw;
                    v4u w; w.x = pk2(v0[0], v0[1]); w.y = pk2(v0[2], v0[3]); w.z = pk2(v1[0], v1[1]); w.w = pk2(v1[2], v1[3]);
                    *(v4u*)(Y + (size_t)pos * D + col0 + bj * 128) = w; } }
    }
};
struct MoeOrder {
    int ntiles, G, c; const int* tile_e; const LAS int* idx;
    __device__ __forceinline__ bool next(int i, pg8::Unit& u) const {
        const int L = i * G + c; if (L >= 4 * ntiles) return false;
        u.pm = L >> 2; u.pn = tile_e[L >> 2] * 4 + (L & 3); return true;
    }
    __device__ __forceinline__ int gather_row(const pg8::Unit& u, int r) const { const int i = (u.pm * 4 + (u.pn & 3) - c) / G; return idx[i * 256 + r]; }
};

__device__ __forceinline__ void meta_rows_job(Frame& F, const bf16* BT, int ncols, bf16* OUTX, int ld, bf16* HALO) {
    const bf16* UM = (const bf16*)(F.ws + WS_UMETA);
    const int lane = F.lane, m = lane & 15, q = lane >> 4;
    for (int tile = F.vcu * NWAVES + F.wave; tile < ncols / 16; tile += F.G * NWAVES) {
        const bf16* ap = UM + (size_t)m * D + 8 * q; const bf16* bp = BT + (size_t)(16 * tile + m) * D + 8 * q;
        f32x4 acc = {0.f, 0.f, 0.f, 0.f};
#pragma unroll 4
        for (int s = 0; s < 32; ++s) acc = MFMA16(*(const bf16x8*)(ap + 32 * s), *(const bf16x8*)(bp + 32 * s), acc);
#pragma unroll
        for (int i = 0; i < 4; ++i) { const int j = 4 * q + i; const bf16 v = f2bf(acc[i]);
#pragma unroll
            for (int b = 0; b < BATCH; ++b) { OUTX[(size_t)(b * LX + 48 + j) * ld + 16 * tile + m] = v;
                if (HALO && j >= 13) HALO[((size_t)((b * NCH + 1) * 3 + (j - 13))) * 3072 + 16 * tile + m] = v; } }
    }
}

constexpr int P2_KN = 0, P2_QN = 17408, P2_KBT = 34816, P2_VBT = 53248, P2_KDT = 71680, P2_QDI = 90112, P2_AM = 107520, P2_TM = 124928, P2_QKM = 134144, P2_SC = 143360, P2_AB21 = 144640;
constexpr int RS = 272, TS = 144;
__device__ __forceinline__ size_t inplace_off(int xr0, int mat, int h, int f, int lane) {
    return ((size_t)(xr0 + 4 * f + (lane >> 4)) * 3072 + mat * 1024 + h * 128) * 2 + (lane & 15) * 16;
}
__device__ __forceinline__ void p2_chunk_local(Frame& F) {
    LAS unsigned char* L = F.lds; const int wave = F.wave;
    LAS float* SC = (LAS float*)(L + P2_SC);
    unsigned char* QKV = F.ws + WS_QKV; const bf16* HALO = (const bf16*)(F.ws + WS_HALO); const float* GB = (const float*)(F.ws + WS_GB);
    unsigned char* CLX = F.ws + WS_CLX; float* CD = (float*)(F.ws + WS_CD);
    v4u raww[11]; f32x4 cwq[8]; float gq = 0.f, beq = 0.f; float val[8][8];
#define P2_PREFETCH(CID) do { const int c_ = (CID) % NCH, bh_ = (CID) / NCH, h_ = bh_ & 7, b_ = bh_ >> 3, xr_ = b_ * LX + 64 * c_; \
        const int tid_ = F.tid, lane_ = tid_ & 63, grp_ = tid_ >> 4, mat_ = grp_ >> 3, rg_ = grp_ & 7, cg_ = lane_ & 15, ch_ = mat_ * 1024 + h_ * 128 + 8 * cg_; \
        if (tid_ < 384) { _Pragma("unroll") for (int i = 0; i < 11; ++i) { const int li = 8 * rg_ - 3 + i; v4u w = {0u, 0u, 0u, 0u}; \
            if (li < 0) { if (c_ > 0) w = *(const v4u*)(HALO + ((size_t)((b_ * NCH + c_) * 3 + (li + 3))) * 3072 + ch_); } \
            else if (!(c_ == 0 && li < 48)) w = *(const v4u*)(QKV + ((size_t)(xr_ + li) * 3072 + ch_) * 2); \
            raww[i] = w; } \
            _Pragma("unroll") for (int kk = 0; kk < 4; ++kk) { cwq[2 * kk] = *(const f32x4*)(F.conv_w + (size_t)kk * 3072 + ch_); cwq[2 * kk + 1] = *(const f32x4*)(F.conv_w + (size_t)kk * 3072 + ch_ + 4); } } \
        if (tid_ < 64) { const bool nul_ = (c_ == 0) && (lane_ < 48); gq = nul_ ? 0.f : GB[(size_t)(xr_ + lane_) * 16 + h_]; beq = nul_ ? 0.f : GB[(size_t)(xr_ + lane_) * 16 + 8 + h_]; } } while (0)
#define P2_KILL() do { _Pragma("unroll") for (int i = 0; i < 11; ++i) raww[i] = (v4u){0u, 0u, 0u, 0u}; _Pragma("unroll") for (int i = 0; i < 8; ++i) { cwq[i] = (f32x4){0.f, 0.f, 0.f, 0.f}; _Pragma("unroll") for (int e = 0; e < 8; ++e) val[i][e] = 0.f; } } while (0)
#define RAWV(i, e) (((e) & 1) ? bfhi(raww[i][(e) >> 1]) : bflo(raww[i][(e) >> 1]))
#define CWV(kk, e) (cwq[2 * (kk) + ((e) >> 2)][(e) & 3])
#define P2_S0S1(CID, TID) do { const int lane_ = (TID) & 63; \
        if (wave == 0) { float gam = gq; \
            _Pragma("unroll") for (int o = 1; o < 64; o <<= 1) { const float t = __shfl_up(gam, o); if (lane_ >= o) gam += t; } \
            const float gl = __shfl(gam, 63); \
            SC[lane_] = gam; SC[64 + lane_] = beq; const float eg = __expf(gam); SC[128 + lane_] = eg; SC[192 + lane_] = __expf(gl - gam); SC[256 + lane_] = beq * eg; \
            if (lane_ == 0) CD[(CID)] = __expf(gl); } \
        if ((TID) < 384) { const int mat_ = (TID) >> 7; \
            _Pragma("unroll") for (int i = 0; i < 8; ++i) { float ss = 0.f; \
                _Pragma("unroll") for (int e = 0; e < 8; ++e) { const float cv = CWV(0, e) * RAWV(i, e) + CWV(1, e) * RAWV(i + 1, e) + CWV(2, e) * RAWV(i + 2, e) + CWV(3, e) * RAWV(i + 3, e); \
                    const float sv = cv * __builtin_amdgcn_rcpf(1.f + __expf(-cv)); val[i][e] = sv; ss += sv * sv; } \
                if (mat_ < 2) { ss += __shfl_xor(ss, 1); ss += __shfl_xor(ss, 2); ss += __shfl_xor(ss, 4); ss += __shfl_xor(ss, 8); \
                    const float inv = __builtin_amdgcn_rsqf(ss + EPS) * (mat_ == 0 ? 0.08838834764831845f : 1.f); \
                    _Pragma("unroll") for (int e = 0; e < 8; ++e) val[i][e] *= inv; } } } } while (0)
    if (F.vcu < NCHUNKS) { P2_PREFETCH(F.vcu); P2_S0S1(F.vcu, F.tid); if (F.vcu + F.G < NCHUNKS) P2_PREFETCH(F.vcu + F.G); }
    __syncthreads();
    for (int cid = F.vcu; cid < NCHUNKS; cid += F.G) {
        const int c = cid % NCH, bh = cid / NCH, h = bh & 7, b = bh >> 3, xr0 = b * LX + 64 * c;
        int tid = F.tid; asm volatile("" : "+v"(tid)); const int lane = tid & 63;
        const int grp = tid >> 4, mat = grp >> 3, rg = grp & 7, cg = lane & 15;
        if (tid < 384) {
            if (mat == 0) {
#pragma unroll
                for (int i = 0; i < 8; ++i) { const int t = 8 * rg + i; const float eg = SC[128 + t];
                    v4u w; w.x = pk2(val[i][0], val[i][1]); w.y = pk2(val[i][2], val[i][3]); w.z = pk2(val[i][4], val[i][5]); w.w = pk2(val[i][6], val[i][7]);
                    *(LAS v4u*)(L + P2_QN + t * RS + cg * 16) = w;
                    w.x = pk2(val[i][0] * eg, val[i][1] * eg); w.y = pk2(val[i][2] * eg, val[i][3] * eg); w.z = pk2(val[i][4] * eg, val[i][5] * eg); w.w = pk2(val[i][6] * eg, val[i][7] * eg);
                    *(LAS v4u*)(L + P2_QDI + t * RS + cg * 16) = w; }
            } else if (mat == 1) {
                float beg[8], egl[8];
#pragma unroll
                for (int i = 0; i < 8; ++i) { beg[i] = SC[256 + 8 * rg + i]; egl[i] = SC[192 + 8 * rg + i]; }
#pragma unroll
                for (int i = 0; i < 8; ++i) { const int t = 8 * rg + i;
                    v4u w; w.x = pk2(val[i][0], val[i][1]); w.y = pk2(val[i][2], val[i][3]); w.z = pk2(val[i][4], val[i][5]); w.w = pk2(val[i][6], val[i][7]);
                    *(LAS v4u*)(L + P2_KN + t * RS + cg * 16) = w; }
#pragma unroll
                for (int e = 0; e < 8; ++e) { const int k = 8 * cg + e;
                    v4u w; w.x = pk2(val[0][e] * beg[0], val[1][e] * beg[1]); w.y = pk2(val[2][e] * beg[2], val[3][e] * beg[3]); w.z = pk2(val[4][e] * beg[4], val[5][e] * beg[5]); w.w = pk2(val[6][e] * beg[6], val[7][e] * beg[7]);
                    *(LAS v4u*)(L + P2_KBT + k * TS + ((rg ^ (cg & 7)) * 16)) = w;
                    w.x = pk2(val[0][e] * egl[0], val[1][e] * egl[1]); w.y = pk2(val[2][e] * egl[2], val[3][e] * egl[3]); w.z = pk2(val[4][e] * egl[4], val[5][e] * egl[5]); w.w = pk2(val[6][e] * egl[6], val[7][e] * egl[7]);
                    *(LAS v4u*)(L + P2_KDT + k * TS + ((rg ^ (cg & 7)) * 16)) = w; }
            } else {
                float be[8];
#pragma unroll
                for (int i = 0; i < 8; ++i) be[i] = SC[64 + 8 * rg + i];
#pragma unroll
                for (int e = 0; e < 8; ++e) { const int k = 8 * cg + e;
                    v4u w; w.x = pk2(val[0][e] * be[0], val[1][e] * be[1]); w.y = pk2(val[2][e] * be[2], val[3][e] * be[3]); w.z = pk2(val[4][e] * be[4], val[5][e] * be[5]); w.w = pk2(val[6][e] * be[6], val[7][e] * be[7]);
                    *(LAS v4u*)(L + P2_VBT + k * TS + ((rg ^ (cg & 7)) * 16)) = w; }
            }
        }
        __syncthreads();
        {
            const int mq = wave >> 2, tm = (wave >> 1) & 1, tn = wave & 1, r = lane & 31, hh = lane >> 5;
            f32x16 acc; for (int i = 0; i < 16; ++i) acc[i] = 0.f;
            if (tm >= tn) {
                LAS unsigned char* ab = L + (mq ? P2_QN : P2_KN) + (32 * tm + r) * RS + hh * 16; LAS unsigned char* bb = L + P2_KN + (32 * tn + r) * RS + hh * 16;
#pragma unroll
                for (int s = 0; s < 8; ++s) acc = MFMA32(*(const LAS bf16x8*)(ab + 32 * s), *(const LAS bf16x8*)(bb + 32 * s), acc);
            }
            const int tc = 32 * tn + r; const float gc = SC[tc];
#pragma unroll
            for (int i = 0; i < 16; ++i) { const int t = 32 * tm + crow(i, hh); const float dec = __expf(SC[t] - gc);
                if (mq == 0) { const float av = (t > tc) ? SC[64 + t] * acc[i] * dec : 0.f; *(LAS float*)(L + P2_AM + t * RS + tc * 4) = av;
                    if (tm == 1 && tn == 0) *(LAS bf16*)(L + P2_AB21 + (t - 32) * 80 + tc * 2) = f2bf(av); }
                else *(LAS bf16*)(L + P2_QKM + t * TS + tc * 2) = f2bf((t >= tc) ? acc[i] * dec : 0.f); }
        }
        __syncthreads();
        if (wave == 7) {
            const int half = lane >> 5, cb = lane & 31;
            float X[32];
#pragma unroll
            for (int i = 0; i < 32; ++i) X[i] = 0.f;
            const LAS unsigned char* am = L + P2_AM + (32 * half) * RS + (32 * half) * 4;
            f32x4 cu[8]; float cdg = *(const LAS float*)(am + 1 * RS + cb * 4);
            cu[0] = *(const LAS f32x4*)(am + 1 * RS);
#pragma unroll
            for (int i = 1; i < 32; ++i) {
                f32x4 nx[8]; float ndg = 0.f;
                if (i + 1 < 32) {
#pragma unroll
                    for (int j4 = 0; j4 < (i + 4) / 4; ++j4) nx[j4] = *(const LAS f32x4*)(am + (i + 1) * RS + j4 * 16);
                    ndg = *(const LAS float*)(am + (i + 1) * RS + cb * 4);
                }
                __builtin_amdgcn_sched_barrier(0);
                float a0 = -cdg, a1 = 0.f, a2 = 0.f, a3 = 0.f;
#pragma unroll
                for (int j4 = 0; j4 < (i + 3) / 4; ++j4) { a0 -= cu[j4].x * X[4 * j4]; a1 -= cu[j4].y * X[4 * j4 + 1]; a2 -= cu[j4].z * X[4 * j4 + 2]; a3 -= cu[j4].w * X[4 * j4 + 3]; }
                X[i] = (a0 + a1) + (a2 + a3);
                __builtin_amdgcn_sched_barrier(0);
                if (i + 1 < 32) {
#pragma unroll
                    for (int j4 = 0; j4 < (i + 4) / 4; ++j4) cu[j4] = nx[j4];
                    cdg = ndg;
                }
            }
            LAS unsigned char* tm = L + P2_TM;
#pragma unroll
            for (int i = 0; i < 32; ++i) *(LAS bf16*)(tm + (32 * half + i) * TS + lane * 2) = f2bf(X[i]);
            if (half == 0) {
#pragma unroll
                for (int i = 0; i < 32; ++i) *(LAS bf16*)(tm + i * TS + (32 + cb) * 2) = (bf16)0;
            }
            LDS_WAIT(); asm volatile("" ::: "memory");
            *(LAS bf16*)(tm + lane * TS + lane * 2) = (bf16)0x3F80;
            LDS_WAIT(); asm volatile("" ::: "memory");
            {
                const int r = cb, hh = half;
                f32x16 M; for (int i = 0; i < 16; ++i) M[i] = 0.f;
#pragma unroll
                for (int s2 = 0; s2 < 2; ++s2) {
                    const bf16x8 a = *(const LAS bf16x8*)(L + P2_AB21 + r * 80 + (16 * s2 + 8 * hh) * 2);
                    unsigned short e[8];
#pragma unroll
                    for (int j = 0; j < 8; ++j) e[j] = *(const LAS bf16*)(tm + (16 * s2 + 8 * hh + j) * TS + r * 2);
                    v4u bw; bw.x = e[0] | ((unsigned)e[1] << 16); bw.y = e[2] | ((unsigned)e[3] << 16); bw.z = e[4] | ((unsigned)e[5] << 16); bw.w = e[6] | ((unsigned)e[7] << 16);
                    M = MFMA32(a, __builtin_bit_cast(bf16x8, bw), M);
                }
                f32x16 T21; for (int i = 0; i < 16; ++i) T21[i] = 0.f;
#pragma unroll
                for (int s2 = 0; s2 < 2; ++s2) {
                    const LAS unsigned char* src = tm + (32 + r) * TS + (32 + 16 * s2 + 4 * hh) * 2;
                    const v2u lo = *(const LAS v2u*)src, hi = *(const LAS v2u*)(src + 16);
                    v4u aw; aw.x = lo.x; aw.y = lo.y; aw.z = hi.x; aw.w = hi.y;
                    T21 = MFMA32(__builtin_bit_cast(bf16x8, aw), pack_step(M, s2), T21);
                }
#pragma unroll
                for (int i = 0; i < 16; ++i) *(LAS bf16*)(tm + (32 + crow(i, hh)) * TS + r * 2) = f2bf(-T21[i]);
            }
            P2_KILL();
        } else if (wave == 6) {
            const int r = lane & 31, hh = lane >> 5;
            for (int f = 0; f < 40; ++f) {
                LAS unsigned char* src; LAS unsigned char* src_hi = nullptr; unsigned char* dst;
                if (f < 16)      { src = L + P2_QDI + (32 * (f >> 3) + r) * RS + (16 * (f & 7) + 4 * hh) * 2; dst = QKV + inplace_off(xr0, 0, h, f, lane); }
                else if (f < 32) { const int g = f - 16, k = 32 * (g >> 2) + r, sw = (k >> 3) & 7; src = L + P2_KDT + k * TS + (((2 * (g & 3)) ^ sw) * 16) + 8 * hh; src_hi = L + P2_KDT + k * TS + (((2 * (g & 3) + 1) ^ sw) * 16) + 8 * hh; dst = QKV + inplace_off(xr0, 1, h, g, lane); }
                else             { const int g = f - 32; src = L + P2_QKM + (32 * (g >> 2) + r) * TS + (16 * (g & 3) + 4 * hh) * 2; dst = CLX + (size_t)cid * 24576 + 16384 + g * 1024 + lane * 16; }
                if (!(f >= 16 && f < 32)) src_hi = src + 16;
                const v2u lo = *(const LAS v2u*)src, hi = *(const LAS v2u*)src_hi;
                v4u w; w.x = lo.x; w.y = lo.y; w.z = hi.x; w.w = hi.y;
                *(v4u*)dst = w;
            }
            P2_KILL();
        } else if (cid + F.G < NCHUNKS) {
            P2_S0S1(cid + F.G, tid);
            if (cid + 2 * F.G < NCHUNKS) P2_PREFETCH(cid + 2 * F.G);
        }
        __syncthreads();
        f32x16 accW, accU;
        {
            const int tm = wave >> 2, tn = wave & 3, r = lane & 31, hh = lane >> 5;
            for (int i = 0; i < 16; ++i) { accW[i] = 0.f; accU[i] = 0.f; }
            LAS unsigned char* ab = L + P2_TM + (32 * tm + r) * TS + hh * 16; const int kr = 32 * tn + r, sw = (kr >> 3) & 7; LAS unsigned char* bk = L + P2_KBT + kr * TS; LAS unsigned char* bv = L + P2_VBT + kr * TS;
#pragma unroll
            for (int s = 0; s < 4; ++s) { const bf16x8 a = *(const LAS bf16x8*)(ab + 32 * s); const int co = ((2 * s + hh) ^ sw) * 16;
                accW = MFMA32(a, *(const LAS bf16x8*)(bk + co), accW); accU = MFMA32(a, *(const LAS bf16x8*)(bv + co), accU); }
        }
        __syncthreads();
        {
            const int tm = wave >> 2, tn = wave & 3, r = lane & 31, hh = lane >> 5;
#pragma unroll
            for (int i = 0; i < 16; ++i) { const int t = 32 * tm + crow(i, hh), n = 32 * tn + r;
                *(LAS bf16*)(L + P2_KBT + t * RS + n * 2) = f2bf(-accW[i]); *(LAS bf16*)(L + P2_VBT + t * RS + n * 2) = f2bf(accU[i]); }
        }
        __syncthreads();
        {
            const int r = lane & 31, hh = lane >> 5;
            for (int f = wave; f < 32; f += 8) {
                if (f < 16) {
                    LAS unsigned char* src = L + P2_KBT + (32 * (f >> 3) + r) * RS + (16 * (f & 7) + 4 * hh) * 2;
                    const v2u lo = *(const LAS v2u*)src, hi = *(const LAS v2u*)(src + 16);
                    v4u w; w.x = lo.x; w.y = lo.y; w.z = hi.x; w.w = hi.y;
                    *(v4u*)(CLX + (size_t)cid * 24576 + f * 1024 + lane * 16) = w;
                } else {
                    const int g = f - 16, s = g >> 2, mt = (g >> 1) & 1, p = g & 1;
                    unsigned short v[8];
#pragma unroll
                    for (int e = 0; e < 8; ++e) { const int t = 32 * mt + crow(8 * p + e, hh); v[e] = *(const LAS bf16*)(L + P2_VBT + t * RS + (32 * s + r) * 2); }
                    v4u w; w.x = v[0] | ((unsigned)v[1] << 16); w.y = v[2] | ((unsigned)v[3] << 16); w.z = v[4] | ((unsigned)v[5] << 16); w.w = v[6] | ((unsigned)v[7] << 16);
                    *(v4u*)(QKV + inplace_off(xr0, 2, h, g, lane)) = w;
                }
            }
        }
        __syncthreads();
    }
}

constexpr int SC_BUF = 61440;
__device__ __forceinline__ void scan_issue(Frame& F, int b, int h, int s, int c, LAS unsigned char* buf) {
    const int lane = F.lane, cid = (b * NH + h) * NCH + c, xr0 = b * LX + 64 * c;
    const unsigned char* QKV = F.ws + WS_QKV; const unsigned char* clx = F.ws + WS_CLX + (size_t)cid * 24576 + lane * 16;
#pragma unroll
    for (int f = 0; f < 16; ++f) __builtin_amdgcn_global_load_lds((const unsigned*)(clx + f * 1024), (LAS unsigned*)(buf + f * 1024), 16, 0, 0);
#pragma unroll
    for (int f = 0; f < 16; ++f) __builtin_amdgcn_global_load_lds((const unsigned*)(QKV + inplace_off(xr0, 0, h, f, lane)), (LAS unsigned*)(buf + 16384 + f * 1024), 16, 0, 0);
#pragma unroll
    for (int f = 0; f < 16; ++f) __builtin_amdgcn_global_load_lds((const unsigned*)(QKV + inplace_off(xr0, 1, h, f, lane)), (LAS unsigned*)(buf + 32768 + f * 1024), 16, 0, 0);
#pragma unroll
    for (int f = 0; f < 8; ++f) __builtin_amdgcn_global_load_lds((const unsigned*)(clx + 16384 + f * 1024), (LAS unsigned*)(buf + 49152 + f * 1024), 16, 0, 0);
#pragma unroll
    for (int f = 0; f < 4; ++f) __builtin_amdgcn_global_load_lds((const unsigned*)(QKV + inplace_off(xr0, 2, h, 4 * s + f, lane)), (LAS unsigned*)(buf + 57344 + f * 1024), 16, 0, 0);
}
#define DSR(dst, base, off) asm volatile("ds_read_b128 %0, %1" : "=v"(dst) : "v"((unsigned)(size_t)(base) + (unsigned)(off)))
#define LWAIT4(n, g) asm volatile("s_waitcnt lgkmcnt(" #n ")" : "+v"(g[0]), "+v"(g[1]), "+v"(g[2]), "+v"(g[3]))
#define LWAIT6(n, g) asm volatile("s_waitcnt lgkmcnt(" #n ")" : "+v"(g[0]), "+v"(g[1]), "+v"(g[2]), "+v"(g[3]), "+v"(g[4]), "+v"(g[5]))
#define BF8(x) __builtin_bit_cast(bf16x8, x)
__device__ __forceinline__ void p3_scan(Frame& F) {
    if (F.wave != 0) return;
    const int lane = F.lane, r = lane & 31, hh = lane >> 5;
    const float* CD = (const float*)(F.ws + WS_CD); bf16* O = (bf16*)(F.ws + WS_O);
    for (int task = F.vcu; task < BATCH * NH * 4; task += F.G) {
        const int s = task & 3, bh = task >> 2, h = bh & 7, b = bh >> 3;
        f32x16 S[4];
#pragma unroll
        for (int kt = 0; kt < 4; ++kt) for (int i = 0; i < 16; ++i) S[kt][i] = 0.f;
        const float cdv = (lane < NCH) ? CD[(b * NH + h) * NCH + lane] : 0.f;
        scan_issue(F, b, h, s, 0, F.lds);
        for (int c = 0; c < NCH; ++c) {
            LAS unsigned char* buf = F.lds + (c & 1) * SC_BUF;
            VM_WAIT();
            if (c + 1 < NCH) scan_issue(F, b, h, s, c + 1, F.lds + ((c + 1) & 1) * SC_BUF);
            const float cd = __builtin_bit_cast(float, __builtin_amdgcn_readlane(__builtin_bit_cast(int, cdv), c));
            const LAS unsigned char* fb = buf + lane * 16;
            v4u G[3][6];
#define ISSUE1(ks, g) do { DSR(G[g][0], fb, (0 * 8 + (ks)) * 1024); DSR(G[g][1], fb, (1 * 8 + (ks)) * 1024); DSR(G[g][2], fb, 16384 + (0 * 8 + (ks)) * 1024); DSR(G[g][3], fb, 16384 + (1 * 8 + (ks)) * 1024); } while (0)
            ISSUE1(0, 0); ISSUE1(1, 1);
            f32x16 aV[2], aO[2];
#pragma unroll
            for (int mt = 0; mt < 2; ++mt) {
                const v4u u0 = *(const LAS v4u*)(fb + 57344 + (2 * mt) * 1024), u1 = *(const LAS v4u*)(fb + 57344 + (2 * mt + 1) * 1024);
                aV[mt][0] = bflo(u0.x); aV[mt][1] = bfhi(u0.x); aV[mt][2] = bflo(u0.y); aV[mt][3] = bfhi(u0.y); aV[mt][4] = bflo(u0.z); aV[mt][5] = bfhi(u0.z); aV[mt][6] = bflo(u0.w); aV[mt][7] = bfhi(u0.w);
                aV[mt][8] = bflo(u1.x); aV[mt][9] = bfhi(u1.x); aV[mt][10] = bflo(u1.y); aV[mt][11] = bfhi(u1.y); aV[mt][12] = bflo(u1.z); aV[mt][13] = bfhi(u1.z); aV[mt][14] = bflo(u1.w); aV[mt][15] = bfhi(u1.w);
                for (int i = 0; i < 16; ++i) aO[mt][i] = 0.f;
            }
            LDS_WAIT();
#pragma unroll
            for (int ks = 0; ks < 8; ++ks) {
                const int g = ks % 3;
                if (ks + 2 < 8) { ISSUE1(ks + 2, (ks + 2) % 3); LWAIT4(8, G[g]); }
                else if (ks + 1 < 8) { LWAIT4(4, G[g]); }
                else { LWAIT4(0, G[g]); }
                const bf16x8 sb = pack_step(S[ks >> 1], ks & 1);
                aV[0] = MFMA32(BF8(G[g][0]), sb, aV[0]); aV[1] = MFMA32(BF8(G[g][1]), sb, aV[1]);
                aO[0] = MFMA32(BF8(G[g][2]), sb, aO[0]); aO[1] = MFMA32(BF8(G[g][3]), sb, aO[1]);
            }
#define ISSUE2(ts, g) do { DSR(G[g][0], fb, 32768 + (0 * 4 + (ts)) * 1024); DSR(G[g][1], fb, 32768 + (1 * 4 + (ts)) * 1024); DSR(G[g][2], fb, 32768 + (2 * 4 + (ts)) * 1024); DSR(G[g][3], fb, 32768 + (3 * 4 + (ts)) * 1024); \
                               DSR(G[g][4], fb, 49152 + (0 * 4 + (ts)) * 1024); DSR(G[g][5], fb, 49152 + (1 * 4 + (ts)) * 1024); } while (0)
            ISSUE2(0, 2);
            bf16x8 Vb[2][2];
#pragma unroll
            for (int mt = 0; mt < 2; ++mt) { Vb[mt][0] = pack_step(aV[mt], 0); Vb[mt][1] = pack_step(aV[mt], 1); }
#pragma unroll
            for (int kt = 0; kt < 4; ++kt) S[kt] = S[kt] * cd;
#pragma unroll
            for (int ts = 0; ts < 4; ++ts) {
                const int g = (ts + 2) % 3;
                if (ts + 1 < 4) { ISSUE2(ts + 1, (ts + 3) % 3); LWAIT6(6, G[g]); }
                else { LWAIT6(0, G[g]); }
#pragma unroll
                for (int kt = 0; kt < 4; ++kt) S[kt] = MFMA32(BF8(G[g][kt]), Vb[ts >> 1][ts & 1], S[kt]);
                aO[0] = MFMA32(BF8(G[g][4]), Vb[ts >> 1][ts & 1], aO[0]); aO[1] = MFMA32(BF8(G[g][5]), Vb[ts >> 1][ts & 1], aO[1]);
            }
#undef ISSUE1
#undef ISSUE2
            if (c > 0) {
                bf16* orow = O + (size_t)(b * SEQ + 64 * (c - 1)) * D + h * HD + 32 * s + r;
#pragma unroll
                for (int mt = 0; mt < 2; ++mt)
#pragma unroll
                    for (int i = 0; i < 16; ++i) orow[(size_t)(32 * mt + crow(i, hh)) * D] = f2bf(aO[mt][i]);
            }
        }
        VM_WAIT();
    }
}

__device__ __forceinline__ void load16(const bf16* p, float (&v)[16]) {
    const v4u a = *(const v4u*)p, b = *(const v4u*)(p + 8);
    v[0] = bflo(a.x); v[1] = bfhi(a.x); v[2] = bflo(a.y); v[3] = bfhi(a.y); v[4] = bflo(a.z); v[5] = bfhi(a.z); v[6] = bflo(a.w); v[7] = bfhi(a.w);
    v[8] = bflo(b.x); v[9] = bfhi(b.x); v[10] = bflo(b.y); v[11] = bfhi(b.y); v[12] = bflo(b.z); v[13] = bfhi(b.z); v[14] = bflo(b.w); v[15] = bfhi(b.w);
}
__device__ __forceinline__ void p5_merge(Frame& F) {
    const int gw = F.vcu * NWAVES + F.wave, NGW = F.G * NWAVES, lane = F.lane;
    const bf16* O = (const bf16*)(F.ws + WS_O); const bf16* PM = (const bf16*)(F.ws + WS_PM); const bf16* ZS = (const bf16*)(F.ws + WS_ZS);
    const bf16* GP = (const bf16*)(F.ws + WS_GP); const bf16* GD = (const bf16*)(F.ws + WS_GD); bf16* MG = (bf16*)(F.ws + WS_MERGED);
    const int n0 = 16 * lane, win = 2 << (lane >> 4); const float rwin = 1.f / (float)win;
    float psc[16], dnw[16];
#pragma unroll
    for (int e = 0; e < 16; ++e) { psc[e] = F.pool_scale[n0 + e]; dnw[e] = F.dn_norm_w[(n0 + e) & 127]; }
    for (int r0 = gw * 8; r0 < MR; r0 += NGW * 8) {
        for (int rr = 0; rr < 8; ++rr) {
            const int r = r0 + rr, xr = xrow_of(r);
            float o[16], z[16], gp[16], gd[16], pm[16], sum[16];
            load16(O + (size_t)r * D + n0, o); load16(ZS + (size_t)r * D + n0, z); load16(GP + (size_t)r * D + n0, gp); load16(GD + (size_t)r * D + n0, gd);
            load16(PM + (size_t)xr * D + n0, pm);
#pragma unroll
            for (int e = 0; e < 16; ++e) sum[e] = pm[e];
            for (int j = 1; j < win; ++j) { float t[16]; load16(PM + (size_t)(xr - j) * D + n0, t);
#pragma unroll
                for (int e = 0; e < 16; ++e) sum[e] += t[e]; }
            float ss = 0.f;
#pragma unroll
            for (int e = 0; e < 16; ++e) ss += o[e] * o[e];
            ss += __shfl_xor(ss, 1); ss += __shfl_xor(ss, 2); ss += __shfl_xor(ss, 4);
            const float rstd = 1.f / sqrtf(ss * (1.f / HD) + EPS);
            float m[16];
#pragma unroll
            for (int e = 0; e < 16; ++e) m[e] = gp[e] * psc[e] * (sum[e] * rwin - pm[e]) + gd[e] * (o[e] * rstd * dnw[e]) * z[e];
            v4u w0, w1; w0.x = pk2(m[0], m[1]); w0.y = pk2(m[2], m[3]); w0.z = pk2(m[4], m[5]); w0.w = pk2(m[6], m[7]);
            w1.x = pk2(m[8], m[9]); w1.y = pk2(m[10], m[11]); w1.z = pk2(m[12], m[13]); w1.w = pk2(m[14], m[15]);
            *(v4u*)(MG + (size_t)r * D + n0) = w0; *(v4u*)(MG + (size_t)r * D + n0 + 8) = w1;
        }
    }
}

struct TokRec { int e0, e1, s0, s1; float w0, w1, rstd, pad; };
constexpr int P7_WS = 1032, P7_WH = 0, P7_WL = 74304, P7_LG = 148608, P7_CNT = 148608 + 4 * 2560;
__device__ __forceinline__ void p7_router(Frame& F) {
    LAS unsigned char* L = F.lds; const int tid = F.tid, lane = F.lane, wave = F.wave;
    for (int idx = tid; idx < 36 * D; idx += NWAVES * 64) {
        const int k = idx / 36, o = idx - k * 36;
        const float w = (o < 4 ? F.rg_w[k * 4 + o] : F.re_w[k * 32 + (o - 4)]) * F.norm_ffn_w[k];
        const unsigned short hi = f2bf(w); const unsigned short lo = f2bf(w - bf2f(hi));
        *(LAS bf16*)(L + P7_WH + (o * P7_WS + k) * 2) = hi; *(LAS bf16*)(L + P7_WL + (o * P7_WS + k) * 2) = lo;
    }
    LAS int* lcnt = (LAS int*)(L + P7_CNT);
    if (tid < 32) lcnt[tid] = 0;
    __syncthreads();
    const float* H1 = (const float*)(F.ws + WS_H1); bf16* XN = (bf16*)(F.ws + WS_XN); TokRec* TOK = (TokRec*)(F.ws + WS_TOK);
    if (wave < 4) {
        const int m = lane & 15, q = lane >> 4, row = 64 * F.vcu + 16 * wave + m;
        const float* hp = H1 + (size_t)row * D + 8 * q; const float* nwp = F.norm_ffn_w + 8 * q;
        f32x4 acc[3] = {{0.f, 0.f, 0.f, 0.f}, {0.f, 0.f, 0.f, 0.f}, {0.f, 0.f, 0.f, 0.f}};
        float ss = 0.f;
        const int orow[3] = {m, 16 + m, (32 + m) < 36 ? 32 + m : 35};
        for (int s = 0; s < 32; ++s) {
            const f32x4 a0 = *(const f32x4*)(hp + 32 * s), a1 = *(const f32x4*)(hp + 32 * s + 4);
            const f32x4 n0 = *(const f32x4*)(nwp + 32 * s), n1 = *(const f32x4*)(nwp + 32 * s + 4);
            const float x[8] = {a0.x, a0.y, a0.z, a0.w, a1.x, a1.y, a1.z, a1.w};
            v4u xh, xl; unsigned hh[4], ll[4];
#pragma unroll
            for (int j = 0; j < 4; ++j) { const unsigned ph = pk2(x[2 * j], x[2 * j + 1]); hh[j] = ph; ll[j] = pk2(x[2 * j] - bflo(ph), x[2 * j + 1] - bfhi(ph)); ss += x[2 * j] * x[2 * j] + x[2 * j + 1] * x[2 * j + 1]; }
            xh.x = hh[0]; xh.y = hh[1]; xh.z = hh[2]; xh.w = hh[3]; xl.x = ll[0]; xl.y = ll[1]; xl.z = ll[2]; xl.w = ll[3];
            v4u xo; xo.x = pk2(a0.x * n0.x, a0.y * n0.y); xo.y = pk2(a0.z * n0.z, a0.w * n0.w); xo.z = pk2(a1.x * n1.x, a1.y * n1.y); xo.w = pk2(a1.z * n1.z, a1.w * n1.w);
            *(v4u*)(XN + (size_t)row * D + 32 * s + 8 * q) = xo;
#pragma unroll
            for (int t = 0; t < 3; ++t) {
                const bf16x8 wh = *(const LAS bf16x8*)(L + P7_WH + (orow[t] * P7_WS + 32 * s + 8 * q) * 2), wl = *(const LAS bf16x8*)(L + P7_WL + (orow[t] * P7_WS + 32 * s + 8 * q) * 2);
                acc[t] = MFMA16(__builtin_bit_cast(bf16x8, xh), wh, acc[t]); acc[t] = MFMA16(__builtin_bit_cast(bf16x8, xl), wh, acc[t]); acc[t] = MFMA16(__builtin_bit_cast(bf16x8, xh), wl, acc[t]);
            }
        }
        ss += __shfl_xor(ss, 16); ss += __shfl_xor(ss, 32);
        LAS float* lg = (LAS float*)(L + P7_LG + wave * 2560);
#pragma unroll
        for (int t = 0; t < 3; ++t)
#pragma unroll
            for (int i = 0; i < 4; ++i) if (16 * t + m < 36) lg[(4 * q + i) * 40 + 16 * t + m] = acc[t][i];
        LDS_WAIT(); asm volatile("" ::: "memory");
        if (lane < 16) {
            const float rstd = 1.f / sqrtf(ss * (1.f / D) + EPS);
            float gl[4];
#pragma unroll
            for (int o = 0; o < 4; ++o) gl[o] = lg[lane * 40 + o] * rstd + F.rg_b[o];
            int gi = 0; float gm = gl[0];
#pragma unroll
            for (int o = 1; o < 4; ++o) if (gl[o] > gm) { gm = gl[o]; gi = o; }
            float den = 0.f;
#pragma unroll
            for (int o = 0; o < 4; ++o) den += __expf(gl[o] - gm);
            const float pg = 1.f / den;
            float el[8];
#pragma unroll
            for (int e = 0; e < 8; ++e) el[e] = lg[lane * 40 + 4 + 8 * gi + e] * rstd + F.re_b[8 * gi + e];
            int i0 = 0; float m0 = el[0];
#pragma unroll
            for (int e = 1; e < 8; ++e) if (el[e] > m0) { m0 = el[e]; i0 = e; }
            int i1 = -1; float m1 = -3.0e38f;
#pragma unroll
            for (int e = 0; e < 8; ++e) if (e != i0 && el[e] > m1) { m1 = el[e]; i1 = e; }
            const float w0 = 1.f / (1.f + __expf(m1 - m0)), w1 = 1.f - w0;
            const int e0 = gi * 8 + i0, e1 = gi * 8 + i1;
            TokRec t; t.e0 = e0; t.e1 = e1; t.s0 = __hip_atomic_fetch_add(&lcnt[e0], 1, __ATOMIC_RELAXED, __HIP_MEMORY_SCOPE_WORKGROUP); t.s1 = __hip_atomic_fetch_add(&lcnt[e1], 1, __ATOMIC_RELAXED, __HIP_MEMORY_SCOPE_WORKGROUP); t.w0 = pg * w0; t.w1 = pg * w1; t.rstd = rstd; t.pad = 0.f;
            TOK[64 * F.vcu + 16 * wave + lane] = t;
        }
    }
    __syncthreads();
    if (tid < 32) ((int*)(F.ws + WS_CNT))[F.vcu * 32 + tid] = lcnt[tid];
    __syncthreads();
    const int gw = F.vcu * NWAVES + wave, NGW = F.G * NWAVES;
    LAS float* scr = (LAS float*)(L + wave * 8448);
    bf16* BTGU = (bf16*)(F.ws + WS_BTGU); bf16* BTDN = (bf16*)(F.ws + WS_BTDN);
    for (int it = gw; it < NEXP * 512 + NEXP * 256; it += NGW) {
        if (it < NEXP * 512) { const int e = it >> 9, nb = (it >> 4) & 31, kb = it & 15;
            transpose_item_gu(F.w_gate + (size_t)e * D * FF, F.w_up + (size_t)e * D * FF, BTGU + (size_t)e * 1024 * D, 32 * nb, 64 * kb, scr, lane); }
        else { const int jt = it - NEXP * 512, e = jt >> 8, nb = (jt >> 3) & 31, kb = jt & 7;
            transpose_item(F.w_down + (size_t)e * FF * D, D, 32 * nb, BTDN + (size_t)e * 1024 * FF, FF, 32 * nb, 64 * kb, scr, lane); }
    }
}

__device__ __forceinline__ void p8_index(Frame& F) {
    LAS int* tot = (LAS int*)F.lds; LAS int* mine = tot + 32; LAS int* base = tot + 64; LAS int* part = tot + 128;
    const int tid = F.tid; const int* CNT = (const int*)(F.ws + WS_CNT);
    { const int e = tid & 31, seg = tid >> 5;
        int st = 0, sm = 0;
        for (int w = seg * 16; w < seg * 16 + 16; ++w) { const int v = CNT[w * 32 + e]; st += v; if (w < F.vcu) sm += v; }
        part[seg * 32 + e] = st; part[512 + seg * 32 + e] = sm; }
    __syncthreads();
    if (tid < 32) { int st = 0, sm = 0; for (int s = 0; s < 16; ++s) { st += part[s * 32 + tid]; sm += part[512 + s * 32 + tid]; } tot[tid] = st; mine[tid] = sm; }
    __syncthreads();
    if (tid == 0) { int acc = 0; for (int e = 0; e < 32; ++e) { base[e] = acc; acc += ((tot[e] + 255) >> 8) << 8; } base[32] = acc; }
    __syncthreads();
    int* ROWIDX = (int*)(F.ws + WS_ROWIDX); float* ROWS = (float*)(F.ws + WS_ROWS); float* ROWW = (float*)(F.ws + WS_ROWW); int* TOKPOS = (int*)(F.ws + WS_TOKPOS);
    const TokRec* TOK = (const TokRec*)(F.ws + WS_TOK);
    if (tid < 128) { const int tk = 64 * F.vcu + (tid >> 1), sl = tid & 1; const TokRec t = TOK[tk];
        const int e = sl ? t.e1 : t.e0, s = sl ? t.s1 : t.s0; const int pos = base[e] + mine[e] + s;
        ROWIDX[pos] = tk; ROWS[pos] = t.rstd; ROWW[pos] = sl ? t.w1 : t.w0; TOKPOS[tk * 2 + sl] = pos; }
    if (F.vcu < 32) { const int e = F.vcu, lo = base[e] + tot[e], hi = base[e + 1];
        for (int p = lo + tid; p < hi; p += NWAVES * 64) { ROWIDX[p] = 0; ROWS[p] = 0.f; ROWW[p] = 0.f; } }
    if (F.vcu == 0 && tid < MAXT + 1) { int* TILEE = (int*)(F.ws + WS_TILEE);
        const int nt = base[32] >> 8;
        if (tid == MAXT) TILEE[MAXT] = nt;
        else { int e = 0; for (int q = 1; q < 32; ++q) if ((base[q] >> 8) <= tid) e = q; TILEE[tid] = (tid < nt) ? e : 0; } }
}

__device__ __forceinline__ void p11_final(Frame& F) {
    const int gw = F.vcu * NWAVES + F.wave, NGW = F.G * NWAVES, lane = F.lane;
    const float* H1 = (const float*)(F.ws + WS_H1); const bf16* Y = (const bf16*)(F.ws + WS_Y); const int* TOKPOS = (const int*)(F.ws + WS_TOKPOS);
    f32x4 nw[4];
#pragma unroll
    for (int j = 0; j < 4; ++j) nw[j] = ((const f32x4*)F.norm_final_w)[64 * j + lane];
    for (int r = gw; r < MR; r += NGW) {
        const int p0 = TOKPOS[r * 2], p1 = TOKPOS[r * 2 + 1];
        const f32x4* hr = (const f32x4*)(H1 + (size_t)r * D) + lane;
        const v2u* y0 = (const v2u*)(Y + (size_t)p0 * D) + lane; const v2u* y1 = (const v2u*)(Y + (size_t)p1 * D) + lane;
        f32x4 v[4]; float s = 0.f;
#pragma unroll
        for (int j = 0; j < 4; ++j) { v[j] = hr[64 * j]; const v2u a = y0[64 * j], b = y1[64 * j];
            v[j].x += bflo(a.x) + bflo(b.x); v[j].y += bfhi(a.x) + bfhi(b.x); v[j].z += bflo(a.y) + bflo(b.y); v[j].w += bfhi(a.y) + bfhi(b.y);
            s += (v[j].x * v[j].x + v[j].y * v[j].y) + (v[j].z * v[j].z + v[j].w * v[j].w); }
        const float rstd = 1.f / sqrtf(wave_sum(s) * (1.f / D) + EPS);
        f32x4* orow = (f32x4*)(F.out + (size_t)r * D) + lane;
#pragma unroll
        for (int j = 0; j < 4; ++j) orow[64 * j] = v[j] * rstd * nw[j];
    }
}

constexpr int NPHASES = 12;
#ifndef MK_ONE_LAUNCH
#define MK_ONE_LAUNCH 1
#endif
struct Args { const float* in[20]; float* out; unsigned char* ws; int ph_lo, ph_hi; };
__global__ void __launch_bounds__(NWAVES * 64, 2) hybrid_fwd(Args args) {
    extern __shared__ __attribute__((aligned(16))) unsigned char lds[];
    Frame F;
    F.lds = (LAS unsigned char*)lds;
    F.MISC = (volatile LAS unsigned*)(F.lds + MISC_OFF);
    F.tid = threadIdx.x; F.lane = F.tid & 63; F.wave = __builtin_amdgcn_readfirstlane(F.tid >> 6);
    F.G = gridDim.x; { const int bx = blockIdx.x; F.vcu = (F.G % 8 == 0) ? (bx % 8) * (F.G / 8) + bx / 8 : bx; }
    F.ws = args.ws; F.out = args.out;
    F.x = args.in[0]; F.meta = args.in[1]; F.norm_mix_w = args.in[2]; F.w_in = args.in[3]; F.conv_w = args.in[4]; F.pool_w = args.in[5]; F.pool_scale = args.in[6];
    F.a_log = args.in[7]; F.dt_bias = args.in[8]; F.dn_norm_w = args.in[9]; F.w_out = args.in[10]; F.norm_ffn_w = args.in[11]; F.rg_w = args.in[12]; F.rg_b = args.in[13];
    F.re_w = args.in[14]; F.re_b = args.in[15]; F.w_gate = args.in[16]; F.w_up = args.in[17]; F.w_down = args.in[18]; F.norm_final_w = args.in[19];
    if (F.tid < 64) F.MISC[F.tid] = 0u;
    __syncthreads();
    const int lo = args.ph_lo, hi = args.ph_hi;
    XcdBarrier bar; bar.bar = (unsigned*)(F.ws + WS_CTL); bar.x = 0; bar.st = nullptr;
    if (hi - lo > 1) bar = xcd_barrier_post((unsigned*)(F.ws + WS_CTL), F.MISC + 8);
#ifndef PHMASK
#define PHMASK 0xFFF
#endif
#define IN(k) ((((PHMASK) >> (k)) & 1) && lo <= (k) && (k) < hi)
#define SEAM(k) do { if (IN(k) && IN((k) + 1)) xcd_barrier(bar); } while (0)

    if (IN(0)) { p0_prologue(F); } SEAM(0);

    if (IN(1)) {
        pg8::Gemm g{(const bf16*)(F.ws + WS_U), (const bf16*)(F.ws + WS_BTIN), MR, 3072, D}; pg8::StaticOrder S; S.init(MR, 3072, F.G, (int)blockIdx.x);
        EpiQKV E{(bf16*)(F.ws + WS_QKV), (bf16*)(F.ws + WS_HALO)};
        pg8::gemm_phase<EpiQKV, pg8::StaticOrder, true, false>(F.lds, g, S, E);
        meta_rows_job(F, (const bf16*)(F.ws + WS_BTIN), 3072, (bf16*)(F.ws + WS_QKV), 3072, (bf16*)(F.ws + WS_HALO));
    } SEAM(1);

    if (IN(2)) { p2_chunk_local(F); } SEAM(2);

    if (IN(3)) { p3_scan(F); } SEAM(3);

    if (IN(4)) {
        pg8::Gemm g{(const bf16*)(F.ws + WS_U), (const bf16*)(F.ws + WS_BTIN) + (size_t)3072 * D, MR, 4096, D}; pg8::StaticOrder S; S.init(MR, 4096, F.G, (int)blockIdx.x);
        EpiPZG E{(bf16*)(F.ws + WS_PM), (bf16*)(F.ws + WS_ZS), (bf16*)(F.ws + WS_GP), (bf16*)(F.ws + WS_GD)};
        pg8::gemm_phase<EpiPZG, pg8::StaticOrder, true, false>(F.lds, g, S, E);
        meta_rows_job(F, (const bf16*)(F.ws + WS_BTIN) + (size_t)3072 * D, 1024, (bf16*)(F.ws + WS_PM), 1024, nullptr);
    } SEAM(4);

    if (IN(5)) { p5_merge(F); } SEAM(5);

    if (IN(6)) {
        pg8::Gemm g{(const bf16*)(F.ws + WS_MERGED), (const bf16*)(F.ws + WS_BTOUT), MR, D, D}; pg8::StaticOrder S; S.init(MR, D, F.G, (int)blockIdx.x);
        EpiOut E{F.x, (float*)(F.ws + WS_H1)};
        pg8::gemm_phase<EpiOut, pg8::StaticOrder, false, false>(F.lds, g, S, E);
    } SEAM(6);

    if (IN(7)) { p7_router(F); } SEAM(7);

    if (IN(8)) { p8_index(F); } SEAM(8);

    if (IN(9) || IN(10)) {
        const int* TILEE = (const int*)(F.ws + WS_TILEE); const int ntiles = TILEE[MAXT];
        LAS int* idx = (LAS int*)(F.lds + 131072);
        if (IN(9)) {
            const int* ROWIDX = (const int*)(F.ws + WS_ROWIDX);
            for (int i = 0; i < 3; ++i) { const int Lu = i * F.G + F.vcu; if (Lu < 4 * ntiles) for (int t = F.tid; t < 256; t += NWAVES * 64) idx[i * 256 + t] = ROWIDX[(Lu >> 2) * 256 + t]; }
            __syncthreads();
            pg8::Gemm g{(const bf16*)(F.ws + WS_XN), (const bf16*)(F.ws + WS_BTGU), 0, 0, D};
            MoeOrder S{ntiles, F.G, F.vcu, TILEE, idx};
            EpiGU E{(bf16*)(F.ws + WS_HDN), (const float*)(F.ws + WS_ROWS)};
            pg8::gemm_phase<EpiGU, MoeOrder, true, true>(F.lds, g, S, E);
        }
        SEAM(9);
        if (IN(10)) {
            pg8::Gemm g{(const bf16*)(F.ws + WS_HDN), (const bf16*)(F.ws + WS_BTDN), 0, 0, FF};
            MoeOrder S{ntiles, F.G, F.vcu, TILEE, idx};
            EpiDown E{(bf16*)(F.ws + WS_Y), (const float*)(F.ws + WS_ROWW)};
            pg8::gemm_phase<EpiDown, MoeOrder, true, false>(F.lds, g, S, E);
        }
    }
    SEAM(10);

    if (IN(11)) { p11_final(F); }
#undef IN
#undef SEAM
}

extern "C" void kernel_launch(void* const* d_in, const int* in_sizes, int n_in, void* d_out, int out_size, void* d_ws, size_t ws_size, hipStream_t stream) {
    static int ready = 0;
    if (ready == 0) {
        if (n_in != 20 || in_sizes[0] != MR * D || out_size != MR * D || ws_size < WS_END) {
            fprintf(stderr, "kernel_launch: unexpected problem (n_in %d, in0 %d, out %d, ws %zu)\n", n_in, n_in > 0 ? in_sizes[0] : -1, out_size, ws_size); ready = -1; return; }
        if (hipFuncSetAttribute((const void*)hybrid_fwd, hipFuncAttributeMaxDynamicSharedMemorySize, LDS_BYTES) != hipSuccess) { fprintf(stderr, "kernel_launch: hipFuncSetAttribute failed\n"); ready = -1; return; }
        int per_cu = 0;
        if (hipOccupancyMaxActiveBlocksPerMultiprocessor(&per_cu, (const void*)hybrid_fwd, NWAVES * 64, LDS_BYTES) != hipSuccess || per_cu < 1)
            fprintf(stderr, "kernel_launch: note: occupancy query reports %d workgroups per CU\n", per_cu);
        (void)hipGetLastError();
        ready = 1;
    }
    if (ready < 0) return;
    (void)hipMemsetAsync((char*)d_ws + WS_CTL, 0, CTL_ZERO_BYTES, stream);
    Args a{};
    for (int i = 0; i < 20; ++i) a.in[i] = (const float*)d_in[i];
    a.out = (float*)d_out; a.ws = (unsigned char*)d_ws;
#if defined(PROBE_LO)
    a.ph_lo = 0; a.ph_hi = PROBE_HI; hipLaunchKernelGGL(hybrid_fwd, dim3(256), dim3(NWAVES * 64), LDS_BYTES, stream, a);
    (void)hipMemsetAsync((char*)d_ws + WS_CTL, 0, CTL_ZERO_BYTES, stream);
    a.ph_lo = PROBE_LO; a.ph_hi = PROBE_HI; hipLaunchKernelGGL(hybrid_fwd, dim3(256), dim3(NWAVES * 64), LDS_BYTES, stream, a);
    (void)hipMemsetAsync((char*)d_ws + WS_CTL, 0, CTL_ZERO_BYTES, stream);
    if (PROBE_HI < NPHASES) { a.ph_lo = PROBE_HI; a.ph_hi = NPHASES; hipLaunchKernelGGL(hybrid_fwd, dim3(256), dim3(NWAVES * 64), LDS_BYTES, stream, a); }
#elif MK_ONE_LAUNCH
    a.ph_lo = 0; a.ph_hi = NPHASES;
    hipLaunchKernelGGL(hybrid_fwd, dim3(256), dim3(NWAVES * 64), LDS_BYTES, stream, a);
#else
    for (int p = 0; p < NPHASES; ++p) { a.ph_lo = p; a.ph_hi = p + 1; hipLaunchKernelGGL(hybrid_fwd, dim3(256), dim3(NWAVES * 64), LDS_BYTES, stream, a); }
#endif
}
```

```cpp
#include <hip/hip_runtime.h>
#include <cstdio>
#include <cstdint>

namespace pg8 {
#define PG8_LAS __attribute__((address_space(3)))
typedef unsigned short bf16_t;
typedef short bf16x8 __attribute__((ext_vector_type(8)));
typedef float f32x4 __attribute__((ext_vector_type(4)));
typedef unsigned u32x4 __attribute__((ext_vector_type(4)));
typedef unsigned u32x2 __attribute__((ext_vector_type(2)));
constexpr int BM = 256, BK = 64, HALF = 128, HTB = HALF * BK * 2  , STAGE_BYTES = 8 * HTB, NXCD = 8, WGM = 8;

__host__ __device__ __forceinline__ int lds_byte(int r, int c) { const int st = (r >> 4) * 2 + (c >> 5), rr = r & 15, cc = c & 31, ob = rr * 64 + cc * 2; return st * 1024 + (ob ^ (((ob >> 9) & 1) << 5)); }
__host__ __device__ __forceinline__ void stage_rc(int b, int& R, int& C) { const int st = b / 1024, sb = b % 1024, swz = sb ^ (((sb >> 9) & 1) << 5); R = (st >> 1) * 16 + swz / 64; C = (st & 1) * 32 + (swz % 64) / 2; }
__host__ __device__ __forceinline__ int perm32(int rho) { const int n = rho >> 4, i = rho & 15; return 8 * (i >> 2) + 4 * n + (i & 3); }

struct Unit { int pm, pn; };
struct Gemm { const bf16_t* A; const bf16_t* Bt; int M, N, K; };

struct StaticOrder {
    int nM, nN, nwg, G, c;
    __host__ __device__ void init(int M, int N, int G_, int c_) { nM = M / BM; nN = N / BM; nwg = nM * nN; G = G_; c = c_; }
    __host__ __device__ bool next(int i, Unit& u) const {
        const long L = (long)i * G + c; if (L >= nwg) return false;
        int wgid = (int)L; { const int q = nwg / NXCD, r = nwg % NXCD, xcd = wgid % NXCD, off = wgid / NXCD; wgid = (xcd < r ? xcd * (q + 1) : r * (q + 1) + (xcd - r) * q) + off; }
        const int nig = WGM * nN, gid = wgid / nig, fm = gid * WGM, gsz = (nM - fm) < WGM ? (nM - fm) : WGM;
        u.pm = fm + ((wgid % nig) % gsz); u.pn = (wgid % nig) / gsz; return true;
    }
    __device__ __forceinline__ int gather_row(const Unit&, int) const { return 0; }
};

template <class Epi, class Sched, bool ALIGN_EPI, bool GATHER>
__device__ __forceinline__ void gemm_phase(PG8_LAS unsigned char* lds, const Gemm g, const Sched& S, const Epi& E) {
    const int tid = threadIdx.x, wid = __builtin_amdgcn_readfirstlane(tid >> 6), lane = tid & 63, wr = wid >> 2, wc = wid & 3, fr = lane & 15, fq = lane >> 4;
    const int K = g.K, nt = K / BK;
    unsigned voffA[2], voffB[2]; int RA[2], CA[2];
#pragma unroll
    for (int i = 0; i < 2; ++i) { int R, C; stage_rc(tid * 16 + i * 8192, R, C); const int Rb = Epi::PERM ? ((R & ~31) + perm32(R & 31)) : R;
        RA[i] = R; CA[i] = C; voffA[i] = (unsigned)(R * K + C) * 2u; voffB[i] = (unsigned)(Rb * K + C) * 2u; }
    const size_t kstep = (size_t)(BK * 2);
    const size_t hstep = (size_t)HALF * K * 2;
    const size_t tstep = 2 * hstep;
    const unsigned ldsw = (unsigned)wid * 1024u;
    const int aoff = lds_byte(wr * 64 + fr, fq * 8), boff = lds_byte(wc * 32 + fr, fq * 8);
#define PG8_SA(b, h) (((b) * 2 + (h)) * HTB)
#define PG8_SB(b, h) ((4 + (b) * 2 + (h)) * HTB)
#define PG8_STAGE(bufoff, gbase, voff) do { _Pragma("unroll") for (int _i = 0; _i < 2; ++_i) \
        __builtin_amdgcn_global_load_lds((const unsigned*)((const char*)(gbase) + (voff)[_i]), (PG8_LAS unsigned*)(lds + (bufoff) + ldsw + _i * 8192), 16, 0, 0); } while (0)
#define PG8_STAGE_A(b, h, gbase, NEXT) do { if constexpr (GATHER) { unsigned _vo[2] = { (NEXT) ? nvo[h][0] : cvo[h][0], (NEXT) ? nvo[h][1] : cvo[h][1] }; PG8_STAGE(PG8_SA(b, h), (gbase), _vo); } \
        else { PG8_STAGE(PG8_SA(b, h), (gbase) + (h) * hstep, voffA); } } while (0)
#define PG8_LDA(dst, b, h) do { _Pragma("unroll") for (int m = 0; m < 4; ++m) _Pragma("unroll") for (int k = 0; k < 2; ++k) dst[m][k] = *(const PG8_LAS bf16x8*)(lds + PG8_SA(b, h) + aoff + m * 2048 + k * 1024); } while (0)
#define PG8_LDB(dst, b, h) do { _Pragma("unroll") for (int n = 0; n < 2; ++n) _Pragma("unroll") for (int k = 0; k < 2; ++k) dst[n][k] = *(const PG8_LAS bf16x8*)(lds + PG8_SB(b, h) + boff + n * 2048 + k * 1024); } while (0)
#define PG8_MMA(ai, bj, At, Bt) do { __builtin_amdgcn_s_setprio(1); _Pragma("unroll") for (int m = 0; m < 4; ++m) _Pragma("unroll") for (int n = 0; n < 2; ++n) _Pragma("unroll") for (int k = 0; k < 2; ++k) \
        acc[ai][bj][m][n] = __builtin_amdgcn_mfma_f32_16x16x32_bf16(Bt[n][k], At[m][k], acc[ai][bj][m][n], 0, 0, 0); __builtin_amdgcn_s_setprio(0); } while (0)
#define PG8_WAIT_V(n) asm volatile("s_waitcnt vmcnt(" #n ")" ::: "memory")
#define PG8_WAIT_L(n) asm volatile("s_waitcnt lgkmcnt(" #n ")" ::: "memory")
#define PG8_BAR __builtin_amdgcn_s_barrier()
#define PG8_SCHED __builtin_amdgcn_sched_barrier(0)
    Unit cur, nxt; int ui = 0;
    if (!S.next(0, cur)) return;
    f32x4 acc[2][2][4][2];
#pragma unroll
    for (int a = 0; a < 2; ++a)
#pragma unroll
        for (int b = 0; b < 2; ++b)
#pragma unroll
            for (int m = 0; m < 4; ++m)
#pragma unroll
                for (int n = 0; n < 2; ++n) acc[a][b][m][n] = (f32x4){0.f, 0.f, 0.f, 0.f};
    bf16x8 At[4][2], B0[2][2], B1[2][2];
    unsigned cvo[2][2] = {{0u, 0u}, {0u, 0u}}, nvo[2][2] = {{0u, 0u}, {0u, 0u}};
    if constexpr (GATHER) {
#pragma unroll
        for (int h = 0; h < 2; ++h)
#pragma unroll
            for (int i = 0; i < 2; ++i) cvo[h][i] = (unsigned)(S.gather_row(cur, h * HALF + RA[i]) * K + CA[i]) * 2u;
    }
    const char* cA = GATHER ? (const char*)g.A : (const char*)g.A + (size_t)cur.pm * tstep; const char* cB = (const char*)g.Bt + (size_t)cur.pn * tstep;
    PG8_STAGE(PG8_SB(0, 0), cB, voffB); PG8_STAGE(PG8_SB(0, 1), cB + hstep, voffB); PG8_STAGE_A(0, 0, cA, false); PG8_STAGE_A(0, 1, cA, false);
    if (wr == 1) PG8_BAR;
    PG8_WAIT_V(2); PG8_BAR;
    PG8_STAGE(PG8_SB(1, 0), cB + kstep, voffB); PG8_STAGE_A(1, 0, cA + kstep, false); PG8_STAGE(PG8_SB(1, 1), cB + hstep + kstep, voffB);
    PG8_WAIT_V(6); PG8_BAR;
    for (;;) {
        const bool has_next = S.next(ui + 1, nxt);
        const char* nA = GATHER ? (const char*)g.A : (has_next ? (const char*)g.A + (size_t)nxt.pm * tstep : cA);
        const char* nB = has_next ? (const char*)g.Bt + (size_t)nxt.pn * tstep : cB;
        for (int t = 0; t < nt; t += 2) {
            const bool last = (t == nt - 2);
            const char* a1 = cA + (size_t)(t + 1) * kstep;
            const char* a2 = last ? nA : cA + (size_t)(t + 2) * kstep; const char* b2 = last ? nB : cB + (size_t)(t + 2) * kstep;
            const char* a3 = a2 + kstep; const char* b3 = b2 + kstep;
            if constexpr (GATHER) { if (last) {
#pragma unroll
                for (int h = 0; h < 2; ++h)
#pragma unroll
                    for (int i = 0; i < 2; ++i) nvo[h][i] = has_next ? (unsigned)(S.gather_row(nxt, h * HALF + RA[i]) * K + CA[i]) * 2u : cvo[h][i];
            } }
            PG8_LDB(B0, 0, 0); PG8_LDB(B1, 0, 1); PG8_SCHED; PG8_LDA(At, 0, 0); PG8_STAGE_A(1, 1, a1, false);
            PG8_WAIT_V(8); PG8_WAIT_L(0); PG8_BAR; PG8_MMA(0, 0, At, B0); PG8_MMA(0, 1, At, B1); PG8_BAR; PG8_SCHED;
            PG8_LDA(At, 0, 1); PG8_STAGE(PG8_SB(0, 0), b2, voffB); PG8_STAGE(PG8_SB(0, 1), b2 + hstep, voffB); PG8_STAGE_A(0, 0, a2, last);
            PG8_WAIT_V(8); PG8_WAIT_L(0); PG8_BAR; PG8_MMA(1, 0, At, B0); PG8_MMA(1, 1, At, B1); PG8_BAR; PG8_SCHED;
            PG8_LDB(B0, 1, 0); PG8_LDB(B1, 1, 1); PG8_SCHED; PG8_LDA(At, 1, 0); PG8_STAGE_A(0, 1, a2, last);
            PG8_WAIT_V(8); PG8_WAIT_L(0); PG8_BAR; PG8_MMA(0, 0, At, B0); PG8_MMA(0, 1, At, B1); PG8_BAR; PG8_SCHED;
            PG8_LDA(At, 1, 1); PG8_STAGE(PG8_SB(1, 0), b3, voffB); PG8_STAGE(PG8_SB(1, 1), b3 + hstep, voffB); PG8_STAGE_A(1, 0, a3, last);
            PG8_WAIT_V(8); PG8_WAIT_L(0); PG8_BAR; PG8_MMA(1, 0, At, B0); PG8_MMA(1, 1, At, B1); PG8_BAR; PG8_SCHED;
        }
        if constexpr (ALIGN_EPI) { if (wr == 0) PG8_BAR; }
        E(acc, cur, wr, wc, fr, fq);
        if (!has_next) break;
#pragma unroll
        for (int a = 0; a < 2; ++a)
#pragma unroll
            for (int b = 0; b < 2; ++b)
#pragma unroll
                for (int m = 0; m < 4; ++m)
#pragma unroll
                    for (int n = 0; n < 2; ++n) acc[a][b][m][n] = (f32x4){0.f, 0.f, 0.f, 0.f};
        cur = nxt; cA = nA; cB = nB; ++ui;
        if constexpr (GATHER) {
#pragma unroll
            for (int h = 0; h < 2; ++h)
#pragma unroll
                for (int i = 0; i < 2; ++i) cvo[h][i] = nvo[h][i];
        }
        if constexpr (ALIGN_EPI) { if (wr == 1) PG8_BAR; }
    }
    PG8_WAIT_V(0);
    if constexpr (!ALIGN_EPI) { if (wr == 0) PG8_BAR; }
    PG8_BAR;
#undef PG8_SA
#undef PG8_SB
#undef PG8_STAGE
#undef PG8_STAGE_A
#undef PG8_LDA
#undef PG8_LDB
#undef PG8_MMA
#undef PG8_WAIT_V
#undef PG8_WAIT_L
#undef PG8_BAR
#undef PG8_SCHED
}
}

#define GAS __attribute__((address_space(1)))
#define LAS __attribute__((address_space(3)))
typedef unsigned short bf16;
typedef unsigned v4u __attribute__((ext_vector_type(4)));
typedef unsigned v2u __attribute__((ext_vector_type(2)));
typedef float f32x4 __attribute__((ext_vector_type(4)));
typedef float f32x16 __attribute__((ext_vector_type(16)));
typedef short bf16x8 __attribute__((ext_vector_type(8)));
typedef __bf16 bf16x2_t __attribute__((ext_vector_type(2)));
typedef float f32x2_t __attribute__((ext_vector_type(2)));
typedef GAS unsigned gu32;
#define RLX_AGENT __ATOMIC_RELAXED, __HIP_MEMORY_SCOPE_AGENT
#define LDS_WAIT() asm volatile("s_waitcnt lgkmcnt(0)" ::: "memory")
#define VM_WAIT() asm volatile("s_waitcnt vmcnt(0)" ::: "memory")
__device__ __forceinline__ unsigned pk2(float lo, float hi) { f32x2_t v = {lo, hi}; bf16x2_t r = __builtin_convertvector(v, bf16x2_t); return __builtin_bit_cast(unsigned, r); }
__device__ __forceinline__ unsigned short f2bf(float f) { return (unsigned short)(pk2(f, 0.f) & 0xffffu); }
__device__ __forceinline__ float bf2f(unsigned short b) { return __builtin_bit_cast(float, ((unsigned)b) << 16); }
__device__ __forceinline__ float bflo(unsigned w) { return __builtin_bit_cast(float, w << 16); }
__device__ __forceinline__ float bfhi(unsigned w) { return __builtin_bit_cast(float, w & 0xffff0000u); }
__device__ __forceinline__ float sigmoidf_(float x) { return __builtin_amdgcn_rcpf(1.f + __expf(-x)); }
__device__ __forceinline__ float siluf_(float x) { return x * __builtin_amdgcn_rcpf(1.f + __expf(-x)); }
__device__ __forceinline__ float wave_sum(float v) {
#pragma unroll
    for (int o = 1; o < 64; o <<= 1) v += __shfl_xor(v, o);
    return v;
}
__device__ __forceinline__ int crow(int reg, int h) { return (reg & 3) + 8 * (reg >> 2) + 4 * h; }
#define MFMA32(a, b, c) __builtin_amdgcn_mfma_f32_32x32x16_bf16((a), (b), (c), 0, 0, 0)
#define MFMA16(a, b, c) __builtin_amdgcn_mfma_f32_16x16x32_bf16((a), (b), (c), 0, 0, 0)
__device__ __forceinline__ bf16x8 pack_step(const f32x16& x, int s) {
    v4u p; p.x = pk2(x[8 * s], x[8 * s + 1]); p.y = pk2(x[8 * s + 2], x[8 * s + 3]); p.z = pk2(x[8 * s + 4], x[8 * s + 5]); p.w = pk2(x[8 * s + 6], x[8 * s + 7]);
    return __builtin_bit_cast(bf16x8, p);
}

#define XB_TMO      128
#define XB_XCNT(j)  (256  + 64 * (j))
#define XB_XSUB(j)  (1280 + 64 * (j))
#define XB_XGEN(j)  (2304 + 64 * (j))
#define XB_TOP      3328
#define XB_TOPGEN   3392
#define XCD_BAR_WORDS 3456
#define XB_SPIN_CAP (1u << 18)

__device__ __forceinline__ unsigned xb_ld(unsigned* p)              { return __hip_atomic_load(p, __ATOMIC_RELAXED, __HIP_MEMORY_SCOPE_AGENT); }
__device__ __forceinline__ unsigned xb_add(unsigned* p, unsigned v) { return __hip_atomic_fetch_add(p, v, __ATOMIC_RELAXED, __HIP_MEMORY_SCOPE_AGENT); }
__device__ __forceinline__ unsigned xb_xcc_id() { return (unsigned)__builtin_amdgcn_s_getreg((3 << 11) | 20) & 0xFu; }
#define XB_SPIN(cond, bar) do { unsigned _sp = 0; while (cond) { __builtin_amdgcn_s_sleep(1); \
    if ((++_sp & 255u) == 0u) { if (xb_ld(&(bar)[XB_TMO])) break; if (_sp > XB_SPIN_CAP) { atomicAdd(&(bar)[XB_TMO], 1u); break; } } } } while (0)

struct XcdBarrier {
    unsigned* bar; unsigned x;
    volatile LAS unsigned* st;
};

__device__ __forceinline__ XcdBarrier xcd_barrier_post(unsigned* bar, volatile LAS unsigned* st) {
    XcdBarrier b; b.bar = bar; b.x = xb_xcc_id(); b.st = st;
    if (threadIdx.x == 0) (void)xb_add(&bar[XB_XCNT(b.x)], 1u);
    return b;
}
__device__ __forceinline__ void xcd_barrier_complete(unsigned* bar, unsigned x, unsigned& nloc, unsigned& nx) {
    const unsigned G = gridDim.x * gridDim.y * gridDim.z;
    unsigned sum, cnt, mine, sp = 0u;
    for (;;) {
        sum = 0u; cnt = 0u; mine = 0u;
#pragma unroll
        for (unsigned j = 0; j < 16; ++j) { const unsigned c = xb_ld(&bar[XB_XCNT(j)]); sum += c; cnt += (c > 0u) ? 1u : 0u; mine = (j == x) ? c : mine; }
        if (sum == G) break;
        __builtin_amdgcn_s_sleep(1);
        if ((++sp & 255u) == 0u) { if (xb_ld(&bar[XB_TMO])) break; if (sp > XB_SPIN_CAP) { atomicAdd(&bar[XB_TMO], 1u); break; } }
    }
    nloc = mine > 0u ? mine : 1u; nx = cnt > 0u ? cnt : 1u;
}

__device__ __forceinline__ void xcd_barrier(const XcdBarrier& b) {
    asm volatile("s_waitcnt vmcnt(0)" ::: "memory");
    __syncthreads();
    if (threadIdx.x == 0) {
        unsigned* bar = b.bar;
        __builtin_amdgcn_s_waitcnt(0);
        unsigned nloc = b.st[0], nx = b.st[1];
        if (nloc == 0u) { xcd_barrier_complete(bar, b.x, nloc, nx); b.st[0] = nloc; b.st[1] = nx; }
        const unsigned old = xb_add(&bar[XB_XSUB(b.x)], 1u);
        const unsigned gen = old / nloc;
        if (old + 1u == (gen + 1u) * nloc) {
            __builtin_amdgcn_fence(__ATOMIC_RELEASE, "agent");
            asm volatile("s_waitcnt vmcnt(0)" ::: "memory");
            const unsigned og = xb_add(&bar[XB_TOP], 1u);
            const unsigned tg = og / nx;
            if (og + 1u == (tg + 1u) * nx) xb_add(&bar[XB_TOPGEN], 1u);
            else XB_SPIN(xb_ld(&bar[XB_TOPGEN]) == tg, bar);
            __builtin_amdgcn_fence(__ATOMIC_ACQUIRE, "agent");
            xb_add(&bar[XB_XGEN(b.x)], 1u);
            asm volatile("s_waitcnt vmcnt(0)" ::: "memory");
        } else {
            XB_SPIN(xb_ld(&bar[XB_XGEN(b.x)]) == gen, bar);
            __builtin_amdgcn_fence(__ATOMIC_ACQUIRE, "agent");
            asm volatile("s_waitcnt vmcnt(0)" ::: "memory");
        }
    }
    __syncthreads();
}

constexpr int NWAVES = 8;
constexpr int BATCH = 8, SEQ = 2048, D = 1024, NMETA = 16, NH = 8, HD = 128;
constexpr int MR = BATCH * SEQ;
constexpr int LX = 2112, NX = BATCH * LX;
constexpr int NCH = 33, NCHUNKS = BATCH * NH * NCH;
constexpr int PROJ = 7184;
constexpr int NEXP = 32, FF = 512;
constexpr int MAXT = 160;
constexpr float EPS = 1e-6f;

constexpr size_t MiB = 1u << 20;
constexpr size_t WS_CTL = 0, CTL_ZERO_BYTES = 64 * 1024;
constexpr size_t WS_GB     = 1 * MiB;
constexpr size_t WS_UMETA  = WS_GB + 1152 * 1024;
constexpr size_t WS_HALO   = WS_UMETA + 64 * 1024;
constexpr size_t WS_CD     = 7 * MiB;
constexpr size_t WS_CNT    = 7 * MiB + 64 * 1024;
constexpr size_t WS_TILEE  = WS_CNT + 64 * 1024;
constexpr size_t WS_TOK    = WS_TILEE + 4096;
constexpr size_t WS_ROWIDX = 8 * MiB;
constexpr size_t WS_ROWS   = WS_ROWIDX + 256 * 1024;
constexpr size_t WS_ROWW   = WS_ROWS + 256 * 1024;
constexpr size_t WS_TOKPOS = WS_ROWW + 256 * 1024;
constexpr size_t WS_BTIN   = 10 * MiB;
constexpr size_t WS_BTOUT  = 24 * MiB;
constexpr size_t WS_U      = 26 * MiB;
constexpr size_t WS_O      = 58 * MiB;
constexpr size_t WS_QKV    = 90 * MiB;
constexpr size_t WS_CLX    = 189 * MiB;
constexpr size_t WS_PM     = 90 * MiB;
constexpr size_t WS_ZS     = 123 * MiB;
constexpr size_t WS_GP     = 155 * MiB;
constexpr size_t WS_GD     = 187 * MiB;
constexpr size_t WS_MERGED = 219 * MiB;
constexpr size_t WS_H1     = 90 * MiB;
constexpr size_t WS_XN     = 10 * MiB;
constexpr size_t WS_HDN    = 42 * MiB;
constexpr size_t WS_BTGU   = 154 * MiB;
constexpr size_t WS_BTDN   = 250 * MiB;
constexpr size_t WS_Y      = 154 * MiB;
constexpr size_t WS_END    = 289 * MiB;

constexpr int LDS_BYTES = 163840;
constexpr int MISC_OFF = 163840 - 256;

struct Frame {
    LAS unsigned char* lds;
    volatile LAS unsigned* MISC;
    int tid, lane, wave;
    int vcu, G;
    unsigned char* ws;
    const float *x, *meta, *norm_mix_w, *w_in, *conv_w, *pool_w, *pool_scale, *a_log, *dt_bias, *dn_norm_w, *w_out, *norm_ffn_w,
                *rg_w, *rg_b, *re_w, *re_b, *w_gate, *w_up, *w_down, *norm_final_w;
    float* out;
};
__device__ __forceinline__ int xrow_of(int r) { return (r >> 11) * LX + 64 + (r & 2047); }

__device__ __forceinline__ void transpose_item(const float* W, int ldw, int c0, bf16* WT, int ldk, int r0, int k0, LAS float* scr, int lane) {
    float tv[32];
#pragma unroll
    for (int i = 0; i < 32; ++i) { const int kk = 2 * i + (lane >> 5); tv[i] = W[(size_t)(k0 + kk) * ldw + c0 + (lane & 31)]; }
#pragma unroll
    for (int i = 0; i < 32; ++i) { const int kk = 2 * i + (lane >> 5); scr[kk * 33 + (lane & 31)] = tv[i]; }
    LDS_WAIT(); asm volatile("" ::: "memory");
    const int c = lane & 7;
#pragma unroll
    for (int j = 0; j < 4; ++j) { const int n = (lane >> 3) + 8 * j; const LAS float* s = scr + (8 * c) * 33 + n;
        v4u o; o.x = pk2(s[0 * 33], s[1 * 33]); o.y = pk2(s[2 * 33], s[3 * 33]); o.z = pk2(s[4 * 33], s[5 * 33]); o.w = pk2(s[6 * 33], s[7 * 33]);
        *(GAS v4u*)(WT + (size_t)(r0 + n) * ldk + k0 + 8 * c) = o; }
    LDS_WAIT(); asm volatile("" ::: "memory");
}
__device__ __forceinline__ void transpose_item_gu(const float* Wg, const float* Wu, const float* nwk, bf16* WT, int r0, int k0, LAS float* scr, int lane) {
    const int d = lane & 31, cdst = r0 + d, f = (cdst >> 3) * 4 + (cdst & 3); const float* src = ((cdst >> 2) & 1) ? Wu : Wg;
    float tv[32];
#pragma unroll
    for (int i = 0; i < 32; ++i) { const int kk = 2 * i + (lane >> 5); tv[i] = src[(size_t)(k0 + kk) * FF + f] * nwk[k0 + kk]; }
#pragma unroll
    for (int i = 0; i < 32; ++i) { const int kk = 2 * i + (lane >> 5); scr[kk * 33 + d] = tv[i]; }
    LDS_WAIT(); asm volatile("" ::: "memory");
    const int c = lane & 7;
#pragma unroll
    for (int j = 0; j < 4; ++j) { const int n = (lane >> 3) + 8 * j; const LAS float* s = scr + (8 * c) * 33 + n;
        v4u o; o.x = pk2(s[0 * 33], s[1 * 33]); o.y = pk2(s[2 * 33], s[3 * 33]); o.z = pk2(s[4 * 33], s[5 * 33]); o.w = pk2(s[6 * 33], s[7 * 33]);
        *(GAS v4u*)(WT + (size_t)(r0 + n) * D + k0 + 8 * c) = o; }
    LDS_WAIT(); asm volatile("" ::: "memory");
}

__device__ __forceinline__ void p0_prologue(Frame& F) {
    const int gw = F.vcu * NWAVES + F.wave, NGW = F.G * NWAVES, lane = F.lane;
    LAS float* WabT = (LAS float*)F.lds;
    for (int k = F.tid; k < D; k += NWAVES * 64) {
        const f32x4* src = (const f32x4*)(F.w_in + (size_t)k * PROJ + 5120);
#pragma unroll
        for (int q = 0; q < 4; ++q) { const f32x4 v = src[q]; WabT[(4 * q + 0) * D + k] = v.x; WabT[(4 * q + 1) * D + k] = v.y; WabT[(4 * q + 2) * D + k] = v.z; WabT[(4 * q + 3) * D + k] = v.w; }
    }
    __syncthreads();
    bf16* U = (bf16*)(F.ws + WS_U); bf16* UM = (bf16*)(F.ws + WS_UMETA); float* GB = (float*)(F.ws + WS_GB);
    f32x4 nw[4];
#pragma unroll
    for (int j = 0; j < 4; ++j) nw[j] = ((const f32x4*)F.norm_mix_w)[64 * j + lane];
#define P0_ROWPTR(r) ((const f32x4*)((r) >= MR ? F.meta + (size_t)((r) - MR) * D : F.x + (size_t)(r) * D) + lane)
    f32x4 vn[4];
    if (gw < MR + NMETA) { const f32x4* xr = P0_ROWPTR(gw);
#pragma unroll
        for (int j = 0; j < 4; ++j) vn[j] = xr[64 * j]; }
    for (int r = gw; r < MR + NMETA; r += NGW) {
        const bool ismeta = r >= MR; const int mj = r - MR;
        f32x4 v[4]; float s = 0.f;
#pragma unroll
        for (int j = 0; j < 4; ++j) { v[j] = vn[j]; s += (v[j].x * v[j].x + v[j].y * v[j].y) + (v[j].z * v[j].z + v[j].w * v[j].w); }
        if (r + NGW < MR + NMETA) { const f32x4* xr = P0_ROWPTR(r + NGW);
#pragma unroll
            for (int j = 0; j < 4; ++j) vn[j] = xr[64 * j]; }
        const float rstd = __builtin_amdgcn_rsqf(wave_sum(s) * (1.f / D) + EPS);
#pragma unroll
        for (int j = 0; j < 4; ++j) v[j] = v[j] * rstd * nw[j];
        unsigned long long* o8 = (unsigned long long*)(ismeta ? UM + (size_t)mj * D : U + (size_t)r * D) + lane;
#pragma unroll
        for (int j = 0; j < 4; ++j) o8[64 * j] = (unsigned long long)pk2(v[j].x, v[j].y) | ((unsigned long long)pk2(v[j].z, v[j].w) << 32);
        float p[16];
#pragma unroll
        for (int o = 0; o < 16; ++o) { float a = 0.f;
#pragma unroll
            for (int j = 0; j < 4; ++j) { const f32x4 w = *(const LAS f32x4*)(WabT + o * D + 256 * j + 4 * lane); a += (v[j].x * w.x + v[j].y * w.y) + (v[j].z * w.z + v[j].w * w.w); }
            p[o] = a; if ((o & 3) == 3) __builtin_amdgcn_sched_barrier(0); }
        const bool b5 = lane & 32, b4 = lane & 16, b3 = lane & 8, b2 = lane & 4;
        float q8[8], q4[4], q2[2];
#pragma unroll
        for (int i = 0; i < 8; ++i) { const float keep = b5 ? p[8 + i] : p[i], send = b5 ? p[i] : p[8 + i]; q8[i] = keep + __shfl_xor(send, 32); }
#pragma unroll
        for (int i = 0; i < 4; ++i) { const float keep = b4 ? q8[4 + i] : q8[i], send = b4 ? q8[i] : q8[4 + i]; q4[i] = keep + __shfl_xor(send, 16); }
#pragma unroll
        for (int i = 0; i < 2; ++i) { const float keep = b3 ? q4[2 + i] : q4[i], send = b3 ? q4[i] : q4[2 + i]; q2[i] = keep + __shfl_xor(send, 8); }
        float mine; { const float keep = b2 ? q2[1] : q2[0], send = b2 ? q2[0] : q2[1]; mine = keep + __shfl_xor(send, 4); }
        mine += __shfl_xor(mine, 2); mine += __shfl_xor(mine, 1);
        const int oo = (b5 ? 8 : 0) + (b4 ? 4 : 0) + (b3 ? 2 : 0) + (b2 ? 1 : 0);
        if ((lane & 3) == 0) {
            float val;
            if (oo < 8) { const float xx = mine + F.dt_bias[oo]; const float sp = xx > 20.f ? xx : log1pf(__expf(xx)); val = -__expf(F.a_log[oo]) * sp; }
            else val = 1.f / (1.f + __expf(-mine));
            if (!ismeta) GB[(size_t)xrow_of(r) * 16 + oo] = val;
            else {
#pragma unroll
                for (int b = 0; b < BATCH; ++b) GB[(size_t)(b * LX + 48 + mj) * 16 + oo] = val; }
        }
    }
    __syncthreads();
    bf16* BTIN = (bf16*)(F.ws + WS_BTIN); bf16* BTOUT = (bf16*)(F.ws + WS_BTOUT);
    LAS float* scr = (LAS float*)(F.lds + 65536 + F.wave * 8448);
    constexpr int NB_TOT = 96 + 32 + 32 + 32 + 32;
    for (int it = gw; it < NB_TOT * 16; it += NGW) {
        const int kb = it & 15; int nb = it >> 4;
        if (nb < 96) { transpose_item(F.w_in, PROJ, 1024 + 32 * nb, BTIN, D, 32 * nb, 64 * kb, scr, lane); continue; } nb -= 96;
        if (nb < 32) { transpose_item(F.w_in, PROJ, 4096 + 32 * nb, BTIN, D, 4096 + 32 * nb, 64 * kb, scr, lane); continue; } nb -= 32;
        if (nb < 32) { transpose_item(F.w_in, PROJ, 5136 + 32 * nb, BTIN, D, 5120 + 32 * nb, 64 * kb, scr, lane); continue; } nb -= 32;
        if (nb < 32) { transpose_item(F.w_in, PROJ, 6160 + 32 * nb, BTIN, D, 6144 + 32 * nb, 64 * kb, scr, lane); continue; } nb -= 32;
        transpose_item(F.w_out, D, 32 * nb, BTOUT, D, 32 * nb, 64 * kb, scr, lane);
    }
    for (int tile = gw; tile < 4 * 64 * 16; tile += NGW) {
        const int g = tile >> 10, kt = (tile >> 4) & 63, ntl = tile & 15;
        const int m = lane & 15, q = lane >> 4;
        const float* arow = F.w_in + (size_t)(16 * kt + m) * PROJ + 256 * g + 8 * q;
        const float* bcol = F.pool_w + (size_t)g * 65536 + (size_t)(8 * q) * 256 + 16 * ntl + m;
        f32x4 acc = {0.f, 0.f, 0.f, 0.f};
#pragma unroll
        for (int s = 0; s < 8; ++s) {
            const f32x4 a0 = *(const f32x4*)(arow + 32 * s), a1 = *(const f32x4*)(arow + 32 * s + 4);
            float bv[8];
#pragma unroll
            for (int j = 0; j < 8; ++j) bv[j] = bcol[(size_t)(32 * s + j) * 256];
            v4u ap, bp; ap.x = pk2(a0.x, a0.y); ap.y = pk2(a0.z, a0.w); ap.z = pk2(a1.x, a1.y); ap.w = pk2(a1.z, a1.w);
            bp.x = pk2(bv[0], bv[1]); bp.y = pk2(bv[2], bv[3]); bp.z = pk2(bv[4], bv[5]); bp.w = pk2(bv[6], bv[7]);
            acc = MFMA16(__builtin_bit_cast(bf16x8, ap), __builtin_bit_cast(bf16x8, bp), acc);
        }
        v2u o; o.x = pk2(acc[0], acc[1]); o.y = pk2(acc[2], acc[3]);
        *(GAS v2u*)(BTIN + (size_t)(3072 + 256 * g + 16 * ntl + m) * D + 16 * kt + 4 * q) = o;
    }
}

typedef pg8::f32x4 (&AccRef)[2][2][4][2];
struct EpiQKV {
    static constexpr bool PERM = true;
    bf16* QKV; bf16* HALO;
    __device__ __forceinline__ void operator()(const pg8::f32x4 (&acc)[2][2][4][2], const pg8::Unit& u, int wr, int wc, int fr, int fq) const {
        const int col0 = u.pn * 256 + wc * 32 + 8 * fq;
#pragma unroll
        for (int ai = 0; ai < 2; ++ai)
#pragma unroll
            for (int m = 0; m < 4; ++m) {
                const int r = u.pm * 256 + ai * 128 + wr * 64 + m * 16 + fr; const int b = r >> 11, xin = 64 + (r & 2047);
                bf16* rowp = QKV + (size_t)(b * LX + xin) * 3072 + col0;
                const bool halo = (m == 3) && (fr >= 13) && ((xin >> 6) + 1 <= 32);
                bf16* hp = HALO + ((size_t)((b * NCH + (xin >> 6) + 1) * 3 + (fr - 13))) * 3072 + col0;
#pragma unroll
                for (int bj = 0; bj < 2; ++bj) { const pg8::f32x4 v0 = acc[ai][bj][m][0], v1 = acc[ai][bj][m][1];
                    v4u w; w.x = pk2(v0[0], v0[1]); w.y = pk2(v0[2], v0[3]); w.z = pk2(v1[0], v1[1]); w.w = pk2(v1[2], v1[3]);
                    *(v4u*)(rowp + bj * 128) = w; if (halo) *(v4u*)(hp + bj * 128) = w; } }
    }
};
struct EpiPZG {
    static constexpr bool PERM = true;
    bf16 *PM, *ZS, *GP, *GD;
    __device__ __forceinline__ void operator()(const pg8::f32x4 (&acc)[2][2][4][2], const pg8::Unit& u, int wr, int wc, int fr, int fq) const {
        const int kind = u.pn >> 2, col0 = (u.pn & 3) * 256 + wc * 32 + 8 * fq;
        bf16* base = kind == 0 ? PM : (kind == 1 ? ZS : (kind == 2 ? GP : GD));
#pragma unroll
        for (int ai = 0; ai < 2; ++ai)
#pragma unroll
            for (int m = 0; m < 4; ++m) {
                const int r = u.pm * 256 + ai * 128 + wr * 64 + m * 16 + fr; const int orow = kind == 0 ? xrow_of(r) : r;
                bf16* rowp = base + (size_t)orow * D + col0;
#pragma unroll
                for (int bj = 0; bj < 2; ++bj) { pg8::f32x4 v0 = acc[ai][bj][m][0], v1 = acc[ai][bj][m][1];
                    if (kind == 1) {
#pragma unroll
                        for (int e = 0; e < 4; ++e) { v0[e] = siluf_(v0[e]); v1[e] = siluf_(v1[e]); } }
                    else if (kind >= 2) {
#pragma unroll
                        for (int e = 0; e < 4; ++e) { v0[e] = sigmoidf_(v0[e]); v1[e] = sigmoidf_(v1[e]); } }
                    v4u w; w.x = pk2(v0[0], v0[1]); w.y = pk2(v0[2], v0[3]); w.z = pk2(v1[0], v1[1]); w.w = pk2(v1[2], v1[3]);
                    *(v4u*)(rowp + bj * 128) = w; } }
    }
};
struct EpiOut {
    static constexpr bool PERM = false;
    const float* X; float* H1; bf16* XN;
    __device__ __forceinline__ void operator()(const pg8::f32x4 (&acc)[2][2][4][2], const pg8::Unit& u, int wr, int wc, int fr, int fq) const {
        const int row0 = u.pm * 256 + wr * 64 + fr, col0 = u.pn * 256 + wc * 32 + 4 * fq;
#pragma unroll
        for (int ai = 0; ai < 2; ++ai)
#pragma unroll
            for (int m = 0; m < 4; ++m) { const size_t off = (size_t)(row0 + ai * 128 + m * 16) * D + col0;
#pragma unroll
                for (int bj = 0; bj < 2; ++bj)
#pragma unroll
                    for (int n = 0; n < 2; ++n) { const pg8::f32x4 xv = *(const pg8::f32x4*)(X + off + bj * 128 + n * 16); const pg8::f32x4 hv = acc[ai][bj][m][n] + xv; *(pg8::f32x4*)(H1 + off + bj * 128 + n * 16) = hv;
                        v2u w; w.x = pk2(hv[0], hv[1]); w.y = pk2(hv[2], hv[3]); *(v2u*)(XN + off + bj * 128 + n * 16) = w; } }
    }
};
struct EpiGU {
    static constexpr bool PERM = true;
    bf16* HDN; const float* ROWS;
    __device__ __forceinline__ void operator()(const pg8::f32x4 (&acc)[2][2][4][2], const pg8::Unit& u, int wr, int wc, int fr, int fq) const {
        const int f0 = (u.pn & 3) * 128 + wc * 16 + 4 * fq;
#pragma unroll
        for (int ai = 0; ai < 2; ++ai)
#pragma unroll
            for (int m = 0; m < 4; ++m) { const int pos = u.pm * 256 + ai * 128 + wr * 64 + m * 16 + fr; const float rs = ROWS[pos];
#pragma unroll
                for (int bj = 0; bj < 2; ++bj) { const pg8::f32x4 gt = acc[ai][bj][m][0] * rs, up = acc[ai][bj][m][1] * rs;
                    v2u w; w.x = pk2(siluf_(gt[0]) * up[0], siluf_(gt[1]) * up[1]); w.y = pk2(siluf_(gt[2]) * up[2], siluf_(gt[3]) * up[3]);
                    *(v2u*)(HDN + (size_t)pos * FF + f0 + bj * 64) = w; } }
    }
};
struct EpiDown {
    static constexpr bool PERM = true;
    bf16* Y; const float* ROWW;
    __device__ __forceinline__ void operator()(const pg8::f32x4 (&acc)[2][2][4][2], const pg8::Unit& u, int wr, int wc, int fr, int fq) const {
        const int col0 = (u.pn & 3) * 256 + wc * 32 + 8 * fq;
#pragma unroll
        for (int ai = 0; ai < 2; ++ai)
#pragma unroll
            for (int m = 0; m < 4; ++m) { const int pos = u.pm * 256 + ai * 128 + wr * 64 + m * 16 + fr; const float cw = ROWW[pos];
#pragma unroll
                for (int bj = 0; bj < 2; ++bj) { const pg8::f32x4 v0 = acc[ai][bj][m][0] * cw, v1 = acc[ai][bj][m][1] * cw;
                    v4u w; w.x = pk2(v0[0], v0[1]); w.y = pk2(v0[2], v0[3]); w.z = pk2(v1[0], v1[1]); w.w = pk2(v1[2], v1[3]);
                    *(v4u*)(Y + (size_t)pos * D + col0 + bj * 128) = w; } }
    }
};
struct MoeOrder {
    int ntiles, G, c; const int* tile_e; const LAS int* idx;
    __device__ __forceinline__ bool next(int i, pg8::Unit& u) const {
        const int L = i * G + c; if (L >= 4 * ntiles) return false;
        u.pm = L >> 2; u.pn = tile_e[L >> 2] * 4 + (L & 3); return true;
    }
    __device__ __forceinline__ int gather_row(const pg8::Unit& u, int r) const { const int i = (u.pm * 4 + (u.pn & 3) - c) / G; return idx[i * 256 + r]; }
};

__device__ __forceinline__ void meta_rows_job(Frame& F, const bf16* BT, int ncols, bf16* OUTX, int ld, bf16* HALO) {
    const bf16* UM = (const bf16*)(F.ws + WS_UMETA);
    const int lane = F.lane, m = lane & 15, q = lane >> 4;
    for (int tile = F.vcu * NWAVES + F.wave; tile < ncols / 16; tile += F.G * NWAVES) {
        const bf16* ap = UM + (size_t)m * D + 8 * q; const bf16* bp = BT + (size_t)(16 * tile + m) * D + 8 * q;
        f32x4 acc = {0.f, 0.f, 0.f, 0.f};
#pragma unroll 4
        for (int s = 0; s < 32; ++s) acc = MFMA16(*(const bf16x8*)(ap + 32 * s), *(const bf16x8*)(bp + 32 * s), acc);
#pragma unroll
        for (int i = 0; i < 4; ++i) { const int j = 4 * q + i; const bf16 v = f2bf(acc[i]);
#pragma unroll
            for (int b = 0; b < BATCH; ++b) { OUTX[(size_t)(b * LX + 48 + j) * ld + 16 * tile + m] = v;
                if (HALO && j >= 13) HALO[((size_t)((b * NCH + 1) * 3 + (j - 13))) * 3072 + 16 * tile + m] = v; } }
    }
}

constexpr int P2_KN = 0, P2_QN = 17408, P2_KBT = 34816, P2_VBT = 53248, P2_KDT = 71680, P2_QDI = 90112, P2_AM = 107520, P2_TM = 124928, P2_QKM = 134144, P2_SC = 143360, P2_AB21 = 144640;
constexpr int RS = 272, TS = 144;
__device__ __forceinline__ size_t inplace_off(int xr0, int mat, int h, int f, int lane) {
    return ((size_t)(xr0 + 4 * f + (lane >> 4)) * 3072 + mat * 1024 + h * 128) * 2 + (lane & 15) * 16;
}
__device__ __forceinline__ void p2_chunk_local(Frame& F) {
    LAS unsigned char* L = F.lds; const int wave = F.wave;
    LAS float* SC = (LAS float*)(L + P2_SC);
    unsigned char* QKV = F.ws + WS_QKV; const bf16* HALO = (const bf16*)(F.ws + WS_HALO); const float* GB = (const float*)(F.ws + WS_GB);
    unsigned char* CLX = F.ws + WS_CLX; float* CD = (float*)(F.ws + WS_CD);
    v4u raww[11]; f32x4 cwq[8]; float gq = 0.f, beq = 0.f; float val[8][8];
#define P2_PREFETCH(CID) do { const int c_ = (CID) % NCH, bh_ = (CID) / NCH, h_ = bh_ & 7, b_ = bh_ >> 3, xr_ = b_ * LX + 64 * c_; \
        const int tid_ = F.tid, lane_ = tid_ & 63, grp_ = tid_ >> 4, mat_ = grp_ >> 3, rg_ = grp_ & 7, cg_ = lane_ & 15, ch_ = mat_ * 1024 + h_ * 128 + 8 * cg_; \
        if (tid_ < 384) { _Pragma("unroll") for (int i = 0; i < 11; ++i) { const int li = 8 * rg_ - 3 + i; v4u w = {0u, 0u, 0u, 0u}; \
            if (li < 0) { if (c_ > 0) w = *(const v4u*)(HALO + ((size_t)((b_ * NCH + c_) * 3 + (li + 3))) * 3072 + ch_); } \
            else if (!(c_ == 0 && li < 48)) w = *(const v4u*)(QKV + ((size_t)(xr_ + li) * 3072 + ch_) * 2); \
            raww[i] = w; } \
            _Pragma("unroll") for (int kk = 0; kk < 4; ++kk) { cwq[2 * kk] = *(const f32x4*)(F.conv_w + (size_t)kk * 3072 + ch_); cwq[2 * kk + 1] = *(const f32x4*)(F.conv_w + (size_t)kk * 3072 + ch_ + 4); } } \
        if (tid_ < 64) { const bool nul_ = (c_ == 0) && (lane_ < 48); gq = nul_ ? 0.f : GB[(size_t)(xr_ + lane_) * 16 + h_]; beq = nul_ ? 0.f : GB[(size_t)(xr_ + lane_) * 16 + 8 + h_]; } } while (0)
#define P2_KILL() do { _Pragma("unroll") for (int i = 0; i < 11; ++i) raww[i] = (v4u){0u, 0u, 0u, 0u}; _Pragma("unroll") for (int i = 0; i < 8; ++i) { cwq[i] = (f32x4){0.f, 0.f, 0.f, 0.f}; _Pragma("unroll") for (int e = 0; e < 8; ++e) val[i][e] = 0.f; } } while (0)
#define RAWV(i, e) (((e) & 1) ? bfhi(raww[i][(e) >> 1]) : bflo(raww[i][(e) >> 1]))
#define CWV(kk, e) (cwq[2 * (kk) + ((e) >> 2)][(e) & 3])
#define P2_S0S1(CID, TID) do { const int lane_ = (TID) & 63; \
        if (wave == 0) { float gam = gq; \
            _Pragma("unroll") for (int o = 1; o < 64; o <<= 1) { const float t = __shfl_up(gam, o); if (lane_ >= o) gam += t; } \
            const float gl = __shfl(gam, 63); \
            SC[lane_] = gam; SC[64 + lane_] = beq; const float eg = __expf(gam); SC[128 + lane_] = eg; SC[192 + lane_] = __expf(gl - gam); SC[256 + lane_] = beq * eg; \
            if (lane_ == 0) CD[(CID)] = __expf(gl); } \
        if ((TID) < 384) { const int mat_ = (TID) >> 7; \
            _Pragma("unroll") for (int i = 0; i < 8; ++i) { float ss = 0.f; \
                _Pragma("unroll") for (int e = 0; e < 8; ++e) { const float cv = CWV(0, e) * RAWV(i, e) + CWV(1, e) * RAWV(i + 1, e) + CWV(2, e) * RAWV(i + 2, e) + CWV(3, e) * RAWV(i + 3, e); \
                    const float sv = cv * __builtin_amdgcn_rcpf(1.f + __expf(-cv)); val[i][e] = sv; ss += sv * sv; } \
                if (mat_ < 2) { ss += __shfl_xor(ss, 1); ss += __shfl_xor(ss, 2); ss += __shfl_xor(ss, 4); ss += __shfl_xor(ss, 8); \
                    const float inv = __builtin_amdgcn_rsqf(ss + EPS) * (mat_ == 0 ? 0.08838834764831845f : 1.f); \
                    _Pragma("unroll") for (int e = 0; e < 8; ++e) val[i][e] *= inv; } } } } while (0)
    if (F.vcu < NCHUNKS) { P2_PREFETCH(F.vcu); P2_S0S1(F.vcu, F.tid); if (F.vcu + F.G < NCHUNKS) P2_PREFETCH(F.vcu + F.G); }
    __syncthreads();
    for (int cid = F.vcu; cid < NCHUNKS; cid += F.G) {
        const int c = cid % NCH, bh = cid / NCH, h = bh & 7, b = bh >> 3, xr0 = b * LX + 64 * c;
        int tid = F.tid; asm volatile("" : "+v"(tid)); const int lane = tid & 63;
        const int grp = tid >> 4, mat = grp >> 3, rg = grp & 7, cg = lane & 15;
        if (tid < 384) {
            if (mat == 0) {
#pragma unroll
                for (int i = 0; i < 8; ++i) { const int t = 8 * rg + i; const float eg = SC[128 + t];
                    v4u w; w.x = pk2(val[i][0], val[i][1]); w.y = pk2(val[i][2], val[i][3]); w.z = pk2(val[i][4], val[i][5]); w.w = pk2(val[i][6], val[i][7]);
                    *(LAS v4u*)(L + P2_QN + t * RS + cg * 16) = w;
                    w.x = pk2(val[i][0] * eg, val[i][1] * eg); w.y = pk2(val[i][2] * eg, val[i][3] * eg); w.z = pk2(val[i][4] * eg, val[i][5] * eg); w.w = pk2(val[i][6] * eg, val[i][7] * eg);
                    *(LAS v4u*)(L + P2_QDI + t * RS + cg * 16) = w; }
            } else if (mat == 1) {
                float beg[8], egl[8];
#pragma unroll
                for (int i = 0; i < 8; ++i) { beg[i] = SC[256 + 8 * rg + i]; egl[i] = SC[192 + 8 * rg + i]; }
#pragma unroll
                for (int i = 0; i < 8; ++i) { const int t = 8 * rg + i;
                    v4u w; w.x = pk2(val[i][0], val[i][1]); w.y = pk2(val[i][2], val[i][3]); w.z = pk2(val[i][4], val[i][5]); w.w = pk2(val[i][6], val[i][7]);
                    *(LAS v4u*)(L + P2_KN + t * RS + cg * 16) = w; }
#pragma unroll
                for (int e = 0; e < 8; ++e) { const int k = 8 * cg + e;
                    v4u w; w.x = pk2(val[0][e] * beg[0], val[1][e] * beg[1]); w.y = pk2(val[2][e] * beg[2], val[3][e] * beg[3]); w.z = pk2(val[4][e] * beg[4], val[5][e] * beg[5]); w.w = pk2(val[6][e] * beg[6], val[7][e] * beg[7]);
                    *(LAS v4u*)(L + P2_KBT + k * TS + ((rg ^ (cg & 7)) * 16)) = w;
                    w.x = pk2(val[0][e] * egl[0], val[1][e] * egl[1]); w.y = pk2(val[2][e] * egl[2], val[3][e] * egl[3]); w.z = pk2(val[4][e] * egl[4], val[5][e] * egl[5]); w.w = pk2(val[6][e] * egl[6], val[7][e] * egl[7]);
                    *(LAS v4u*)(L + P2_KDT + k * TS + ((rg ^ (cg & 7)) * 16)) = w; }
            } else {
                float be[8];
#pragma unroll
                for (int i = 0; i < 8; ++i) be[i] = SC[64 + 8 * rg + i];
#pragma unroll
                for (int e = 0; e < 8; ++e) { const int k = 8 * cg + e;
                    v4u w; w.x = pk2(val[0][e] * be[0], val[1][e] * be[1]); w.y = pk2(val[2][e] * be[2], val[3][e] * be[3]); w.z = pk2(val[4][e] * be[4], val[5][e] * be[5]); w.w = pk2(val[6][e] * be[6], val[7][e] * be[7]);
                    *(LAS v4u*)(L + P2_VBT + k * TS + ((rg ^ (cg & 7)) * 16)) = w; }
            }
        }
        __syncthreads();
        {
            const int mq = wave >> 2, tm = (wave >> 1) & 1, tn = wave & 1, r = lane & 31, hh = lane >> 5;
            f32x16 acc; for (int i = 0; i < 16; ++i) acc[i] = 0.f;
            if (tm >= tn) {
                LAS unsigned char* ab = L + (mq ? P2_QN : P2_KN) + (32 * tm + r) * RS + hh * 16; LAS unsigned char* bb = L + P2_KN + (32 * tn + r) * RS + hh * 16;
#pragma unroll
                for (int s = 0; s < 8; ++s) acc = MFMA32(*(const LAS bf16x8*)(ab + 32 * s), *(const LAS bf16x8*)(bb + 32 * s), acc);
            }
            const int tc = 32 * tn + r; const float gc = SC[tc];
#pragma unroll
            for (int i = 0; i < 16; ++i) { const int t = 32 * tm + crow(i, hh); const float dec = __expf(SC[t] - gc);
                if (mq == 0) { const float av = (t > tc) ? SC[64 + t] * acc[i] * dec : 0.f; *(LAS float*)(L + P2_AM + t * RS + tc * 4) = av;
                    if (tm == 1 && tn == 0) *(LAS bf16*)(L + P2_AB21 + (t - 32) * 80 + tc * 2) = f2bf(av); }
                else *(LAS bf16*)(L + P2_QKM + t * TS + tc * 2) = f2bf((t >= tc) ? acc[i] * dec : 0.f); }
        }
        __syncthreads();
        if (wave == 7) {
            const int half = lane >> 5, cb = lane & 31;
            float X[32];
#pragma unroll
            for (int i = 0; i < 32; ++i) X[i] = 0.f;
            const LAS unsigned char* am = L + P2_AM + (32 * half) * RS + (32 * half) * 4;
            f32x4 cu[8]; float cdg = *(const LAS float*)(am + 1 * RS + cb * 4);
            cu[0] = *(const LAS f32x4*)(am + 1 * RS);
#pragma unroll
            for (int i = 1; i < 32; ++i) {
                f32x4 nx[8]; float ndg = 0.f;
                if (i + 1 < 32) {
#pragma unroll
                    for (int j4 = 0; j4 < (i + 4) / 4; ++j4) nx[j4] = *(const LAS f32x4*)(am + (i + 1) * RS + j4 * 16);
                    ndg = *(const LAS float*)(am + (i + 1) * RS + cb * 4);
                }
                __builtin_amdgcn_sched_barrier(0);
                float a0 = -cdg, a1 = 0.f, a2 = 0.f, a3 = 0.f;
#pragma unroll
                for (int j4 = 0; j4 < (i + 3) / 4; ++j4) { a0 -= cu[j4].x * X[4 * j4]; a1 -= cu[j4].y * X[4 * j4 + 1]; a2 -= cu[j4].z * X[4 * j4 + 2]; a3 -= cu[j4].w * X[4 * j4 + 3]; }
                X[i] = (a0 + a1) + (a2 + a3);
                __builtin_amdgcn_sched_barrier(0);
                if (i + 1 < 32) {
#pragma unroll
                    for (int j4 = 0; j4 < (i + 4) / 4; ++j4) cu[j4] = nx[j4];
                    cdg = ndg;
                }
            }
            LAS unsigned char* tm = L + P2_TM;
#pragma unroll
            for (int i = 0; i < 32; ++i) *(LAS bf16*)(tm + (32 * half + i) * TS + lane * 2) = f2bf(X[i]);
            if (half == 0) {
#pragma unroll
                for (int i = 0; i < 32; ++i) *(LAS bf16*)(tm + i * TS + (32 + cb) * 2) = (bf16)0;
            }
            LDS_WAIT(); asm volatile("" ::: "memory");
            *(LAS bf16*)(tm + lane * TS + lane * 2) = (bf16)0x3F80;
            LDS_WAIT(); asm volatile("" ::: "memory");
            {
                const int r = cb, hh = half;
                f32x16 M; for (int i = 0; i < 16; ++i) M[i] = 0.f;
#pragma unroll
                for (int s2 = 0; s2 < 2; ++s2) {
                    const bf16x8 a = *(const LAS bf16x8*)(L + P2_AB21 + r * 80 + (16 * s2 + 8 * hh) * 2);
                    unsigned short e[8];
#pragma unroll
                    for (int j = 0; j < 8; ++j) e[j] = *(const LAS bf16*)(tm + (16 * s2 + 8 * hh + j) * TS + r * 2);
                    v4u bw; bw.x = e[0] | ((unsigned)e[1] << 16); bw.y = e[2] | ((unsigned)e[3] << 16); bw.z = e[4] | ((unsigned)e[5] << 16); bw.w = e[6] | ((unsigned)e[7] << 16);
                    M = MFMA32(a, __builtin_bit_cast(bf16x8, bw), M);
                }
                f32x16 T21; for (int i = 0; i < 16; ++i) T21[i] = 0.f;
#pragma unroll
                for (int s2 = 0; s2 < 2; ++s2) {
                    const LAS unsigned char* src = tm + (32 + r) * TS + (32 + 16 * s2 + 4 * hh) * 2;
                    const v2u lo = *(const LAS v2u*)src, hi = *(const LAS v2u*)(src + 16);
                    v4u aw; aw.x = lo.x; aw.y = lo.y; aw.z = hi.x; aw.w = hi.y;
                    T21 = MFMA32(__builtin_bit_cast(bf16x8, aw), pack_step(M, s2), T21);
                }
#pragma unroll
                for (int i = 0; i < 16; ++i) *(LAS bf16*)(tm + (32 + crow(i, hh)) * TS + r * 2) = f2bf(-T21[i]);
            }
            P2_KILL();
        } else if (wave == 6) {
            const int r = lane & 31, hh = lane >> 5;
            for (int f = 0; f < 40; ++f) {
                LAS unsigned char* src; LAS unsigned char* src_hi = nullptr; unsigned char* dst;
                if (f < 16)      { src = L + P2_QDI + (32 * (f >> 3) + r) * RS + (16 * (f & 7) + 4 * hh) * 2; dst = QKV + inplace_off(xr0, 0, h, f, lane); }
                else if (f < 32) { const int g = f - 16, k = 32 * (g >> 2) + r, sw = (k >> 3) & 7; src = L + P2_KDT + k * TS + (((2 * (g & 3)) ^ sw) * 16) + 8 * hh; src_hi = L + P2_KDT + k * TS + (((2 * (g & 3) + 1) ^ sw) * 16) + 8 * hh; dst = QKV + inplace_off(xr0, 1, h, g, lane); }
                else             { const int g = f - 32; src = L + P2_QKM + (32 * (g >> 2) + r) * TS + (16 * (g & 3) + 4 * hh) * 2; dst = CLX + (size_t)cid * 24576 + 16384 + g * 1024 + lane * 16; }
                if (!(f >= 16 && f < 32)) src_hi = src + 16;
                const v2u lo = *(const LAS v2u*)src, hi = *(const LAS v2u*)src_hi;
                v4u w; w.x = lo.x; w.y = lo.y; w.z = hi.x; w.w = hi.y;
                *(v4u*)dst = w;
            }
            P2_KILL();
        } else if (cid + F.G < NCHUNKS) {
            P2_S0S1(cid + F.G, tid);
            if (cid + 2 * F.G < NCHUNKS) P2_PREFETCH(cid + 2 * F.G);
        }
        __syncthreads();
        f32x16 accW, accU;
        {
            const int tm = wave >> 2, tn = wave & 3, r = lane & 31, hh = lane >> 5;
            for (int i = 0; i < 16; ++i) { accW[i] = 0.f; accU[i] = 0.f; }
            LAS unsigned char* ab = L + P2_TM + (32 * tm + r) * TS + hh * 16; const int kr = 32 * tn + r, sw = (kr >> 3) & 7; LAS unsigned char* bk = L + P2_KBT + kr * TS; LAS unsigned char* bv = L + P2_VBT + kr * TS;
#pragma unroll
            for (int s = 0; s < 4; ++s) { const bf16x8 a = *(const LAS bf16x8*)(ab + 32 * s); const int co = ((2 * s + hh) ^ sw) * 16;
                accW = MFMA32(a, *(const LAS bf16x8*)(bk + co), accW); accU = MFMA32(a, *(const LAS bf16x8*)(bv + co), accU); }
        }
        __syncthreads();
        {
            const int tm = wave >> 2, tn = wave & 3, r = lane & 31, hh = lane >> 5;
#pragma unroll
            for (int i = 0; i < 16; ++i) { const int t = 32 * tm + crow(i, hh), n = 32 * tn + r;
                *(LAS bf16*)(L + P2_KBT + t * RS + n * 2) = f2bf(-accW[i]); *(LAS bf16*)(L + P2_VBT + t * RS + n * 2) = f2bf(accU[i]); }
        }
        __syncthreads();
        {
            const int r = lane & 31, hh = lane >> 5;
            for (int f = wave; f < 32; f += 8) {
                if (f < 16) {
                    LAS unsigned char* src = L + P2_KBT + (32 * (f >> 3) + r) * RS + (16 * (f & 7) + 4 * hh) * 2;
                    const v2u lo = *(const LAS v2u*)src, hi = *(const LAS v2u*)(src + 16);
                    v4u w; w.x = lo.x; w.y = lo.y; w.z = hi.x; w.w = hi.y;
                    *(v4u*)(CLX + (size_t)cid * 24576 + f * 1024 + lane * 16) = w;
                } else {
                    const int g = f - 16, s = g >> 2, mt = (g >> 1) & 1, p = g & 1;
                    unsigned short v[8];
#pragma unroll
                    for (int e = 0; e < 8; ++e) { const int t = 32 * mt + crow(8 * p + e, hh); v[e] = *(const LAS bf16*)(L + P2_VBT + t * RS + (32 * s + r) * 2); }
                    v4u w; w.x = v[0] | ((unsigned)v[1] << 16); w.y = v[2] | ((unsigned)v[3] << 16); w.z = v[4] | ((unsigned)v[5] << 16); w.w = v[6] | ((unsigned)v[7] << 16);
                    *(v4u*)(QKV + inplace_off(xr0, 2, h, g, lane)) = w;
                }
            }
        }
        __syncthreads();
    }
}

constexpr int SC_BUF = 61440;
__device__ __forceinline__ void scan_issue(Frame& F, int b, int h, int s, int c, LAS unsigned char* buf) {
    const int lane = F.lane, cid = (b * NH + h) * NCH + c, xr0 = b * LX + 64 * c;
    const unsigned char* QKV = F.ws + WS_QKV; const unsigned char* clx = F.ws + WS_CLX + (size_t)cid * 24576 + lane * 16;
#pragma unroll
    for (int f = 0; f < 16; ++f) __builtin_amdgcn_global_load_lds((const unsigned*)(clx + f * 1024), (LAS unsigned*)(buf + f * 1024), 16, 0, 0);
#pragma unroll
    for (int f = 0; f < 16; ++f) __builtin_amdgcn_global_load_lds((const unsigned*)(QKV + inplace_off(xr0, 0, h, f, lane)), (LAS unsigned*)(buf + 16384 + f * 1024), 16, 0, 0);
#pragma unroll
    for (int f = 0; f < 16; ++f) __builtin_amdgcn_global_load_lds((const unsigned*)(QKV + inplace_off(xr0, 1, h, f, lane)), (LAS unsigned*)(buf + 32768 + f * 1024), 16, 0, 0);
#pragma unroll
    for (int f = 0; f < 8; ++f) __builtin_amdgcn_global_load_lds((const unsigned*)(clx + 16384 + f * 1024), (LAS unsigned*)(buf + 49152 + f * 1024), 16, 0, 0);
#pragma unroll
    for (int f = 0; f < 4; ++f) __builtin_amdgcn_global_load_lds((const unsigned*)(QKV + inplace_off(xr0, 2, h, 4 * s + f, lane)), (LAS unsigned*)(buf + 57344 + f * 1024), 16, 0, 0);
}
#define DSR(dst, base, off) asm volatile("ds_read_b128 %0, %1" : "=v"(dst) : "v"((unsigned)(size_t)(base) + (unsigned)(off)))
#define LWAIT4(n, g) asm volatile("s_waitcnt lgkmcnt(" #n ")" : "+v"(g[0]), "+v"(g[1]), "+v"(g[2]), "+v"(g[3]))
#define LWAIT6(n, g) asm volatile("s_waitcnt lgkmcnt(" #n ")" : "+v"(g[0]), "+v"(g[1]), "+v"(g[2]), "+v"(g[3]), "+v"(g[4]), "+v"(g[5]))
#define BF8(x) __builtin_bit_cast(bf16x8, x)
__device__ __forceinline__ void p3_scan(Frame& F) {
    if (F.wave != 0) return;
    const int lane = F.lane, r = lane & 31, hh = lane >> 5;
    const float* CD = (const float*)(F.ws + WS_CD); bf16* O = (bf16*)(F.ws + WS_O);
    for (int task = F.vcu; task < BATCH * NH * 4; task += F.G) {
        const int s = task & 3, bh = task >> 2, h = bh & 7, b = bh >> 3;
        f32x16 S[4];
#pragma unroll
        for (int kt = 0; kt < 4; ++kt) for (int i = 0; i < 16; ++i) S[kt][i] = 0.f;
        const float cdv = (lane < NCH) ? CD[(b * NH + h) * NCH + lane] : 0.f;
        scan_issue(F, b, h, s, 0, F.lds);
        for (int c = 0; c < NCH; ++c) {
            LAS unsigned char* buf = F.lds + (c & 1) * SC_BUF;
            VM_WAIT();
            if (c + 1 < NCH) scan_issue(F, b, h, s, c + 1, F.lds + ((c + 1) & 1) * SC_BUF);
            const float cd = __builtin_bit_cast(float, __builtin_amdgcn_readlane(__builtin_bit_cast(int, cdv), c));
            const LAS unsigned char* fb = buf + lane * 16;
            v4u G[3][6];
#define ISSUE1(ks, g) do { DSR(G[g][0], fb, (0 * 8 + (ks)) * 1024); DSR(G[g][1], fb, (1 * 8 + (ks)) * 1024); DSR(G[g][2], fb, 16384 + (0 * 8 + (ks)) * 1024); DSR(G[g][3], fb, 16384 + (1 * 8 + (ks)) * 1024); } while (0)
            ISSUE1(0, 0); ISSUE1(1, 1);
            f32x16 aV[2], aO[2];
#pragma unroll
            for (int mt = 0; mt < 2; ++mt) {
                const v4u u0 = *(const LAS v4u*)(fb + 57344 + (2 * mt) * 1024), u1 = *(const LAS v4u*)(fb + 57344 + (2 * mt + 1) * 1024);
                aV[mt][0] = bflo(u0.x); aV[mt][1] = bfhi(u0.x); aV[mt][2] = bflo(u0.y); aV[mt][3] = bfhi(u0.y); aV[mt][4] = bflo(u0.z); aV[mt][5] = bfhi(u0.z); aV[mt][6] = bflo(u0.w); aV[mt][7] = bfhi(u0.w);
                aV[mt][8] = bflo(u1.x); aV[mt][9] = bfhi(u1.x); aV[mt][10] = bflo(u1.y); aV[mt][11] = bfhi(u1.y); aV[mt][12] = bflo(u1.z); aV[mt][13] = bfhi(u1.z); aV[mt][14] = bflo(u1.w); aV[mt][15] = bfhi(u1.w);
                for (int i = 0; i < 16; ++i) aO[mt][i] = 0.f;
            }
            LDS_WAIT();
#pragma unroll
            for (int ks = 0; ks < 8; ++ks) {
                const int g = ks % 3;
                if (ks + 2 < 8) { ISSUE1(ks + 2, (ks + 2) % 3); LWAIT4(8, G[g]); }
                else if (ks + 1 < 8) { LWAIT4(4, G[g]); }
                else { LWAIT4(0, G[g]); }
                const bf16x8 sb = pack_step(S[ks >> 1], ks & 1);
                aV[0] = MFMA32(BF8(G[g][0]), sb, aV[0]); aV[1] = MFMA32(BF8(G[g][1]), sb, aV[1]);
                aO[0] = MFMA32(BF8(G[g][2]), sb, aO[0]); aO[1] = MFMA32(BF8(G[g][3]), sb, aO[1]);
            }
#define ISSUE2(ts, g) do { DSR(G[g][0], fb, 32768 + (0 * 4 + (ts)) * 1024); DSR(G[g][1], fb, 32768 + (1 * 4 + (ts)) * 1024); DSR(G[g][2], fb, 32768 + (2 * 4 + (ts)) * 1024); DSR(G[g][3], fb, 32768 + (3 * 4 + (ts)) * 1024); \
                               DSR(G[g][4], fb, 49152 + (0 * 4 + (ts)) * 1024); DSR(G[g][5], fb, 49152 + (1 * 4 + (ts)) * 1024); } while (0)
            ISSUE2(0, 2);
            bf16x8 Vb[2][2];
#pragma unroll
            for (int mt = 0; mt < 2; ++mt) { Vb[mt][0] = pack_step(aV[mt], 0); Vb[mt][1] = pack_step(aV[mt], 1); }
#pragma unroll
            for (int kt = 0; kt < 4; ++kt) S[kt] = S[kt] * cd;
#pragma unroll
            for (int ts = 0; ts < 4; ++ts) {
                const int g = (ts + 2) % 3;
                if (ts + 1 < 4) { ISSUE2(ts + 1, (ts + 3) % 3); LWAIT6(6, G[g]); }
                else { LWAIT6(0, G[g]); }
#pragma unroll
                for (int kt = 0; kt < 4; ++kt) S[kt] = MFMA32(BF8(G[g][kt]), Vb[ts >> 1][ts & 1], S[kt]);
                aO[0] = MFMA32(BF8(G[g][4]), Vb[ts >> 1][ts & 1], aO[0]); aO[1] = MFMA32(BF8(G[g][5]), Vb[ts >> 1][ts & 1], aO[1]);
            }
#undef ISSUE1
#undef ISSUE2
            if (c > 0) {
                bf16* orow = O + (size_t)(b * SEQ + 64 * (c - 1)) * D + h * HD + 32 * s + r;
#pragma unroll
                for (int mt = 0; mt < 2; ++mt)
#pragma unroll
                    for (int i = 0; i < 16; ++i) orow[(size_t)(32 * mt + crow(i, hh)) * D] = f2bf(aO[mt][i]);
            }
        }
        VM_WAIT();
    }
}

__device__ __forceinline__ void load16(const bf16* p, float (&v)[16]) {
    const v4u a = *(const v4u*)p, b = *(const v4u*)(p + 8);
    v[0] = bflo(a.x); v[1] = bfhi(a.x); v[2] = bflo(a.y); v[3] = bfhi(a.y); v[4] = bflo(a.z); v[5] = bfhi(a.z); v[6] = bflo(a.w); v[7] = bfhi(a.w);
    v[8] = bflo(b.x); v[9] = bfhi(b.x); v[10] = bflo(b.y); v[11] = bfhi(b.y); v[12] = bflo(b.z); v[13] = bfhi(b.z); v[14] = bflo(b.w); v[15] = bfhi(b.w);
}
__device__ __forceinline__ void p5_merge(Frame& F) {
    const int gw = F.vcu * NWAVES + F.wave, NGW = F.G * NWAVES, lane = F.lane;
    const bf16* O = (const bf16*)(F.ws + WS_O); const bf16* PM = (const bf16*)(F.ws + WS_PM); const bf16* ZS = (const bf16*)(F.ws + WS_ZS);
    const bf16* GP = (const bf16*)(F.ws + WS_GP); const bf16* GD = (const bf16*)(F.ws + WS_GD); bf16* MG = (bf16*)(F.ws + WS_MERGED);
    const int n0 = 16 * lane, win = 2 << (lane >> 4); const float rwin = 1.f / (float)win;
    float psc[16], dnw[16];
#pragma unroll
    for (int e = 0; e < 16; ++e) { psc[e] = F.pool_scale[n0 + e]; dnw[e] = F.dn_norm_w[(n0 + e) & 127]; }
    for (int r0 = gw * 8; r0 < MR; r0 += NGW * 8) {
        v4u nO[2], nZ[2], nP[2], nD[2], nM[2];
#define P5_LOAD(r) do { const size_t o_ = (size_t)(r) * D + n0; const size_t x_ = (size_t)xrow_of(r) * D + n0; \
            nO[0] = *(const v4u*)(O + o_); nO[1] = *(const v4u*)(O + o_ + 8); nZ[0] = *(const v4u*)(ZS + o_); nZ[1] = *(const v4u*)(ZS + o_ + 8); \
            nP[0] = *(const v4u*)(GP + o_); nP[1] = *(const v4u*)(GP + o_ + 8); nD[0] = *(const v4u*)(GD + o_); nD[1] = *(const v4u*)(GD + o_ + 8); \
            nM[0] = *(const v4u*)(PM + x_); nM[1] = *(const v4u*)(PM + x_ + 8); } while (0)
#define P5_UNPK(dst, src) do { dst[0] = bflo(src[0].x); dst[1] = bfhi(src[0].x); dst[2] = bflo(src[0].y); dst[3] = bfhi(src[0].y); dst[4] = bflo(src[0].z); dst[5] = bfhi(src[0].z); dst[6] = bflo(src[0].w); dst[7] = bfhi(src[0].w); \
            dst[8] = bflo(src[1].x); dst[9] = bfhi(src[1].x); dst[10] = bflo(src[1].y); dst[11] = bfhi(src[1].y); dst[12] = bflo(src[1].z); dst[13] = bfhi(src[1].z); dst[14] = bflo(src[1].w); dst[15] = bfhi(src[1].w); } while (0)
        P5_LOAD(r0);
#pragma unroll 1
        for (int rr = 0; rr < 8; ++rr) {
            const int r = r0 + rr, xr = xrow_of(r);
            float o[16], z[16], gp[16], gd[16], pm[16], sum[16];
            P5_UNPK(o, nO); P5_UNPK(z, nZ); P5_UNPK(gp, nP); P5_UNPK(gd, nD); P5_UNPK(pm, nM);
            if (rr < 7) P5_LOAD(r + 1);
#pragma unroll
            for (int e = 0; e < 16; ++e) sum[e] = pm[e];
            for (int j = 1; j < win; ++j) { float t[16]; load16(PM + (size_t)(xr - j) * D + n0, t);
#pragma unroll
                for (int e = 0; e < 16; ++e) sum[e] += t[e]; }
            float ss = 0.f;
#pragma unroll
            for (int e = 0; e < 16; ++e) ss += o[e] * o[e];
            ss += __shfl_xor(ss, 1); ss += __shfl_xor(ss, 2); ss += __shfl_xor(ss, 4);
            const float rstd = __builtin_amdgcn_rsqf(ss * (1.f / HD) + EPS);
            float m[16];
#pragma unroll
            for (int e = 0; e < 16; ++e) m[e] = gp[e] * psc[e] * (sum[e] * rwin - pm[e]) + gd[e] * (o[e] * rstd * dnw[e]) * z[e];
            v4u w0, w1; w0.x = pk2(m[0], m[1]); w0.y = pk2(m[2], m[3]); w0.z = pk2(m[4], m[5]); w0.w = pk2(m[6], m[7]);
            w1.x = pk2(m[8], m[9]); w1.y = pk2(m[10], m[11]); w1.z = pk2(m[12], m[13]); w1.w = pk2(m[14], m[15]);
            *(v4u*)(MG + (size_t)r * D + n0) = w0; *(v4u*)(MG + (size_t)r * D + n0 + 8) = w1;
        }
    }
}

struct TokRec { int e0, e1, s0, s1; float w0, w1, rstd, pad; };
constexpr int P7_WS = 1032, P7_WH = 0, P7_WL = 74304, P7_LG = 148608, P7_LGS = 2624, P7_CNT = P7_LG + 4 * P7_LGS;
__device__ __forceinline__ void p7_router(Frame& F) {
    LAS unsigned char* L = F.lds; const int tid = F.tid, lane = F.lane, wave = F.wave;
    for (int k = tid; k < D; k += NWAVES * 64) {
        const float nwk = F.norm_ffn_w[k]; const f32x4 g4 = *(const f32x4*)(F.rg_w + k * 4);
        f32x4 e4[8];
#pragma unroll
        for (int j = 0; j < 8; ++j) e4[j] = *(const f32x4*)(F.re_w + k * 32 + 4 * j);
#pragma unroll
        for (int o = 0; o < 36; ++o) { const float w = (o < 4 ? g4[o & 3] : e4[(o - 4) >> 2][(o - 4) & 3]) * nwk;
            const unsigned short hi = f2bf(w); const unsigned short lo = f2bf(w - bf2f(hi));
            *(LAS bf16*)(L + P7_WH + (o * P7_WS + k) * 2) = hi; *(LAS bf16*)(L + P7_WL + (o * P7_WS + k) * 2) = lo; }
    }
    LAS int* lcnt = (LAS int*)(L + P7_CNT);
    if (tid < 32) lcnt[tid] = 0;
    __syncthreads();
    const float* H1 = (const float*)(F.ws + WS_H1); TokRec* TOK = (TokRec*)(F.ws + WS_TOK);
    const int task = wave & 3, kh = wave >> 2, m = lane & 15, q = lane >> 4, row = 64 * F.vcu + 16 * task + m;
    {
        const float* hp = H1 + (size_t)row * D + 512 * kh + 8 * q;
        f32x4 acc[3] = {{0.f, 0.f, 0.f, 0.f}, {0.f, 0.f, 0.f, 0.f}, {0.f, 0.f, 0.f, 0.f}};
        float ss = 0.f;
        const int orow[3] = {m, 16 + m, (32 + m) < 36 ? 32 + m : 35};
        f32x4 av[32];
#pragma unroll
        for (int s = 0; s < 16; ++s) { av[2 * s] = *(const f32x4*)(hp + 32 * s); av[2 * s + 1] = *(const f32x4*)(hp + 32 * s + 4); }
#pragma unroll
        for (int s = 0; s < 16; ++s) {
            const f32x4 a0 = av[2 * s], a1 = av[2 * s + 1];
            const float x[8] = {a0.x, a0.y, a0.z, a0.w, a1.x, a1.y, a1.z, a1.w};
            v4u xh, xl; unsigned hh[4], ll[4];
#pragma unroll
            for (int j = 0; j < 4; ++j) { const unsigned ph = pk2(x[2 * j], x[2 * j + 1]); hh[j] = ph; ll[j] = pk2(x[2 * j] - bflo(ph), x[2 * j + 1] - bfhi(ph)); ss += x[2 * j] * x[2 * j] + x[2 * j + 1] * x[2 * j + 1]; }
            xh.x = hh[0]; xh.y = hh[1]; xh.z = hh[2]; xh.w = hh[3]; xl.x = ll[0]; xl.y = ll[1]; xl.z = ll[2]; xl.w = ll[3];
            const int ko = 512 * kh + 32 * s + 8 * q;
#pragma unroll
            for (int t = 0; t < 3; ++t) {
                const bf16x8 wh = *(const LAS bf16x8*)(L + P7_WH + (orow[t] * P7_WS + ko) * 2), wl = *(const LAS bf16x8*)(L + P7_WL + (orow[t] * P7_WS + ko) * 2);
                acc[t] = MFMA16(__builtin_bit_cast(bf16x8, xh), wh, acc[t]); acc[t] = MFMA16(__builtin_bit_cast(bf16x8, xl), wh, acc[t]); acc[t] = MFMA16(__builtin_bit_cast(bf16x8, xh), wl, acc[t]);
            }
        }
        ss += __shfl_xor(ss, 16); ss += __shfl_xor(ss, 32);
        LAS float* lg = (LAS float*)(L + P7_LG + task * P7_LGS);
        if (kh == 1) {
#pragma unroll
            for (int t = 0; t < 3; ++t)
#pragma unroll
                for (int i = 0; i < 4; ++i) if (16 * t + m < 36) lg[(4 * q + i) * 40 + 16 * t + m] = acc[t][i];
            if (lane < 16) lg[640 + lane] = ss;
        }
        __syncthreads();
        if (kh == 0) {
#pragma unroll
            for (int t = 0; t < 3; ++t)
#pragma unroll
                for (int i = 0; i < 4; ++i) if (16 * t + m < 36) lg[(4 * q + i) * 40 + 16 * t + m] += acc[t][i];
            if (lane < 16) ss += lg[640 + lane];
            LDS_WAIT(); asm volatile("" ::: "memory");
            if (lane < 16) {
                const float rstd = __builtin_amdgcn_rsqf(ss * (1.f / D) + EPS);
                float gl[4];
#pragma unroll
                for (int o = 0; o < 4; ++o) gl[o] = lg[lane * 40 + o] * rstd + F.rg_b[o];
                int gi = 0; float gm = gl[0];
#pragma unroll
                for (int o = 1; o < 4; ++o) if (gl[o] > gm) { gm = gl[o]; gi = o; }
                float den = 0.f;
#pragma unroll
                for (int o = 0; o < 4; ++o) den += __expf(gl[o] - gm);
                const float pg = 1.f / den;
                float el[8];
#pragma unroll
                for (int e = 0; e < 8; ++e) el[e] = lg[lane * 40 + 4 + 8 * gi + e] * rstd + F.re_b[8 * gi + e];
                int i0 = 0; float m0 = el[0];
#pragma unroll
                for (int e = 1; e < 8; ++e) if (el[e] > m0) { m0 = el[e]; i0 = e; }
                int i1 = -1; float m1 = -3.0e38f;
#pragma unroll
                for (int e = 0; e < 8; ++e) if (e != i0 && el[e] > m1) { m1 = el[e]; i1 = e; }
                const float w0 = 1.f / (1.f + __expf(m1 - m0)), w1 = 1.f - w0;
                const int e0 = gi * 8 + i0, e1 = gi * 8 + i1;
                TokRec t; t.e0 = e0; t.e1 = e1; t.s0 = __hip_atomic_fetch_add(&lcnt[e0], 1, __ATOMIC_RELAXED, __HIP_MEMORY_SCOPE_WORKGROUP); t.s1 = __hip_atomic_fetch_add(&lcnt[e1], 1, __ATOMIC_RELAXED, __HIP_MEMORY_SCOPE_WORKGROUP);
                t.w0 = pg * w0; t.w1 = pg * w1; t.rstd = rstd; t.pad = 0.f;
                TOK[64 * F.vcu + 16 * task + lane] = t;
            }
        }
    }
    __syncthreads();
    if (tid < 32) ((int*)(F.ws + WS_CNT))[F.vcu * 32 + tid] = lcnt[tid];
    __syncthreads();
    const int gw = F.vcu * NWAVES + wave, NGW = F.G * NWAVES;
    LAS float* scr = (LAS float*)(L + wave * 8448);
    bf16* BTGU = (bf16*)(F.ws + WS_BTGU); bf16* BTDN = (bf16*)(F.ws + WS_BTDN);
    for (int it = gw; it < NEXP * 512 + NEXP * 256; it += NGW) {
        if (it < NEXP * 512) { const int e = it >> 9, nb = (it >> 4) & 31, kb = it & 15;
            transpose_item_gu(F.w_gate + (size_t)e * D * FF, F.w_up + (size_t)e * D * FF, F.norm_ffn_w, BTGU + (size_t)e * 1024 * D, 32 * nb, 64 * kb, scr, lane); }
        else { const int jt = it - NEXP * 512, e = jt >> 8, nb = (jt >> 3) & 31, kb = jt & 7;
            transpose_item(F.w_down + (size_t)e * FF * D, D, 32 * nb, BTDN + (size_t)e * 1024 * FF, FF, 32 * nb, 64 * kb, scr, lane); }
    }
}

__device__ __forceinline__ void p8_index(Frame& F) {
    LAS int* tot = (LAS int*)F.lds; LAS int* mine = tot + 32; LAS int* base = tot + 64; LAS int* part = tot + 128;
    const int tid = F.tid; const int* CNT = (const int*)(F.ws + WS_CNT);
    { const int e = tid & 31, seg = tid >> 5;
        int st = 0, sm = 0;
        for (int w = seg * 16; w < seg * 16 + 16; ++w) { const int v = CNT[w * 32 + e]; st += v; if (w < F.vcu) sm += v; }
        part[seg * 32 + e] = st; part[512 + seg * 32 + e] = sm; }
    __syncthreads();
    if (tid < 32) { int st = 0, sm = 0; for (int s = 0; s < 16; ++s) { st += part[s * 32 + tid]; sm += part[512 + s * 32 + tid]; } tot[tid] = st; mine[tid] = sm; }
    __syncthreads();
    if (tid == 0) { int acc = 0; for (int e = 0; e < 32; ++e) { base[e] = acc; acc += ((tot[e] + 255) >> 8) << 8; } base[32] = acc; }
    __syncthreads();
    int* ROWIDX = (int*)(F.ws + WS_ROWIDX); float* ROWS = (float*)(F.ws + WS_ROWS); float* ROWW = (float*)(F.ws + WS_ROWW); int* TOKPOS = (int*)(F.ws + WS_TOKPOS);
    const TokRec* TOK = (const TokRec*)(F.ws + WS_TOK);
    if (tid < 128) { const int tk = 64 * F.vcu + (tid >> 1), sl = tid & 1; const TokRec t = TOK[tk];
        const int e = sl ? t.e1 : t.e0, s = sl ? t.s1 : t.s0; const int pos = base[e] + mine[e] + s;
        ROWIDX[pos] = tk; ROWS[pos] = t.rstd; ROWW[pos] = sl ? t.w1 : t.w0; TOKPOS[tk * 2 + sl] = pos; }
    if (F.vcu < 32) { const int e = F.vcu, lo = base[e] + tot[e], hi = base[e + 1];
        for (int p = lo + tid; p < hi; p += NWAVES * 64) { ROWIDX[p] = 0; ROWS[p] = 0.f; ROWW[p] = 0.f; } }
    if (F.vcu == 0 && tid < MAXT + 1) { int* TILEE = (int*)(F.ws + WS_TILEE);
        const int nt = base[32] >> 8;
        if (tid == MAXT) TILEE[MAXT] = nt;
        else { int e = 0; for (int q = 1; q < 32; ++q) if ((base[q] >> 8) <= tid) e = q; TILEE[tid] = (tid < nt) ? e : 0; } }
}

__device__ __forceinline__ void p11_final(Frame& F) {
    const int gw = F.vcu * NWAVES + F.wave, NGW = F.G * NWAVES, lane = F.lane;
    const float* H1 = (const float*)(F.ws + WS_H1); const bf16* Y = (const bf16*)(F.ws + WS_Y); const int* TOKPOS = (const int*)(F.ws + WS_TOKPOS);
    f32x4 nw[4];
#pragma unroll
    for (int j = 0; j < 4; ++j) nw[j] = ((const f32x4*)F.norm_final_w)[64 * j + lane];
    for (int r = gw; r < MR; r += NGW) {
        const int p0 = TOKPOS[r * 2], p1 = TOKPOS[r * 2 + 1];
        const f32x4* hr = (const f32x4*)(H1 + (size_t)r * D) + lane;
        const v2u* y0 = (const v2u*)(Y + (size_t)p0 * D) + lane; const v2u* y1 = (const v2u*)(Y + (size_t)p1 * D) + lane;
        f32x4 v[4]; float s = 0.f;
#pragma unroll
        for (int j = 0; j < 4; ++j) { v[j] = hr[64 * j]; const v2u a = y0[64 * j], b = y1[64 * j];
            v[j].x += bflo(a.x) + bflo(b.x); v[j].y += bfhi(a.x) + bfhi(b.x); v[j].z += bflo(a.y) + bflo(b.y); v[j].w += bfhi(a.y) + bfhi(b.y);
            s += (v[j].x * v[j].x + v[j].y * v[j].y) + (v[j].z * v[j].z + v[j].w * v[j].w); }
        const float rstd = 1.f / sqrtf(wave_sum(s) * (1.f / D) + EPS);
        f32x4* orow = (f32x4*)(F.out + (size_t)r * D) + lane;
#pragma unroll
        for (int j = 0; j < 4; ++j) orow[64 * j] = v[j] * rstd * nw[j];
    }
}

constexpr int NPHASES = 12;
#ifndef MK_ONE_LAUNCH
#define MK_ONE_LAUNCH 1
#endif
struct Args { const float* in[20]; float* out; unsigned char* ws; int ph_lo, ph_hi; };
__global__ void __launch_bounds__(NWAVES * 64, 2) hybrid_fwd(Args args) {
    extern __shared__ __attribute__((aligned(16))) unsigned char lds[];
    Frame F;
    F.lds = (LAS unsigned char*)lds;
    F.MISC = (volatile LAS unsigned*)(F.lds + MISC_OFF);
    F.tid = threadIdx.x; F.lane = F.tid & 63; F.wave = __builtin_amdgcn_readfirstlane(F.tid >> 6);
    F.G = gridDim.x; { const int bx = blockIdx.x; F.vcu = (F.G % 8 == 0) ? (bx % 8) * (F.G / 8) + bx / 8 : bx; }
    F.ws = args.ws; F.out = args.out;
    F.x = args.in[0]; F.meta = args.in[1]; F.norm_mix_w = args.in[2]; F.w_in = args.in[3]; F.conv_w = args.in[4]; F.pool_w = args.in[5]; F.pool_scale = args.in[6];
    F.a_log = args.in[7]; F.dt_bias = args.in[8]; F.dn_norm_w = args.in[9]; F.w_out = args.in[10]; F.norm_ffn_w = args.in[11]; F.rg_w = args.in[12]; F.rg_b = args.in[13];
    F.re_w = args.in[14]; F.re_b = args.in[15]; F.w_gate = args.in[16]; F.w_up = args.in[17]; F.w_down = args.in[18]; F.norm_final_w = args.in[19];
    if (F.tid < 64) F.MISC[F.tid] = 0u;
    __syncthreads();
    const int lo = args.ph_lo, hi = args.ph_hi;
    XcdBarrier bar; bar.bar = (unsigned*)(F.ws + WS_CTL); bar.x = 0; bar.st = nullptr;
    if (hi - lo > 1) bar = xcd_barrier_post((unsigned*)(F.ws + WS_CTL), F.MISC + 8);
#ifndef PHMASK
#define PHMASK 0xFFF
#endif
#define IN(k) ((((PHMASK) >> (k)) & 1) && lo <= (k) && (k) < hi)
#define SEAM(k) do { if (IN(k) && IN((k) + 1)) xcd_barrier(bar); } while (0)

    if (IN(0)) { p0_prologue(F); } SEAM(0);

    if (IN(1)) {
        pg8::Gemm g{(const bf16*)(F.ws + WS_U), (const bf16*)(F.ws + WS_BTIN), MR, 3072, D}; pg8::StaticOrder S; S.init(MR, 3072, F.G, (int)blockIdx.x);
        EpiQKV E{(bf16*)(F.ws + WS_QKV), (bf16*)(F.ws + WS_HALO)};
        pg8::gemm_phase<EpiQKV, pg8::StaticOrder, true, false>(F.lds, g, S, E);
        meta_rows_job(F, (const bf16*)(F.ws + WS_BTIN), 3072, (bf16*)(F.ws + WS_QKV), 3072, (bf16*)(F.ws + WS_HALO));
    } SEAM(1);

    if (IN(2)) { p2_chunk_local(F); } SEAM(2);

    if (IN(3)) { p3_scan(F); } SEAM(3);

    if (IN(4)) {
        pg8::Gemm g{(const bf16*)(F.ws + WS_U), (const bf16*)(F.ws + WS_BTIN) + (size_t)3072 * D, MR, 4096, D}; pg8::StaticOrder S; S.init(MR, 4096, F.G, (int)blockIdx.x);
        EpiPZG E{(bf16*)(F.ws + WS_PM), (bf16*)(F.ws + WS_ZS), (bf16*)(F.ws + WS_GP), (bf16*)(F.ws + WS_GD)};
        pg8::gemm_phase<EpiPZG, pg8::StaticOrder, true, false>(F.lds, g, S, E);
        meta_rows_job(F, (const bf16*)(F.ws + WS_BTIN) + (size_t)3072 * D, 1024, (bf16*)(F.ws + WS_PM), 1024, nullptr);
    } SEAM(4);

    if (IN(5)) { p5_merge(F); } SEAM(5);

    if (IN(6)) {
        pg8::Gemm g{(const bf16*)(F.ws + WS_MERGED), (const bf16*)(F.ws + WS_BTOUT), MR, D, D}; pg8::StaticOrder S; S.init(MR, D, F.G, (int)blockIdx.x);
        EpiOut E{F.x, (float*)(F.ws + WS_H1), (bf16*)(F.ws + WS_XN)};
        pg8::gemm_phase<EpiOut, pg8::StaticOrder, false, false>(F.lds, g, S, E);
    } SEAM(6);

    if (IN(7)) { p7_router(F); } SEAM(7);

    if (IN(8)) { p8_index(F); } SEAM(8);

    if (IN(9) || IN(10)) {
        const int* TILEE = (const int*)(F.ws + WS_TILEE); const int ntiles = TILEE[MAXT];
        LAS int* idx = (LAS int*)(F.lds + 131072);
        if (IN(9)) {
            const int* ROWIDX = (const int*)(F.ws + WS_ROWIDX);
            for (int i = 0; i < 3; ++i) { const int Lu = i * F.G + F.vcu; if (Lu < 4 * ntiles) for (int t = F.tid; t < 256; t += NWAVES * 64) idx[i * 256 + t] = ROWIDX[(Lu >> 2) * 256 + t]; }
            __syncthreads();
            pg8::Gemm g{(const bf16*)(F.ws + WS_XN), (const bf16*)(F.ws + WS_BTGU), 0, 0, D};
            MoeOrder S{ntiles, F.G, F.vcu, TILEE, idx};
            EpiGU E{(bf16*)(F.ws + WS_HDN), (const float*)(F.ws + WS_ROWS)};
            pg8::gemm_phase<EpiGU, MoeOrder, true, true>(F.lds, g, S, E);
        }
        SEAM(9);
        if (IN(10)) {
            pg8::Gemm g{(const bf16*)(F.ws + WS_HDN), (const bf16*)(F.ws + WS_BTDN), 0, 0, FF};
            MoeOrder S{ntiles, F.G, F.vcu, TILEE, idx};
            EpiDown E{(bf16*)(F.ws + WS_Y), (const float*)(F.ws + WS_ROWW)};
            pg8::gemm_phase<EpiDown, MoeOrder, true, false>(F.lds, g, S, E);
        }
    }
    SEAM(10);

    if (IN(11)) { p11_final(F); }
#undef IN
#undef SEAM
}

extern "C" void kernel_launch(void* const* d_in, const int* in_sizes, int n_in, void* d_out, int out_size, void* d_ws, size_t ws_size, hipStream_t stream) {
    static int ready = 0;
    if (ready == 0) {
        if (n_in != 20 || in_sizes[0] != MR * D || out_size != MR * D || ws_size < WS_END) {
            fprintf(stderr, "kernel_launch: unexpected problem (n_in %d, in0 %d, out %d, ws %zu)\n", n_in, n_in > 0 ? in_sizes[0] : -1, out_size, ws_size); ready = -1; return; }
        if (hipFuncSetAttribute((const void*)hybrid_fwd, hipFuncAttributeMaxDynamicSharedMemorySize, LDS_BYTES) != hipSuccess) { fprintf(stderr, "kernel_launch: hipFuncSetAttribute failed\n"); ready = -1; return; }
        int per_cu = 0;
        if (hipOccupancyMaxActiveBlocksPerMultiprocessor(&per_cu, (const void*)hybrid_fwd, NWAVES * 64, LDS_BYTES) != hipSuccess || per_cu < 1)
            fprintf(stderr, "kernel_launch: note: occupancy query reports %d workgroups per CU\n", per_cu);
        (void)hipGetLastError();
        ready = 1;
    }
    if (ready < 0) return;
    (void)hipMemsetAsync((char*)d_ws + WS_CTL, 0, CTL_ZERO_BYTES, stream);
    Args a{};
    for (int i = 0; i < 20; ++i) a.in[i] = (const float*)d_in[i];
    a.out = (float*)d_out; a.ws = (unsigned char*)d_ws;
#if defined(PROBE_LO)
    a.ph_lo = 0; a.ph_hi = PROBE_HI; hipLaunchKernelGGL(hybrid_fwd, dim3(256), dim3(NWAVES * 64), LDS_BYTES, stream, a);
    (void)hipMemsetAsync((char*)d_ws + WS_CTL, 0, CTL_ZERO_BYTES, stream);
    a.ph_lo = PROBE_LO; a.ph_hi = PROBE_HI; hipLaunchKernelGGL(hybrid_fwd, dim3(256), dim3(NWAVES * 64), LDS_BYTES, stream, a);
    (void)hipMemsetAsync((char*)d_ws + WS_CTL, 0, CTL_ZERO_BYTES, stream);
    if (PROBE_HI < NPHASES) { a.ph_lo = PROBE_HI; a.ph_hi = NPHASES; hipLaunchKernelGGL(hybrid_fwd, dim3(256), dim3(NWAVES * 64), LDS_BYTES, stream, a); }
#elif MK_ONE_LAUNCH
    a.ph_lo = 0; a.ph_hi = NPHASES;
    hipLaunchKernelGGL(hybrid_fwd, dim3(256), dim3(NWAVES * 64), LDS_BYTES, stream, a);
#else
    for (int p = 0; p < NPHASES; ++p) { a.ph_lo = p; a.ph_hi = p + 1; hipLaunchKernelGGL(hybrid_fwd, dim3(256), dim3(NWAVES * 64), LDS_BYTES, stream, a); }
#endif
}
```

```cpp
#include <hip/hip_runtime.h>
#include <cstdio>
#include <cstdint>

namespace pg8 {
#define PG8_LAS __attribute__((address_space(3)))
typedef unsigned short bf16_t;
typedef short bf16x8 __attribute__((ext_vector_type(8)));
typedef float f32x4 __attribute__((ext_vector_type(4)));
typedef unsigned u32x4 __attribute__((ext_vector_type(4)));
typedef unsigned u32x2 __attribute__((ext_vector_type(2)));
constexpr int BM = 256, BK = 64, HALF = 128, HTB = HALF * BK * 2  , STAGE_BYTES = 8 * HTB, NXCD = 8, WGM = 8;

__host__ __device__ __forceinline__ int lds_byte(int r, int c) { const int st = (r >> 4) * 2 + (c >> 5), rr = r & 15, cc = c & 31, ob = rr * 64 + cc * 2; return st * 1024 + (ob ^ (((ob >> 9) & 1) << 5)); }
__host__ __device__ __forceinline__ void stage_rc(int b, int& R, int& C) { const int st = b / 1024, sb = b % 1024, swz = sb ^ (((sb >> 9) & 1) << 5); R = (st >> 1) * 16 + swz / 64; C = (st & 1) * 32 + (swz % 64) / 2; }
__host__ __device__ __forceinline__ int perm32(int rho) { const int n = rho >> 4, i = rho & 15; return 8 * (i >> 2) + 4 * n + (i & 3); }

struct Unit { int pm, pn; };
struct Gemm { const bf16_t* A; const bf16_t* Bt; int M, N, K; };

struct StaticOrder {
    int nM, nN, nwg, G, c;
    __host__ __device__ void init(int M, int N, int G_, int c_) { nM = M / BM; nN = N / BM; nwg = nM * nN; G = G_; c = c_; }
    __host__ __device__ bool next(int i, Unit& u) const {
        const long L = (long)i * G + c; if (L >= nwg) return false;
        int wgid = (int)L; { const int q = nwg / NXCD, r = nwg % NXCD, xcd = wgid % NXCD, off = wgid / NXCD; wgid = (xcd < r ? xcd * (q + 1) : r * (q + 1) + (xcd - r) * q) + off; }
        const int nig = WGM * nN, gid = wgid / nig, fm = gid * WGM, gsz = (nM - fm) < WGM ? (nM - fm) : WGM;
        u.pm = fm + ((wgid % nig) % gsz); u.pn = (wgid % nig) / gsz; return true;
    }
    __device__ __forceinline__ int gather_row(const Unit&, int) const { return 0; }
};

template <class Epi, class Sched, bool ALIGN_EPI, bool GATHER>
__device__ __forceinline__ void gemm_phase(PG8_LAS unsigned char* lds, const Gemm g, const Sched& S, const Epi& E) {
    const int tid = threadIdx.x, wid = __builtin_amdgcn_readfirstlane(tid >> 6), lane = tid & 63, wr = wid >> 2, wc = wid & 3, fr = lane & 15, fq = lane >> 4;
    const int K = g.K, nt = K / BK;
    unsigned voffA[2], voffB[2]; int RA[2], CA[2];
#pragma unroll
    for (int i = 0; i < 2; ++i) { int R, C; stage_rc(tid * 16 + i * 8192, R, C); const int Rb = Epi::PERM ? ((R & ~31) + perm32(R & 31)) : R;
        RA[i] = R; CA[i] = C; voffA[i] = (unsigned)(R * K + C) * 2u; voffB[i] = (unsigned)(Rb * K + C) * 2u; }
    const size_t kstep = (size_t)(BK * 2);
    const size_t hstep = (size_t)HALF * K * 2;
    const size_t tstep = 2 * hstep;
    const unsigned ldsw = (unsigned)wid * 1024u;
    const int aoff = lds_byte(wr * 64 + fr, fq * 8), boff = lds_byte(wc * 32 + fr, fq * 8);
#define PG8_SA(b, h) (((b) * 2 + (h)) * HTB)
#define PG8_SB(b, h) ((4 + (b) * 2 + (h)) * HTB)
#define PG8_STAGE(bufoff, gbase, voff) do { _Pragma("unroll") for (int _i = 0; _i < 2; ++_i) \
        __builtin_amdgcn_global_load_lds((const unsigned*)((const char*)(gbase) + (voff)[_i]), (PG8_LAS unsigned*)(lds + (bufoff) + ldsw + _i * 8192), 16, 0, 0); } while (0)
#define PG8_STAGE_A(b, h, gbase, NEXT) do { if constexpr (GATHER) { unsigned _vo[2] = { (NEXT) ? nvo[h][0] : cvo[h][0], (NEXT) ? nvo[h][1] : cvo[h][1] }; PG8_STAGE(PG8_SA(b, h), (gbase), _vo); } \
        else { PG8_STAGE(PG8_SA(b, h), (gbase) + (h) * hstep, voffA); } } while (0)
#define PG8_LDA(dst, b, h) do { _Pragma("unroll") for (int m = 0; m < 4; ++m) _Pragma("unroll") for (int k = 0; k < 2; ++k) dst[m][k] = *(const PG8_LAS bf16x8*)(lds + PG8_SA(b, h) + aoff + m * 2048 + k * 1024); } while (0)
#define PG8_LDB(dst, b, h) do { _Pragma("unroll") for (int n = 0; n < 2; ++n) _Pragma("unroll") for (int k = 0; k < 2; ++k) dst[n][k] = *(const PG8_LAS bf16x8*)(lds + PG8_SB(b, h) + boff + n * 2048 + k * 1024); } while (0)
#define PG8_MMA(ai, bj, At, Bt) do { __builtin_amdgcn_s_setprio(1); _Pragma("unroll") for (int m = 0; m < 4; ++m) _Pragma("unroll") for (int n = 0; n < 2; ++n) _Pragma("unroll") for (int k = 0; k < 2; ++k) \
        acc[ai][bj][m][n] = __builtin_amdgcn_mfma_f32_16x16x32_bf16(Bt[n][k], At[m][k], acc[ai][bj][m][n], 0, 0, 0); __builtin_amdgcn_s_setprio(0); } while (0)
#define PG8_WAIT_V(n) asm volatile("s_waitcnt vmcnt(" #n ")" ::: "memory")
#define PG8_WAIT_L(n) asm volatile("s_waitcnt lgkmcnt(" #n ")" ::: "memory")
#define PG8_BAR __builtin_amdgcn_s_barrier()
#define PG8_SCHED __builtin_amdgcn_sched_barrier(0)
    Unit cur, nxt; int ui = 0;
    if (!S.next(0, cur)) return;
    f32x4 acc[2][2][4][2];
#pragma unroll
    for (int a = 0; a < 2; ++a)
#pragma unroll
        for (int b = 0; b < 2; ++b)
#pragma unroll
            for (int m = 0; m < 4; ++m)
#pragma unroll
                for (int n = 0; n < 2; ++n) acc[a][b][m][n] = (f32x4){0.f, 0.f, 0.f, 0.f};
    bf16x8 At[4][2], B0[2][2], B1[2][2];
    unsigned cvo[2][2] = {{0u, 0u}, {0u, 0u}}, nvo[2][2] = {{0u, 0u}, {0u, 0u}};
    if constexpr (GATHER) {
#pragma unroll
        for (int h = 0; h < 2; ++h)
#pragma unroll
            for (int i = 0; i < 2; ++i) cvo[h][i] = (unsigned)(S.gather_row(cur, h * HALF + RA[i]) * K + CA[i]) * 2u;
    }
    const char* cA = GATHER ? (const char*)g.A : (const char*)g.A + (size_t)cur.pm * tstep; const char* cB = (const char*)g.Bt + (size_t)cur.pn * tstep;
    PG8_STAGE(PG8_SB(0, 0), cB, voffB); PG8_STAGE(PG8_SB(0, 1), cB + hstep, voffB); PG8_STAGE_A(0, 0, cA, false); PG8_STAGE_A(0, 1, cA, false);
    if (wr == 1) PG8_BAR;
    PG8_WAIT_V(2); PG8_BAR;
    PG8_STAGE(PG8_SB(1, 0), cB + kstep, voffB); PG8_STAGE_A(1, 0, cA + kstep, false); PG8_STAGE(PG8_SB(1, 1), cB + hstep + kstep, voffB);
    PG8_WAIT_V(6); PG8_BAR;
    for (;;) {
        const bool has_next = S.next(ui + 1, nxt);
        const char* nA = GATHER ? (const char*)g.A : (has_next ? (const char*)g.A + (size_t)nxt.pm * tstep : cA);
        const char* nB = has_next ? (const char*)g.Bt + (size_t)nxt.pn * tstep : cB;
        for (int t = 0; t < nt; t += 2) {
            const bool last = (t == nt - 2);
            const char* a1 = cA + (size_t)(t + 1) * kstep;
            const char* a2 = last ? nA : cA + (size_t)(t + 2) * kstep; const char* b2 = last ? nB : cB + (size_t)(t + 2) * kstep;
            const char* a3 = a2 + kstep; const char* b3 = b2 + kstep;
            if constexpr (GATHER) { if (last) {
#pragma unroll
                for (int h = 0; h < 2; ++h)
#pragma unroll
                    for (int i = 0; i < 2; ++i) nvo[h][i] = has_next ? (unsigned)(S.gather_row(nxt, h * HALF + RA[i]) * K + CA[i]) * 2u : cvo[h][i];
            } }
            PG8_LDB(B0, 0, 0); PG8_LDB(B1, 0, 1); PG8_SCHED; PG8_LDA(At, 0, 0); PG8_STAGE_A(1, 1, a1, false);
            PG8_WAIT_V(8); PG8_WAIT_L(0); PG8_BAR; PG8_MMA(0, 0, At, B0); PG8_MMA(0, 1, At, B1); PG8_BAR; PG8_SCHED;
            PG8_LDA(At, 0, 1); PG8_STAGE(PG8_SB(0, 0), b2, voffB); PG8_STAGE(PG8_SB(0, 1), b2 + hstep, voffB); PG8_STAGE_A(0, 0, a2, last);
            PG8_WAIT_V(8); PG8_WAIT_L(0); PG8_BAR; PG8_MMA(1, 0, At, B0); PG8_MMA(1, 1, At, B1); PG8_BAR; PG8_SCHED;
            PG8_LDB(B0, 1, 0); PG8_LDB(B1, 1, 1); PG8_SCHED; PG8_LDA(At, 1, 0); PG8_STAGE_A(0, 1, a2, last);
            PG8_WAIT_V(8); PG8_WAIT_L(0); PG8_BAR; PG8_MMA(0, 0, At, B0); PG8_MMA(0, 1, At, B1); PG8_BAR; PG8_SCHED;
            PG8_LDA(At, 1, 1); PG8_STAGE(PG8_SB(1, 0), b3, voffB); PG8_STAGE(PG8_SB(1, 1), b3 + hstep, voffB); PG8_STAGE_A(1, 0, a3, last);
            PG8_WAIT_V(8); PG8_WAIT_L(0); PG8_BAR; PG8_MMA(1, 0, At, B0); PG8_MMA(1, 1, At, B1); PG8_BAR; PG8_SCHED;
        }
        if constexpr (ALIGN_EPI) { if (wr == 0) PG8_BAR; }
        E(acc, cur, wr, wc, fr, fq);
        if (!has_next) break;
#pragma unroll
        for (int a = 0; a < 2; ++a)
#pragma unroll
            for (int b = 0; b < 2; ++b)
#pragma unroll
                for (int m = 0; m < 4; ++m)
#pragma unroll
                    for (int n = 0; n < 2; ++n) acc[a][b][m][n] = (f32x4){0.f, 0.f, 0.f, 0.f};
        cur = nxt; cA = nA; cB = nB; ++ui;
        if constexpr (GATHER) {
#pragma unroll
            for (int h = 0; h < 2; ++h)
#pragma unroll
                for (int i = 0; i < 2; ++i) cvo[h][i] = nvo[h][i];
        }
        if constexpr (ALIGN_EPI) { if (wr == 1) PG8_BAR; }
    }
    PG8_WAIT_V(0);
    if constexpr (!ALIGN_EPI) { if (wr == 0) PG8_BAR; }
    PG8_BAR;
#undef PG8_SA
#undef PG8_SB
#undef PG8_STAGE
#undef PG8_STAGE_A
#undef PG8_LDA
#undef PG8_LDB
#undef PG8_MMA
#undef PG8_WAIT_V
#undef PG8_WAIT_L
#undef PG8_BAR
#undef PG8_SCHED
}
}

#define GAS __attribute__((address_space(1)))
#define LAS __attribute__((address_space(3)))
typedef unsigned short bf16;
typedef unsigned v4u __attribute__((ext_vector_type(4)));
typedef unsigned v2u __attribute__((ext_vector_type(2)));
typedef float f32x4 __attribute__((ext_vector_type(4)));
typedef float f32x16 __attribute__((ext_vector_type(16)));
typedef short bf16x8 __attribute__((ext_vector_type(8)));
typedef __bf16 bf16x2_t __attribute__((ext_vector_type(2)));
typedef float f32x2_t __attribute__((ext_vector_type(2)));
typedef GAS unsigned gu32;
#define RLX_AGENT __ATOMIC_RELAXED, __HIP_MEMORY_SCOPE_AGENT
#define LDS_WAIT() asm volatile("s_waitcnt lgkmcnt(0)" ::: "memory")
#define VM_WAIT() asm volatile("s_waitcnt vmcnt(0)" ::: "memory")
__device__ __forceinline__ unsigned pk2(float lo, float hi) { f32x2_t v = {lo, hi}; bf16x2_t r = __builtin_convertvector(v, bf16x2_t); return __builtin_bit_cast(unsigned, r); }
__device__ __forceinline__ unsigned short f2bf(float f) { return (unsigned short)(pk2(f, 0.f) & 0xffffu); }
__device__ __forceinline__ float bf2f(unsigned short b) { return __builtin_bit_cast(float, ((unsigned)b) << 16); }
__device__ __forceinline__ float bflo(unsigned w) { return __builtin_bit_cast(float, w << 16); }
__device__ __forceinline__ float bfhi(unsigned w) { return __builtin_bit_cast(float, w & 0xffff0000u); }
__device__ __forceinline__ float sigmoidf_(float x) { return __builtin_amdgcn_rcpf(1.f + __expf(-x)); }
__device__ __forceinline__ float siluf_(float x) { return x * __builtin_amdgcn_rcpf(1.f + __expf(-x)); }
__device__ __forceinline__ float wave_sum(float v) {
#pragma unroll
    for (int o = 1; o < 64; o <<= 1) v += __shfl_xor(v, o);
    return v;
}
__device__ __forceinline__ int crow(int reg, int h) { return (reg & 3) + 8 * (reg >> 2) + 4 * h; }
#define MFMA32(a, b, c) __builtin_amdgcn_mfma_f32_32x32x16_bf16((a), (b), (c), 0, 0, 0)
#define MFMA16(a, b, c) __builtin_amdgcn_mfma_f32_16x16x32_bf16((a), (b), (c), 0, 0, 0)
__device__ __forceinline__ bf16x8 pack_step(const f32x16& x, int s) {
    v4u p; p.x = pk2(x[8 * s], x[8 * s + 1]); p.y = pk2(x[8 * s + 2], x[8 * s + 3]); p.z = pk2(x[8 * s + 4], x[8 * s + 5]); p.w = pk2(x[8 * s + 6], x[8 * s + 7]);
    return __builtin_bit_cast(bf16x8, p);
}

#define XB_TMO      128
#define XB_XCNT(j)  (256  + 64 * (j))
#define XB_XSUB(j)  (1280 + 64 * (j))
#define XB_XGEN(j)  (2304 + 64 * (j))
#define XB_TOP      3328
#define XB_TOPGEN   3392
#define XCD_BAR_WORDS 3456
#define XB_SPIN_CAP (1u << 18)

__device__ __forceinline__ unsigned xb_ld(unsigned* p)              { return __hip_atomic_load(p, __ATOMIC_RELAXED, __HIP_MEMORY_SCOPE_AGENT); }
__device__ __forceinline__ unsigned xb_add(unsigned* p, unsigned v) { return __hip_atomic_fetch_add(p, v, __ATOMIC_RELAXED, __HIP_MEMORY_SCOPE_AGENT); }
__device__ __forceinline__ unsigned xb_xcc_id() { return (unsigned)__builtin_amdgcn_s_getreg((3 << 11) | 20) & 0xFu; }
#define XB_SPIN(cond, bar) do { unsigned _sp = 0; while (cond) { __builtin_amdgcn_s_sleep(1); \
    if ((++_sp & 255u) == 0u) { if (xb_ld(&(bar)[XB_TMO])) break; if (_sp > XB_SPIN_CAP) { atomicAdd(&(bar)[XB_TMO], 1u); break; } } } } while (0)

struct XcdBarrier {
    unsigned* bar; unsigned x;
    volatile LAS unsigned* st;
};

__device__ __forceinline__ XcdBarrier xcd_barrier_post(unsigned* bar, volatile LAS unsigned* st) {
    XcdBarrier b; b.bar = bar; b.x = xb_xcc_id(); b.st = st;
    if (threadIdx.x == 0) (void)xb_add(&bar[XB_XCNT(b.x)], 1u);
    return b;
}
__device__ __forceinline__ void xcd_barrier_complete(unsigned* bar, unsigned x, unsigned& nloc, unsigned& nx) {
    const unsigned G = gridDim.x * gridDim.y * gridDim.z;
    unsigned sum, cnt, mine, sp = 0u;
    for (;;) {
        sum = 0u; cnt = 0u; mine = 0u;
#pragma unroll
        for (unsigned j = 0; j < 16; ++j) { const unsigned c = xb_ld(&bar[XB_XCNT(j)]); sum += c; cnt += (c > 0u) ? 1u : 0u; mine = (j == x) ? c : mine; }
        if (sum == G) break;
        __builtin_amdgcn_s_sleep(1);
        if ((++sp & 255u) == 0u) { if (xb_ld(&bar[XB_TMO])) break; if (sp > XB_SPIN_CAP) { atomicAdd(&bar[XB_TMO], 1u); break; } }
    }
    nloc = mine > 0u ? mine : 1u; nx = cnt > 0u ? cnt : 1u;
}

__device__ __forceinline__ void xcd_barrier(const XcdBarrier& b) {
    asm volatile("s_waitcnt vmcnt(0)" ::: "memory");
    __syncthreads();
    if (threadIdx.x == 0) {
        unsigned* bar = b.bar;
        __builtin_amdgcn_s_waitcnt(0);
        unsigned nloc = b.st[0], nx = b.st[1];
        if (nloc == 0u) { xcd_barrier_complete(bar, b.x, nloc, nx); b.st[0] = nloc; b.st[1] = nx; }
        const unsigned old = xb_add(&bar[XB_XSUB(b.x)], 1u);
        const unsigned gen = old / nloc;
        if (old + 1u == (gen + 1u) * nloc) {
            __builtin_amdgcn_fence(__ATOMIC_RELEASE, "agent");
            asm volatile("s_waitcnt vmcnt(0)" ::: "memory");
            const unsigned og = xb_add(&bar[XB_TOP], 1u);
            const unsigned tg = og / nx;
            if (og + 1u == (tg + 1u) * nx) xb_add(&bar[XB_TOPGEN], 1u);
            else XB_SPIN(xb_ld(&bar[XB_TOPGEN]) == tg, bar);
            __builtin_amdgcn_fence(__ATOMIC_ACQUIRE, "agent");
            xb_add(&bar[XB_XGEN(b.x)], 1u);
            asm volatile("s_waitcnt vmcnt(0)" ::: "memory");
        } else {
            XB_SPIN(xb_ld(&bar[XB_XGEN(b.x)]) == gen, bar);
            __builtin_amdgcn_fence(__ATOMIC_ACQUIRE, "agent");
            asm volatile("s_waitcnt vmcnt(0)" ::: "memory");
        }
    }
    __syncthreads();
}

constexpr int NWAVES = 8;
constexpr int BATCH = 8, SEQ = 2048, D = 1024, NMETA = 16, NH = 8, HD = 128;
constexpr int MR = BATCH * SEQ;
constexpr int LX = 2112, NX = BATCH * LX;
constexpr int NCH = 33, NCHUNKS = BATCH * NH * NCH;
constexpr int PROJ = 7184;
constexpr int NEXP = 32, FF = 512;
constexpr int MAXT = 160;
constexpr float EPS = 1e-6f;

constexpr size_t MiB = 1u << 20;
constexpr size_t WS_CTL = 0, CTL_ZERO_BYTES = 64 * 1024;
constexpr size_t WS_GB     = 1 * MiB;
constexpr size_t WS_UMETA  = WS_GB + 1152 * 1024;
constexpr size_t WS_HALO   = WS_UMETA + 64 * 1024;
constexpr size_t WS_CD     = 7 * MiB;
constexpr size_t WS_CNT    = 7 * MiB + 64 * 1024;
constexpr size_t WS_TILEE  = WS_CNT + 64 * 1024;
constexpr size_t WS_TOK    = WS_TILEE + 4096;
constexpr size_t WS_ROWIDX = 8 * MiB;
constexpr size_t WS_ROWS   = WS_ROWIDX + 256 * 1024;
constexpr size_t WS_ROWW   = WS_ROWS + 256 * 1024;
constexpr size_t WS_TOKPOS = WS_ROWW + 256 * 1024;
constexpr size_t WS_BTIN   = 10 * MiB;
constexpr size_t WS_BTOUT  = 24 * MiB;
constexpr size_t WS_U      = 26 * MiB;
constexpr size_t WS_O      = 58 * MiB;
constexpr size_t WS_QKV    = 90 * MiB;
constexpr size_t WS_CLX    = 189 * MiB;
constexpr size_t WS_PM     = 90 * MiB;
constexpr size_t WS_ZS     = 123 * MiB;
constexpr size_t WS_GP     = 155 * MiB;
constexpr size_t WS_GD     = 187 * MiB;
constexpr size_t WS_MERGED = 219 * MiB;
constexpr size_t WS_H1     = 90 * MiB;
constexpr size_t WS_XN     = 10 * MiB;
constexpr size_t WS_HDN    = 42 * MiB;
constexpr size_t WS_BTGU   = 154 * MiB;
constexpr size_t WS_BTDN   = 250 * MiB;
constexpr size_t WS_Y      = 154 * MiB;
constexpr size_t WS_END    = 289 * MiB;

constexpr int LDS_BYTES = 163840;
constexpr int MISC_OFF = 163840 - 256;

struct Frame {
    LAS unsigned char* lds;
    volatile LAS unsigned* MISC;
    int tid, lane, wave;
    int vcu, G;
    unsigned char* ws;
    const float *x, *meta, *norm_mix_w, *w_in, *conv_w, *pool_w, *pool_scale, *a_log, *dt_bias, *dn_norm_w, *w_out, *norm_ffn_w,
                *rg_w, *rg_b, *re_w, *re_b, *w_gate, *w_up, *w_down, *norm_final_w;
    float* out;
};
__device__ __forceinline__ int xrow_of(int r) { return (r >> 11) * LX + 64 + (r & 2047); }

__device__ __forceinline__ void transpose_item(const float* W, int ldw, int c0, bf16* WT, int ldk, int r0, int k0, LAS float* scr, int lane) {
    float tv[32];
#pragma unroll
    for (int i = 0; i < 32; ++i) { const int kk = 2 * i + (lane >> 5); tv[i] = W[(size_t)(k0 + kk) * ldw + c0 + (lane & 31)]; }
#pragma unroll
    for (int i = 0; i < 32; ++i) { const int kk = 2 * i + (lane >> 5); scr[kk * 33 + (lane & 31)] = tv[i]; }
    LDS_WAIT(); asm volatile("" ::: "memory");
    const int c = lane & 7;
#pragma unroll
    for (int j = 0; j < 4; ++j) { const int n = (lane >> 3) + 8 * j; const LAS float* s = scr + (8 * c) * 33 + n;
        v4u o; o.x = pk2(s[0 * 33], s[1 * 33]); o.y = pk2(s[2 * 33], s[3 * 33]); o.z = pk2(s[4 * 33], s[5 * 33]); o.w = pk2(s[6 * 33], s[7 * 33]);
        *(GAS v4u*)(WT + (size_t)(r0 + n) * ldk + k0 + 8 * c) = o; }
    LDS_WAIT(); asm volatile("" ::: "memory");
}
__device__ __forceinline__ void transpose_item_gu(const float* Wg, const float* Wu, const float* nwk, bf16* WT, int r0, int k0, LAS float* scr, int lane) {
    const int d = lane & 31, cdst = r0 + d, f = (cdst >> 3) * 4 + (cdst & 3); const float* src = ((cdst >> 2) & 1) ? Wu : Wg;
    float tv[32];
#pragma unroll
    for (int i = 0; i < 32; ++i) { const int kk = 2 * i + (lane >> 5); tv[i] = src[(size_t)(k0 + kk) * FF + f] * nwk[k0 + kk]; }
#pragma unroll
    for (int i = 0; i < 32; ++i) { const int kk = 2 * i + (lane >> 5); scr[kk * 33 + d] = tv[i]; }
    LDS_WAIT(); asm volatile("" ::: "memory");
    const int c = lane & 7;
#pragma unroll
    for (int j = 0; j < 4; ++j) { const int n = (lane >> 3) + 8 * j; const LAS float* s = scr + (8 * c) * 33 + n;
        v4u o; o.x = pk2(s[0 * 33], s[1 * 33]); o.y = pk2(s[2 * 33], s[3 * 33]); o.z = pk2(s[4 * 33], s[5 * 33]); o.w = pk2(s[6 * 33], s[7 * 33]);
        *(GAS v4u*)(WT + (size_t)(r0 + n) * D + k0 + 8 * c) = o; }
    LDS_WAIT(); asm volatile("" ::: "memory");
}

__device__ __forceinline__ void p0_prologue(Frame& F) {
    const int gw = F.vcu * NWAVES + F.wave, NGW = F.G * NWAVES, lane = F.lane;
    LAS float* WabT = (LAS float*)F.lds;
    for (int k = F.tid; k < D; k += NWAVES * 64) {
        const f32x4* src = (const f32x4*)(F.w_in + (size_t)k * PROJ + 5120);
#pragma unroll
        for (int q = 0; q < 4; ++q) { const f32x4 v = src[q]; WabT[(4 * q + 0) * D + k] = v.x; WabT[(4 * q + 1) * D + k] = v.y; WabT[(4 * q + 2) * D + k] = v.z; WabT[(4 * q + 3) * D + k] = v.w; }
    }
    __syncthreads();
    bf16* U = (bf16*)(F.ws + WS_U); bf16* UM = (bf16*)(F.ws + WS_UMETA); float* GB = (float*)(F.ws + WS_GB);
    f32x4 nw[4];
#pragma unroll
    for (int j = 0; j < 4; ++j) nw[j] = ((const f32x4*)F.norm_mix_w)[64 * j + lane];
#define P0_ROWPTR(r) ((const f32x4*)((r) >= MR ? F.meta + (size_t)((r) - MR) * D : F.x + (size_t)(r) * D) + lane)
    f32x4 vn[4];
    if (gw < MR + NMETA) { const f32x4* xr = P0_ROWPTR(gw);
#pragma unroll
        for (int j = 0; j < 4; ++j) vn[j] = xr[64 * j]; }
    for (int r = gw; r < MR + NMETA; r += NGW) {
        const bool ismeta = r >= MR; const int mj = r - MR;
        f32x4 v[4]; float s = 0.f;
#pragma unroll
        for (int j = 0; j < 4; ++j) { v[j] = vn[j]; s += (v[j].x * v[j].x + v[j].y * v[j].y) + (v[j].z * v[j].z + v[j].w * v[j].w); }
        if (r + NGW < MR + NMETA) { const f32x4* xr = P0_ROWPTR(r + NGW);
#pragma unroll
            for (int j = 0; j < 4; ++j) vn[j] = xr[64 * j]; }
        const float rstd = __builtin_amdgcn_rsqf(wave_sum(s) * (1.f / D) + EPS);
#pragma unroll
        for (int j = 0; j < 4; ++j) v[j] = v[j] * rstd * nw[j];
        unsigned long long* o8 = (unsigned long long*)(ismeta ? UM + (size_t)mj * D : U + (size_t)r * D) + lane;
#pragma unroll
        for (int j = 0; j < 4; ++j) o8[64 * j] = (unsigned long long)pk2(v[j].x, v[j].y) | ((unsigned long long)pk2(v[j].z, v[j].w) << 32);
        float p[16];
#pragma unroll
        for (int o = 0; o < 16; ++o) { float a = 0.f;
#pragma unroll
            for (int j = 0; j < 4; ++j) { const f32x4 w = *(const LAS f32x4*)(WabT + o * D + 256 * j + 4 * lane); a += (v[j].x * w.x + v[j].y * w.y) + (v[j].z * w.z + v[j].w * w.w); }
            p[o] = a; if ((o & 3) == 3) __builtin_amdgcn_sched_barrier(0); }
        const bool b5 = lane & 32, b4 = lane & 16, b3 = lane & 8, b2 = lane & 4;
        float q8[8], q4[4], q2[2];
#pragma unroll
        for (int i = 0; i < 8; ++i) { const float keep = b5 ? p[8 + i] : p[i], send = b5 ? p[i] : p[8 + i]; q8[i] = keep + __shfl_xor(send, 32); }
#pragma unroll
        for (int i = 0; i < 4; ++i) { const float keep = b4 ? q8[4 + i] : q8[i], send = b4 ? q8[i] : q8[4 + i]; q4[i] = keep + __shfl_xor(send, 16); }
#pragma unroll
        for (int i = 0; i < 2; ++i) { const float keep = b3 ? q4[2 + i] : q4[i], send = b3 ? q4[i] : q4[2 + i]; q2[i] = keep + __shfl_xor(send, 8); }
        float mine; { const float keep = b2 ? q2[1] : q2[0], send = b2 ? q2[0] : q2[1]; mine = keep + __shfl_xor(send, 4); }
        mine += __shfl_xor(mine, 2); mine += __shfl_xor(mine, 1);
        const int oo = (b5 ? 8 : 0) + (b4 ? 4 : 0) + (b3 ? 2 : 0) + (b2 ? 1 : 0);
        if ((lane & 3) == 0) {
            float val;
            if (oo < 8) { const float xx = mine + F.dt_bias[oo]; const float sp = xx > 20.f ? xx : log1pf(__expf(xx)); val = -__expf(F.a_log[oo]) * sp; }
            else val = 1.f / (1.f + __expf(-mine));
            if (!ismeta) GB[(size_t)xrow_of(r) * 16 + oo] = val;
            else {
#pragma unroll
                for (int b = 0; b < BATCH; ++b) GB[(size_t)(b * LX + 48 + mj) * 16 + oo] = val; }
        }
    }
    __syncthreads();
    bf16* BTIN = (bf16*)(F.ws + WS_BTIN); bf16* BTOUT = (bf16*)(F.ws + WS_BTOUT);
    LAS float* scr = (LAS float*)(F.lds + 65536 + F.wave * 8448);
    constexpr int NB_TOT = 96 + 32 + 32 + 32 + 32;
    for (int it = gw; it < NB_TOT * 16; it += NGW) {
        const int kb = it & 15; int nb = it >> 4;
        if (nb < 96) { transpose_item(F.w_in, PROJ, 1024 + 32 * nb, BTIN, D, 32 * nb, 64 * kb, scr, lane); continue; } nb -= 96;
        if (nb < 32) { transpose_item(F.w_in, PROJ, 4096 + 32 * nb, BTIN, D, 4096 + 32 * nb, 64 * kb, scr, lane); continue; } nb -= 32;
        if (nb < 32) { transpose_item(F.w_in, PROJ, 5136 + 32 * nb, BTIN, D, 5120 + 32 * nb, 64 * kb, scr, lane); continue; } nb -= 32;
        if (nb < 32) { transpose_item(F.w_in, PROJ, 6160 + 32 * nb, BTIN, D, 6144 + 32 * nb, 64 * kb, scr, lane); continue; } nb -= 32;
        transpose_item(F.w_out, D, 32 * nb, BTOUT, D, 32 * nb, 64 * kb, scr, lane);
    }
    for (int tile = gw; tile < 4 * 64 * 16; tile += NGW) {
        const int g = tile >> 10, kt = (tile >> 4) & 63, ntl = tile & 15;
        const int m = lane & 15, q = lane >> 4;
        const float* arow = F.w_in + (size_t)(16 * kt + m) * PROJ + 256 * g + 8 * q;
        const float* bcol = F.pool_w + (size_t)g * 65536 + (size_t)(8 * q) * 256 + 16 * ntl + m;
        f32x4 acc = {0.f, 0.f, 0.f, 0.f};
#pragma unroll
        for (int s = 0; s < 8; ++s) {
            const f32x4 a0 = *(const f32x4*)(arow + 32 * s), a1 = *(const f32x4*)(arow + 32 * s + 4);
            float bv[8];
#pragma unroll
            for (int j = 0; j < 8; ++j) bv[j] = bcol[(size_t)(32 * s + j) * 256];
            v4u ap, bp; ap.x = pk2(a0.x, a0.y); ap.y = pk2(a0.z, a0.w); ap.z = pk2(a1.x, a1.y); ap.w = pk2(a1.z, a1.w);
            bp.x = pk2(bv[0], bv[1]); bp.y = pk2(bv[2], bv[3]); bp.z = pk2(bv[4], bv[5]); bp.w = pk2(bv[6], bv[7]);
            acc = MFMA16(__builtin_bit_cast(bf16x8, ap), __builtin_bit_cast(bf16x8, bp), acc);
        }
        v2u o; o.x = pk2(acc[0], acc[1]); o.y = pk2(acc[2], acc[3]);
        *(GAS v2u*)(BTIN + (size_t)(3072 + 256 * g + 16 * ntl + m) * D + 16 * kt + 4 * q) = o;
    }
}

typedef pg8::f32x4 (&AccRef)[2][2][4][2];
struct EpiQKV {
    static constexpr bool PERM = true;
    bf16* QKV; bf16* HALO;
    __device__ __forceinline__ void operator()(const pg8::f32x4 (&acc)[2][2][4][2], const pg8::Unit& u, int wr, int wc, int fr, int fq) const {
        const int col0 = u.pn * 256 + wc * 32 + 8 * fq;
#pragma unroll
        for (int ai = 0; ai < 2; ++ai)
#pragma unroll
            for (int m = 0; m < 4; ++m) {
                const int r = u.pm * 256 + ai * 128 + wr * 64 + m * 16 + fr; const int b = r >> 11, xin = 64 + (r & 2047);
                bf16* rowp = QKV + (size_t)(b * LX + xin) * 3072 + col0;
                const bool halo = (m == 3) && (fr >= 13) && ((xin >> 6) + 1 <= 32);
                bf16* hp = HALO + ((size_t)((b * NCH + (xin >> 6) + 1) * 3 + (fr - 13))) * 3072 + col0;
#pragma unroll
                for (int bj = 0; bj < 2; ++bj) { const pg8::f32x4 v0 = acc[ai][bj][m][0], v1 = acc[ai][bj][m][1];
                    v4u w; w.x = pk2(v0[0], v0[1]); w.y = pk2(v0[2], v0[3]); w.z = pk2(v1[0], v1[1]); w.w = pk2(v1[2], v1[3]);
                    *(v4u*)(rowp + bj * 128) = w; if (halo) *(v4u*)(hp + bj * 128) = w; } }
    }
};
struct EpiPZG {
    static constexpr bool PERM = true;
    bf16 *PM, *ZS, *GP, *GD;
    __device__ __forceinline__ void operator()(const pg8::f32x4 (&acc)[2][2][4][2], const pg8::Unit& u, int wr, int wc, int fr, int fq) const {
        const int kind = u.pn >> 2, col0 = (u.pn & 3) * 256 + wc * 32 + 8 * fq;
        bf16* base = kind == 0 ? PM : (kind == 1 ? ZS : (kind == 2 ? GP : GD));
#pragma unroll
        for (int ai = 0; ai < 2; ++ai)
#pragma unroll
            for (int m = 0; m < 4; ++m) {
                const int r = u.pm * 256 + ai * 128 + wr * 64 + m * 16 + fr; const int orow = kind == 0 ? xrow_of(r) : r;
                bf16* rowp = base + (size_t)orow * D + col0;
#pragma unroll
                for (int bj = 0; bj < 2; ++bj) { pg8::f32x4 v0 = acc[ai][bj][m][0], v1 = acc[ai][bj][m][1];
                    if (kind == 1) {
#pragma unroll
                        for (int e = 0; e < 4; ++e) { v0[e] = siluf_(v0[e]); v1[e] = siluf_(v1[e]); } }
                    else if (kind >= 2) {
#pragma unroll
                        for (int e = 0; e < 4; ++e) { v0[e] = sigmoidf_(v0[e]); v1[e] = sigmoidf_(v1[e]); } }
                    v4u w; w.x = pk2(v0[0], v0[1]); w.y = pk2(v0[2], v0[3]); w.z = pk2(v1[0], v1[1]); w.w = pk2(v1[2], v1[3]);
                    *(v4u*)(rowp + bj * 128) = w; } }
    }
};
struct EpiOut {
    static constexpr bool PERM = false;
    const float* X; float* H1; bf16* XN;
    __device__ __forceinline__ void operator()(const pg8::f32x4 (&acc)[2][2][4][2], const pg8::Unit& u, int wr, int wc, int fr, int fq) const {
        const int row0 = u.pm * 256 + wr * 64 + fr, col0 = u.pn * 256 + wc * 32 + 4 * fq;
#pragma unroll
        for (int ai = 0; ai < 2; ++ai)
#pragma unroll
            for (int m = 0; m < 4; ++m) { const size_t off = (size_t)(row0 + ai * 128 + m * 16) * D + col0;
#pragma unroll
                for (int bj = 0; bj < 2; ++bj)
#pragma unroll
                    for (int n = 0; n < 2; ++n) { const pg8::f32x4 xv = *(const pg8::f32x4*)(X + off + bj * 128 + n * 16); const pg8::f32x4 hv = acc[ai][bj][m][n] + xv; *(pg8::f32x4*)(H1 + off + bj * 128 + n * 16) = hv;
                        v2u w; w.x = pk2(hv[0], hv[1]); w.y = pk2(hv[2], hv[3]); *(v2u*)(XN + off + bj * 128 + n * 16) = w; } }
    }
};
struct EpiGU {
    static constexpr bool PERM = true;
    bf16* HDN; const float* ROWS;
    __device__ __forceinline__ void operator()(const pg8::f32x4 (&acc)[2][2][4][2], const pg8::Unit& u, int wr, int wc, int fr, int fq) const {
        const int f0 = (u.pn & 3) * 128 + wc * 16 + 4 * fq;
#pragma unroll
        for (int ai = 0; ai < 2; ++ai)
#pragma unroll
            for (int m = 0; m < 4; ++m) { const int pos = u.pm * 256 + ai * 128 + wr * 64 + m * 16 + fr; const float rs = ROWS[pos];
#pragma unroll
                for (int bj = 0; bj < 2; ++bj) { const pg8::f32x4 gt = acc[ai][bj][m][0] * rs, up = acc[ai][bj][m][1] * rs;
                    v2u w; w.x = pk2(siluf_(gt[0]) * up[0], siluf_(gt[1]) * up[1]); w.y = pk2(siluf_(gt[2]) * up[2], siluf_(gt[3]) * up[3]);
                    *(v2u*)(HDN + (size_t)pos * FF + f0 + bj * 64) = w; } }
    }
};
struct EpiDown {
    static constexpr bool PERM = true;
    bf16* Y; const float* ROWW;
    __device__ __forceinline__ void operator()(const pg8::f32x4 (&acc)[2][2][4][2], const pg8::Unit& u, int wr, int wc, int fr, int fq) const {
        const int col0 = (u.pn & 3) * 256 + wc * 32 + 8 * fq;
#pragma unroll
        for (int ai = 0; ai < 2; ++ai)
#pragma unroll
            for (int m = 0; m < 4; ++m) { const int pos = u.pm * 256 + ai * 128 + wr * 64 + m * 16 + fr; const float cw = ROWW[pos];
#pragma unroll
                for (int bj = 0; bj < 2; ++bj) { const pg8::f32x4 v0 = acc[ai][bj][m][0] * cw, v1 = acc[ai][bj][m][1] * cw;
                    v4u w; w.x = pk2(v0[0], v0[1]); w.y = pk2(v0[2], v0[3]); w.z = pk2(v1[0], v1[1]); w.w = pk2(v1[2], v1[3]);
                    *(v4u*)(Y + (size_t)pos * D + col0 + bj * 128) = w; } }
    }
};
struct MoeOrder {
    int ntiles, G, c; const int* tile_e; const LAS int* idx;
    __device__ __forceinline__ bool next(int i, pg8::Unit& u) const {
        const int L = i * G + c; if (L >= 4 * ntiles) return false;
        u.pm = L >> 2; u.pn = tile_e[L >> 2] * 4 + (L & 3); return true;
    }
    __device__ __forceinline__ int gather_row(const pg8::Unit& u, int r) const { const int i = (u.pm * 4 + (u.pn & 3) - c) / G; return idx[i * 256 + r]; }
};

__device__ __forceinline__ void meta_rows_job(Frame& F, const bf16* BT, int ncols, bf16* OUTX, int ld, bf16* HALO) {
    const bf16* UM = (const bf16*)(F.ws + WS_UMETA);
    const int lane = F.lane, m = lane & 15, q = lane >> 4;
    for (int tile = F.vcu * NWAVES + F.wave; tile < ncols / 16; tile += F.G * NWAVES) {
        const bf16* ap = UM + (size_t)m * D + 8 * q; const bf16* bp = BT + (size_t)(16 * tile + m) * D + 8 * q;
        f32x4 acc = {0.f, 0.f, 0.f, 0.f}, acc2 = {0.f, 0.f, 0.f, 0.f};
#pragma unroll
        for (int hf = 0; hf < 2; ++hf) {
            bf16x8 av[16], bv[16];
#pragma unroll
            for (int s = 0; s < 16; ++s) { av[s] = *(const bf16x8*)(ap + 32 * (16 * hf + s)); bv[s] = *(const bf16x8*)(bp + 32 * (16 * hf + s)); }
#pragma unroll
            for (int s = 0; s < 16; s += 2) { acc = MFMA16(av[s], bv[s], acc); acc2 = MFMA16(av[s + 1], bv[s + 1], acc2); }
        }
        acc = acc + acc2;
#pragma unroll
        for (int i = 0; i < 4; ++i) { const int j = 4 * q + i; const bf16 v = f2bf(acc[i]);
#pragma unroll
            for (int b = 0; b < BATCH; ++b) { OUTX[(size_t)(b * LX + 48 + j) * ld + 16 * tile + m] = v;
                if (HALO && j >= 13) HALO[((size_t)((b * NCH + 1) * 3 + (j - 13))) * 3072 + 16 * tile + m] = v; } }
    }
}

constexpr int P2_KN = 0, P2_QN = 17408, P2_KBT = 34816, P2_VBT = 53248, P2_KDT = 71680, P2_QDI = 90112, P2_AM = 107520, P2_TM = 124928, P2_QKM = 134144, P2_SC = 143360, P2_AB21 = 144640;
constexpr int RS = 272, TS = 144;
__device__ __forceinline__ size_t inplace_off(int xr0, int mat, int h, int f, int lane) {
    return ((size_t)(xr0 + 4 * f + (lane >> 4)) * 3072 + mat * 1024 + h * 128) * 2 + (lane & 15) * 16;
}
__device__ __forceinline__ void p2_chunk_local(Frame& F) {
    LAS unsigned char* L = F.lds; const int wave = F.wave;
    LAS float* SC = (LAS float*)(L + P2_SC);
    unsigned char* QKV = F.ws + WS_QKV; const bf16* HALO = (const bf16*)(F.ws + WS_HALO); const float* GB = (const float*)(F.ws + WS_GB);
    unsigned char* CLX = F.ws + WS_CLX; float* CD = (float*)(F.ws + WS_CD);
    v4u raww[11]; f32x4 cwq[8]; float gq = 0.f, beq = 0.f; float val[8][8];
#define P2_PREFETCH(CID) do { const int c_ = (CID) % NCH, bh_ = (CID) / NCH, h_ = bh_ & 7, b_ = bh_ >> 3, xr_ = b_ * LX + 64 * c_; \
        const int tid_ = F.tid, lane_ = tid_ & 63, grp_ = tid_ >> 4, mat_ = grp_ >> 3, rg_ = grp_ & 7, cg_ = lane_ & 15, ch_ = mat_ * 1024 + h_ * 128 + 8 * cg_; \
        if (tid_ < 384) { _Pragma("unroll") for (int i = 0; i < 11; ++i) { const int li = 8 * rg_ - 3 + i; v4u w = {0u, 0u, 0u, 0u}; \
            if (li < 0) { if (c_ > 0) w = *(const v4u*)(HALO + ((size_t)((b_ * NCH + c_) * 3 + (li + 3))) * 3072 + ch_); } \
            else if (!(c_ == 0 && li < 48)) w = *(const v4u*)(QKV + ((size_t)(xr_ + li) * 3072 + ch_) * 2); \
            raww[i] = w; } \
            _Pragma("unroll") for (int kk = 0; kk < 4; ++kk) { cwq[2 * kk] = *(const f32x4*)(F.conv_w + (size_t)kk * 3072 + ch_); cwq[2 * kk + 1] = *(const f32x4*)(F.conv_w + (size_t)kk * 3072 + ch_ + 4); } } \
        if (tid_ < 64) { const bool nul_ = (c_ == 0) && (lane_ < 48); gq = nul_ ? 0.f : GB[(size_t)(xr_ + lane_) * 16 + h_]; beq = nul_ ? 0.f : GB[(size_t)(xr_ + lane_) * 16 + 8 + h_]; } } while (0)
#define P2_KILL() do { _Pragma("unroll") for (int i = 0; i < 11; ++i) raww[i] = (v4u){0u, 0u, 0u, 0u}; _Pragma("unroll") for (int i = 0; i < 8; ++i) { cwq[i] = (f32x4){0.f, 0.f, 0.f, 0.f}; _Pragma("unroll") for (int e = 0; e < 8; ++e) val[i][e] = 0.f; } } while (0)
#define RAWV(i, e) (((e) & 1) ? bfhi(raww[i][(e) >> 1]) : bflo(raww[i][(e) >> 1]))
#define CWV(kk, e) (cwq[2 * (kk) + ((e) >> 2)][(e) & 3])
#define P2_S0S1(CID, TID) do { const int lane_ = (TID) & 63; \
        if (wave == 0) { float gam = gq; \
            _Pragma("unroll") for (int o = 1; o < 64; o <<= 1) { const float t = __shfl_up(gam, o); if (lane_ >= o) gam += t; } \
            const float gl = __shfl(gam, 63); \
            SC[lane_] = gam; SC[64 + lane_] = beq; const float eg = __expf(gam); SC[128 + lane_] = eg; SC[192 + lane_] = __expf(gl - gam); SC[256 + lane_] = beq * eg; \
            if (lane_ == 0) CD[(CID)] = __expf(gl); } \
        if ((TID) < 384) { const int mat_ = (TID) >> 7; \
            _Pragma("unroll") for (int i = 0; i < 8; ++i) { float ss = 0.f; \
                _Pragma("unroll") for (int e = 0; e < 8; ++e) { const float cv = CWV(0, e) * RAWV(i, e) + CWV(1, e) * RAWV(i + 1, e) + CWV(2, e) * RAWV(i + 2, e) + CWV(3, e) * RAWV(i + 3, e); \
                    const float sv = cv * __builtin_amdgcn_rcpf(1.f + __expf(-cv)); val[i][e] = sv; ss += sv * sv; } \
                if (mat_ < 2) { ss += __shfl_xor(ss, 1); ss += __shfl_xor(ss, 2); ss += __shfl_xor(ss, 4); ss += __shfl_xor(ss, 8); \
                    const float inv = __builtin_amdgcn_rsqf(ss + EPS) * (mat_ == 0 ? 0.08838834764831845f : 1.f); \
                    _Pragma("unroll") for (int e = 0; e < 8; ++e) val[i][e] *= inv; } } } } while (0)
    if (F.vcu < NCHUNKS) { P2_PREFETCH(F.vcu); P2_S0S1(F.vcu, F.tid); if (F.vcu + F.G < NCHUNKS) P2_PREFETCH(F.vcu + F.G); }
    __syncthreads();
    for (int cid = F.vcu; cid < NCHUNKS; cid += F.G) {
        const int c = cid % NCH, bh = cid / NCH, h = bh & 7, b = bh >> 3, xr0 = b * LX + 64 * c;
        int tid = F.tid; asm volatile("" : "+v"(tid)); const int lane = tid & 63;
        const int grp = tid >> 4, mat = grp >> 3, rg = grp & 7, cg = lane & 15;
        if (tid < 384) {
            if (mat == 0) {
#pragma unroll
                for (int i = 0; i < 8; ++i) { const int t = 8 * rg + i; const float eg = SC[128 + t];
                    v4u w; w.x = pk2(val[i][0], val[i][1]); w.y = pk2(val[i][2], val[i][3]); w.z = pk2(val[i][4], val[i][5]); w.w = pk2(val[i][6], val[i][7]);
                    *(LAS v4u*)(L + P2_QN + t * RS + cg * 16) = w;
                    w.x = pk2(val[i][0] * eg, val[i][1] * eg); w.y = pk2(val[i][2] * eg, val[i][3] * eg); w.z = pk2(val[i][4] * eg, val[i][5] * eg); w.w = pk2(val[i][6] * eg, val[i][7] * eg);
                    *(LAS v4u*)(L + P2_QDI + t * RS + cg * 16) = w; }
            } else if (mat == 1) {
                float beg[8], egl[8];
#pragma unroll
                for (int i = 0; i < 8; ++i) { beg[i] = SC[256 + 8 * rg + i]; egl[i] = SC[192 + 8 * rg + i]; }
#pragma unroll
                for (int i = 0; i < 8; ++i) { const int t = 8 * rg + i;
                    v4u w; w.x = pk2(val[i][0], val[i][1]); w.y = pk2(val[i][2], val[i][3]); w.z = pk2(val[i][4], val[i][5]); w.w = pk2(val[i][6], val[i][7]);
                    *(LAS v4u*)(L + P2_KN + t * RS + cg * 16) = w; }
#pragma unroll
                for (int e = 0; e < 8; ++e) { const int k = 8 * cg + e;
                    v4u w; w.x = pk2(val[0][e] * beg[0], val[1][e] * beg[1]); w.y = pk2(val[2][e] * beg[2], val[3][e] * beg[3]); w.z = pk2(val[4][e] * beg[4], val[5][e] * beg[5]); w.w = pk2(val[6][e] * beg[6], val[7][e] * beg[7]);
                    *(LAS v4u*)(L + P2_KBT + k * TS + ((rg ^ (cg & 7)) * 16)) = w;
                    w.x = pk2(val[0][e] * egl[0], val[1][e] * egl[1]); w.y = pk2(val[2][e] * egl[2], val[3][e] * egl[3]); w.z = pk2(val[4][e] * egl[4], val[5][e] * egl[5]); w.w = pk2(val[6][e] * egl[6], val[7][e] * egl[7]);
                    *(LAS v4u*)(L + P2_KDT + k * TS + ((rg ^ (cg & 7)) * 16)) = w; }
            } else {
                float be[8];
#pragma unroll
                for (int i = 0; i < 8; ++i) be[i] = SC[64 + 8 * rg + i];
#pragma unroll
                for (int e = 0; e < 8; ++e) { const int k = 8 * cg + e;
                    v4u w; w.x = pk2(val[0][e] * be[0], val[1][e] * be[1]); w.y = pk2(val[2][e] * be[2], val[3][e] * be[3]); w.z = pk2(val[4][e] * be[4], val[5][e] * be[5]); w.w = pk2(val[6][e] * be[6], val[7][e] * be[7]);
                    *(LAS v4u*)(L + P2_VBT + k * TS + ((rg ^ (cg & 7)) * 16)) = w; }
            }
        }
        __syncthreads();
        {
            const int mq = wave >> 2, tm = (wave >> 1) & 1, tn = wave & 1, r = lane & 31, hh = lane >> 5;
            f32x16 acc; for (int i = 0; i < 16; ++i) acc[i] = 0.f;
            if (tm >= tn) {
                LAS unsigned char* ab = L + (mq ? P2_QN : P2_KN) + (32 * tm + r) * RS + hh * 16; LAS unsigned char* bb = L + P2_KN + (32 * tn + r) * RS + hh * 16;
#pragma unroll
                for (int s = 0; s < 8; ++s) acc = MFMA32(*(const LAS bf16x8*)(ab + 32 * s), *(const LAS bf16x8*)(bb + 32 * s), acc);
            }
            const int tc = 32 * tn + r; const float gc = SC[tc];
#pragma unroll
            for (int i = 0; i < 16; ++i) { const int t = 32 * tm + crow(i, hh); const float dec = __expf(SC[t] - gc);
                if (mq == 0) { const float av = (t > tc) ? SC[64 + t] * acc[i] * dec : 0.f; *(LAS float*)(L + P2_AM + t * RS + tc * 4) = av;
                    if (tm == 1 && tn == 0) *(LAS bf16*)(L + P2_AB21 + (t - 32) * 80 + tc * 2) = f2bf(av); }
                else *(LAS bf16*)(L + P2_QKM + t * TS + tc * 2) = f2bf((t >= tc) ? acc[i] * dec : 0.f); }
        }
        __syncthreads();
        if (wave == 7) {
            const int half = lane >> 5, cb = lane & 31;
            float X[32];
#pragma unroll
            for (int i = 0; i < 32; ++i) X[i] = 0.f;
            const LAS unsigned char* am = L + P2_AM + (32 * half) * RS + (32 * half) * 4;
            f32x4 rb[2][8]; float dg[2];
            dg[1] = *(const LAS float*)(am + 1 * RS + cb * 4); rb[1][0] = *(const LAS f32x4*)(am + 1 * RS);
#pragma unroll
            for (int i = 1; i < 32; ++i) {
                if (i + 1 < 32) {
#pragma unroll
                    for (int j4 = 0; j4 < (i + 4) / 4; ++j4) rb[(i + 1) & 1][j4] = *(const LAS f32x4*)(am + (i + 1) * RS + j4 * 16);
                    dg[(i + 1) & 1] = *(const LAS float*)(am + (i + 1) * RS + cb * 4);
                }
                __builtin_amdgcn_sched_barrier(0);
                float a0 = -dg[i & 1], a1 = 0.f, a2 = 0.f, a3 = 0.f;
#pragma unroll
                for (int j4 = 0; j4 < (i + 3) / 4; ++j4) { a0 -= rb[i & 1][j4].x * X[4 * j4]; a1 -= rb[i & 1][j4].y * X[4 * j4 + 1]; a2 -= rb[i & 1][j4].z * X[4 * j4 + 2]; a3 -= rb[i & 1][j4].w * X[4 * j4 + 3]; }
                X[i] = (a0 + a1) + (a2 + a3);
                __builtin_amdgcn_sched_barrier(0);
            }
            LAS unsigned char* tm = L + P2_TM;
#pragma unroll
            for (int i = 0; i < 32; ++i) *(LAS bf16*)(tm + (32 * half + i) * TS + lane * 2) = f2bf(X[i]);
            if (half == 0) {
#pragma unroll
                for (int i = 0; i < 32; ++i) *(LAS bf16*)(tm + i * TS + (32 + cb) * 2) = (bf16)0;
            }
            LDS_WAIT(); asm volatile("" ::: "memory");
            *(LAS bf16*)(tm + lane * TS + lane * 2) = (bf16)0x3F80;
            LDS_WAIT(); asm volatile("" ::: "memory");
            {
                const int r = cb, hh = half;
                f32x16 M; for (int i = 0; i < 16; ++i) M[i] = 0.f;
#pragma unroll
                for (int s2 = 0; s2 < 2; ++s2) {
                    const bf16x8 a = *(const LAS bf16x8*)(L + P2_AB21 + r * 80 + (16 * s2 + 8 * hh) * 2);
                    unsigned short e[8];
#pragma unroll
                    for (int j = 0; j < 8; ++j) e[j] = *(const LAS bf16*)(tm + (16 * s2 + 8 * hh + j) * TS + r * 2);
                    v4u bw; bw.x = e[0] | ((unsigned)e[1] << 16); bw.y = e[2] | ((unsigned)e[3] << 16); bw.z = e[4] | ((unsigned)e[5] << 16); bw.w = e[6] | ((unsigned)e[7] << 16);
                    M = MFMA32(a, __builtin_bit_cast(bf16x8, bw), M);
                }
                f32x16 T21; for (int i = 0; i < 16; ++i) T21[i] = 0.f;
#pragma unroll
                for (int s2 = 0; s2 < 2; ++s2) {
                    const LAS unsigned char* src = tm + (32 + r) * TS + (32 + 16 * s2 + 4 * hh) * 2;
                    const v2u lo = *(const LAS v2u*)src, hi = *(const LAS v2u*)(src + 16);
                    v4u aw; aw.x = lo.x; aw.y = lo.y; aw.z = hi.x; aw.w = hi.y;
                    T21 = MFMA32(__builtin_bit_cast(bf16x8, aw), pack_step(M, s2), T21);
                }
#pragma unroll
                for (int i = 0; i < 16; ++i) *(LAS bf16*)(tm + (32 + crow(i, hh)) * TS + r * 2) = f2bf(-T21[i]);
            }
            P2_KILL();
        } else if (wave == 6) {
            const int r = lane & 31, hh = lane >> 5;
#pragma unroll 4
            for (int f = 0; f < 16; ++f) {
                LAS unsigned char* src = L + P2_QDI + (32 * (f >> 3) + r) * RS + (16 * (f & 7) + 4 * hh) * 2;
                const v2u lo = *(const LAS v2u*)src, hi = *(const LAS v2u*)(src + 16);
                v4u w; w.x = lo.x; w.y = lo.y; w.z = hi.x; w.w = hi.y;
                *(v4u*)(QKV + inplace_off(xr0, 0, h, f, lane)) = w; }
#pragma unroll 4
            for (int g = 0; g < 16; ++g) {
                const int k = 32 * (g >> 2) + r, sw = (k >> 3) & 7; LAS unsigned char* kb = L + P2_KDT + k * TS + 8 * hh;
                const v2u lo = *(const LAS v2u*)(kb + (((2 * (g & 3)) ^ sw) * 16)), hi = *(const LAS v2u*)(kb + (((2 * (g & 3) + 1) ^ sw) * 16));
                v4u w; w.x = lo.x; w.y = lo.y; w.z = hi.x; w.w = hi.y;
                *(v4u*)(QKV + inplace_off(xr0, 1, h, g, lane)) = w; }
#pragma unroll 4
            for (int g = 0; g < 8; ++g) {
                LAS unsigned char* src = L + P2_QKM + (32 * (g >> 2) + r) * TS + (16 * (g & 3) + 4 * hh) * 2;
                const v2u lo = *(const LAS v2u*)src, hi = *(const LAS v2u*)(src + 16);
                v4u w; w.x = lo.x; w.y = lo.y; w.z = hi.x; w.w = hi.y;
                *(v4u*)(CLX + (size_t)cid * 24576 + 16384 + g * 1024 + lane * 16) = w; }
            P2_KILL();
        } else if (cid + F.G < NCHUNKS) {
            P2_S0S1(cid + F.G, tid);
            if (cid + 2 * F.G < NCHUNKS) P2_PREFETCH(cid + 2 * F.G);
        }
        __syncthreads();
        {
            const int r = lane & 31, hh = lane >> 5;
            f32x16 accW, accU;
            for (int i = 0; i < 16; ++i) { accW[i] = 0.f; accU[i] = 0.f; }
            {
                const int kt = wave >> 1, mt = wave & 1, kr = 32 * kt + r, sw = (kr >> 3) & 7;
                LAS unsigned char* ak = L + P2_KBT + kr * TS; LAS unsigned char* bt = L + P2_TM + (32 * mt + r) * TS + hh * 16;
#pragma unroll
                for (int s = 0; s < 4; ++s) accW = MFMA32(*(const LAS bf16x8*)(ak + (((2 * s + hh) ^ sw) * 16)), *(const LAS bf16x8*)(bt + 32 * s), accW);
                const int tm = wave >> 2, tn = wave & 3, vr = 32 * tn + r, sv = (vr >> 3) & 7;
                LAS unsigned char* at = L + P2_TM + (32 * tm + r) * TS + hh * 16; LAS unsigned char* bv = L + P2_VBT + vr * TS;
#pragma unroll
                for (int s = 0; s < 4; ++s) accU = MFMA32(*(const LAS bf16x8*)(at + 32 * s), *(const LAS bf16x8*)(bv + (((2 * s + hh) ^ sv) * 16)), accU);
#pragma unroll
                for (int s2 = 0; s2 < 2; ++s2) {
                    v4u w; w.x = pk2(-accW[8 * s2], -accW[8 * s2 + 1]); w.y = pk2(-accW[8 * s2 + 2], -accW[8 * s2 + 3]); w.z = pk2(-accW[8 * s2 + 4], -accW[8 * s2 + 5]); w.w = pk2(-accW[8 * s2 + 6], -accW[8 * s2 + 7]);
                    *(v4u*)(CLX + (size_t)cid * 24576 + (mt * 8 + 2 * kt + s2) * 1024 + lane * 16) = w;
                    v4u u; u.x = pk2(accU[8 * s2], accU[8 * s2 + 1]); u.y = pk2(accU[8 * s2 + 2], accU[8 * s2 + 3]); u.z = pk2(accU[8 * s2 + 4], accU[8 * s2 + 5]); u.w = pk2(accU[8 * s2 + 6], accU[8 * s2 + 7]);
                    *(v4u*)(QKV + inplace_off(xr0, 2, h, tn * 4 + tm * 2 + s2, lane)) = u;
                }
            }
        }
        __syncthreads();
    }
}

constexpr int SC_BUF = 61440;
__device__ __forceinline__ void scan_issue(Frame& F, int b, int h, int s, int c, LAS unsigned char* buf) {
    const int lane = F.lane, cid = (b * NH + h) * NCH + c, xr0 = b * LX + 64 * c;
    const unsigned char* QKV = F.ws + WS_QKV; const unsigned char* clx = F.ws + WS_CLX + (size_t)cid * 24576 + lane * 16;
#pragma unroll
    for (int f = 0; f < 16; ++f) __builtin_amdgcn_global_load_lds((const unsigned*)(clx + f * 1024), (LAS unsigned*)(buf + f * 1024), 16, 0, 0);
#pragma unroll
    for (int f = 0; f < 16; ++f) __builtin_amdgcn_global_load_lds((const unsigned*)(QKV + inplace_off(xr0, 0, h, f, lane)), (LAS unsigned*)(buf + 16384 + f * 1024), 16, 0, 0);
#pragma unroll
    for (int f = 0; f < 16; ++f) __builtin_amdgcn_global_load_lds((const unsigned*)(QKV + inplace_off(xr0, 1, h, f, lane)), (LAS unsigned*)(buf + 32768 + f * 1024), 16, 0, 0);
#pragma unroll
    for (int f = 0; f < 8; ++f) __builtin_amdgcn_global_load_lds((const unsigned*)(clx + 16384 + f * 1024), (LAS unsigned*)(buf + 49152 + f * 1024), 16, 0, 0);
#pragma unroll
    for (int f = 0; f < 4; ++f) __builtin_amdgcn_global_load_lds((const unsigned*)(QKV + inplace_off(xr0, 2, h, 4 * s + f, lane)), (LAS unsigned*)(buf + 57344 + f * 1024), 16, 0, 0);
}
template <int PART>
__device__ __forceinline__ void scan_issue_part(Frame& F, int b, int h, int s, int c, LAS unsigned char* buf) {
    const int lane = F.lane, cid = (b * NH + h) * NCH + c, xr0 = b * LX + 64 * c;
    const unsigned char* QKV = F.ws + WS_QKV; const unsigned char* clx = F.ws + WS_CLX + (size_t)cid * 24576 + lane * 16;
#pragma unroll
    for (int j = 0; j < 8; ++j) { constexpr int base = 8 * PART; const int f = base + j;
        if (f < 16) __builtin_amdgcn_global_load_lds((const unsigned*)(clx + f * 1024), (LAS unsigned*)(buf + f * 1024), 16, 0, 0);
        else if (f < 32) __builtin_amdgcn_global_load_lds((const unsigned*)(QKV + inplace_off(xr0, 0, h, f - 16, lane)), (LAS unsigned*)(buf + 16384 + (f - 16) * 1024), 16, 0, 0);
        else if (f < 48) __builtin_amdgcn_global_load_lds((const unsigned*)(QKV + inplace_off(xr0, 1, h, f - 32, lane)), (LAS unsigned*)(buf + 32768 + (f - 32) * 1024), 16, 0, 0);
        else if (f < 56) __builtin_amdgcn_global_load_lds((const unsigned*)(clx + 16384 + (f - 48) * 1024), (LAS unsigned*)(buf + 49152 + (f - 48) * 1024), 16, 0, 0);
        else if (f < 60) __builtin_amdgcn_global_load_lds((const unsigned*)(QKV + inplace_off(xr0, 2, h, 4 * s + (f - 56), lane)), (LAS unsigned*)(buf + 57344 + (f - 56) * 1024), 16, 0, 0);
    }
}
__device__ __forceinline__ void scan_issue_shared(Frame& F, int b, int h, int s, int c, LAS unsigned char* buf) {
    const int lane = F.lane, cid = (b * NH + h) * NCH + c, xr0 = b * LX + 64 * c;
    const unsigned char* QKV = F.ws + WS_QKV; const unsigned char* clx = F.ws + WS_CLX + (size_t)cid * 24576 + lane * 16;
    for (int f = F.wave - 1; f < 60; f += 7) {
        const unsigned char* src; int off;
        if (f < 16) { src = clx + f * 1024; off = f * 1024; }
        else if (f < 32) { src = QKV + inplace_off(xr0, 0, h, f - 16, lane); off = 16384 + (f - 16) * 1024; }
        else if (f < 48) { src = QKV + inplace_off(xr0, 1, h, f - 32, lane); off = 32768 + (f - 32) * 1024; }
        else if (f < 56) { src = clx + 16384 + (f - 48) * 1024; off = 49152 + (f - 48) * 1024; }
        else { src = QKV + inplace_off(xr0, 2, h, 4 * s + (f - 56), lane); off = 57344 + (f - 56) * 1024; }
        __builtin_amdgcn_global_load_lds((const unsigned*)src, (LAS unsigned*)(buf + off), 16, 0, 0);
    }
}
#define DSR(dst, base, off) asm volatile("ds_read_b128 %0, %1" : "=v"(dst) : "v"((unsigned)(size_t)(base) + (unsigned)(off)))
#define LWAIT4(n, g) asm volatile("s_waitcnt lgkmcnt(" #n ")" : "+v"(g[0]), "+v"(g[1]), "+v"(g[2]), "+v"(g[3]))
#define LWAIT6(n, g) asm volatile("s_waitcnt lgkmcnt(" #n ")" : "+v"(g[0]), "+v"(g[1]), "+v"(g[2]), "+v"(g[3]), "+v"(g[4]), "+v"(g[5]))
#define BF8(x) __builtin_bit_cast(bf16x8, x)
__device__ __forceinline__ void p3_scan(Frame& F, const int mode) {
    const bool scanw = (F.wave == 0);
    const int lane = F.lane, r = lane & 31, hh = lane >> 5;
    const float* CD = (const float*)(F.ws + WS_CD); bf16* O = (bf16*)(F.ws + WS_O);
    for (int task = F.vcu; task < BATCH * NH * 4; task += F.G) {
        const int s = task & 3, bh = task >> 2, h = bh & 7, b = bh >> 3;
        f32x16 S[4];
#pragma unroll
        for (int kt = 0; kt < 4; ++kt) for (int i = 0; i < 16; ++i) S[kt][i] = 0.f;
        float cdv = 0.f;
        if (scanw) cdv = (lane < NCH) ? CD[(b * NH + h) * NCH + lane] : 0.f;
        if (!scanw) { scan_issue_shared(F, b, h, s, 0, F.lds); VM_WAIT(); }
        __syncthreads();
        v2u pend[2][4];
#define P3_STORE(cc) do { bf16* ob_ = O + (size_t)(b * SEQ + 64 * ((cc) - 1) + r) * D + h * HD + 32 * s + 4 * hh; \
            _Pragma("unroll") for (int mt = 0; mt < 2; ++mt) _Pragma("unroll") for (int g4 = 0; g4 < 4; ++g4) *(v2u*)(ob_ + (size_t)(32 * mt) * D + 8 * g4) = pend[mt][g4]; } while (0)
        for (int c = 0; c < NCH; ++c) {
            LAS unsigned char* buf = F.lds + (c & 1) * SC_BUF;
            if (!scanw) {
                if (c + 1 < NCH) { scan_issue_shared(F, b, h, s, c + 1, F.lds + ((c + 1) & 1) * SC_BUF); VM_WAIT(); }
                __syncthreads();
                continue;
            }
            const float cd = __builtin_bit_cast(float, __builtin_amdgcn_readlane(__builtin_bit_cast(int, cdv), c));
            const LAS unsigned char* fb = buf + lane * 16;
            v4u G[3][6];
#define ISSUE1(ks, g) do { DSR(G[g][0], fb, (0 * 8 + (ks)) * 1024); DSR(G[g][1], fb, (1 * 8 + (ks)) * 1024); DSR(G[g][2], fb, 16384 + (0 * 8 + (ks)) * 1024); DSR(G[g][3], fb, 16384 + (1 * 8 + (ks)) * 1024); } while (0)
            ISSUE1(0, 0); ISSUE1(1, 1);
            if (c > 1) P3_STORE(c - 1);
            f32x16 aV[2], aO[2];
#pragma unroll
            for (int mt = 0; mt < 2; ++mt) {
                const v4u u0 = *(const LAS v4u*)(fb + 57344 + (2 * mt) * 1024), u1 = *(const LAS v4u*)(fb + 57344 + (2 * mt + 1) * 1024);
                aV[mt][0] = bflo(u0.x); aV[mt][1] = bfhi(u0.x); aV[mt][2] = bflo(u0.y); aV[mt][3] = bfhi(u0.y); aV[mt][4] = bflo(u0.z); aV[mt][5] = bfhi(u0.z); aV[mt][6] = bflo(u0.w); aV[mt][7] = bfhi(u0.w);
                aV[mt][8] = bflo(u1.x); aV[mt][9] = bfhi(u1.x); aV[mt][10] = bflo(u1.y); aV[mt][11] = bfhi(u1.y); aV[mt][12] = bflo(u1.z); aV[mt][13] = bfhi(u1.z); aV[mt][14] = bflo(u1.w); aV[mt][15] = bfhi(u1.w);
                for (int i = 0; i < 16; ++i) aO[mt][i] = 0.f;
            }
            LDS_WAIT();
#pragma unroll
            for (int ks = 0; ks < 8; ++ks) {
                const int g = ks % 3;
                if (ks + 2 < 8) { ISSUE1(ks + 2, (ks + 2) % 3); LWAIT4(8, G[g]); }
                else if (ks + 1 < 8) { LWAIT4(4, G[g]); }
                else { LWAIT4(0, G[g]); }
                const bf16x8 sb = pack_step(S[ks >> 1], ks & 1);
                aV[0] = MFMA32(BF8(G[g][0]), sb, aV[0]); aV[1] = MFMA32(BF8(G[g][1]), sb, aV[1]);
                aO[0] = MFMA32(sb, BF8(G[g][2]), aO[0]); aO[1] = MFMA32(sb, BF8(G[g][3]), aO[1]);
            }
#define ISSUE2(ts, g) do { DSR(G[g][0], fb, 32768 + (0 * 4 + (ts)) * 1024); DSR(G[g][1], fb, 32768 + (1 * 4 + (ts)) * 1024); DSR(G[g][2], fb, 32768 + (2 * 4 + (ts)) * 1024); DSR(G[g][3], fb, 32768 + (3 * 4 + (ts)) * 1024); \
                               DSR(G[g][4], fb, 49152 + (0 * 4 + (ts)) * 1024); DSR(G[g][5], fb, 49152 + (1 * 4 + (ts)) * 1024); } while (0)
            ISSUE2(0, 2);
            bf16x8 Vb[2][2];
#pragma unroll
            for (int mt = 0; mt < 2; ++mt) { Vb[mt][0] = pack_step(aV[mt], 0); Vb[mt][1] = pack_step(aV[mt], 1); }
#pragma unroll
            for (int kt = 0; kt < 4; ++kt) S[kt] = S[kt] * cd;
#pragma unroll
            for (int ts = 0; ts < 4; ++ts) {
                const int g = (ts + 2) % 3;
                if (ts + 1 < 4) { ISSUE2(ts + 1, (ts + 3) % 3); LWAIT6(6, G[g]); }
                else { LWAIT6(0, G[g]); }
#pragma unroll
                for (int kt = 0; kt < 4; ++kt) S[kt] = MFMA32(BF8(G[g][kt]), Vb[ts >> 1][ts & 1], S[kt]);
                aO[0] = MFMA32(Vb[ts >> 1][ts & 1], BF8(G[g][4]), aO[0]); aO[1] = MFMA32(Vb[ts >> 1][ts & 1], BF8(G[g][5]), aO[1]);
            }
#undef ISSUE1
#undef ISSUE2
#pragma unroll
            for (int mt = 0; mt < 2; ++mt)
#pragma unroll
                for (int g4 = 0; g4 < 4; ++g4) { pend[mt][g4].x = pk2(aO[mt][4 * g4], aO[mt][4 * g4 + 1]); pend[mt][g4].y = pk2(aO[mt][4 * g4 + 2], aO[mt][4 * g4 + 3]); }
            __syncthreads();
        }
        if (scanw && mode == 0) P3_STORE(NCH - 1);
        VM_WAIT();
    }
}
#undef P3_STORE

__device__ __forceinline__ void load16(const bf16* p, float (&v)[16]) {
    const v4u a = *(const v4u*)p, b = *(const v4u*)(p + 8);
    v[0] = bflo(a.x); v[1] = bfhi(a.x); v[2] = bflo(a.y); v[3] = bfhi(a.y); v[4] = bflo(a.z); v[5] = bfhi(a.z); v[6] = bflo(a.w); v[7] = bfhi(a.w);
    v[8] = bflo(b.x); v[9] = bfhi(b.x); v[10] = bflo(b.y); v[11] = bfhi(b.y); v[12] = bflo(b.z); v[13] = bfhi(b.z); v[14] = bflo(b.w); v[15] = bfhi(b.w);
}
__device__ __forceinline__ void p5_merge(Frame& F) {
    const int gw = F.vcu * NWAVES + F.wave, NGW = F.G * NWAVES, lane = F.lane;
    const bf16* O = (const bf16*)(F.ws + WS_O); const bf16* PM = (const bf16*)(F.ws + WS_PM); const bf16* ZS = (const bf16*)(F.ws + WS_ZS);
    const bf16* GP = (const bf16*)(F.ws + WS_GP); const bf16* GD = (const bf16*)(F.ws + WS_GD); bf16* MG = (bf16*)(F.ws + WS_MERGED);
    const int n0 = 16 * lane, win = 2 << (lane >> 4); const float rwin = 1.f / (float)win;
    float psc[16], dnw[16];
#pragma unroll
    for (int e = 0; e < 16; ++e) { psc[e] = F.pool_scale[n0 + e]; dnw[e] = F.dn_norm_w[(n0 + e) & 127]; }
    for (int r0 = gw * 8; r0 < MR; r0 += NGW * 8) {
        v4u nO[2], nZ[2], nP[2], nD[2], nM[2];
#define P5_LOAD(r) do { const size_t o_ = (size_t)(r) * D + n0; const size_t x_ = (size_t)xrow_of(r) * D + n0; \
            nO[0] = *(const v4u*)(O + o_); nO[1] = *(const v4u*)(O + o_ + 8); nZ[0] = *(const v4u*)(ZS + o_); nZ[1] = *(const v4u*)(ZS + o_ + 8); \
            nP[0] = *(const v4u*)(GP + o_); nP[1] = *(const v4u*)(GP + o_ + 8); nD[0] = *(const v4u*)(GD + o_); nD[1] = *(const v4u*)(GD + o_ + 8); \
            nM[0] = *(const v4u*)(PM + x_); nM[1] = *(const v4u*)(PM + x_ + 8); } while (0)
#define P5_UNPK(dst, src) do { dst[0] = bflo(src[0].x); dst[1] = bfhi(src[0].x); dst[2] = bflo(src[0].y); dst[3] = bfhi(src[0].y); dst[4] = bflo(src[0].z); dst[5] = bfhi(src[0].z); dst[6] = bflo(src[0].w); dst[7] = bfhi(src[0].w); \
            dst[8] = bflo(src[1].x); dst[9] = bfhi(src[1].x); dst[10] = bflo(src[1].y); dst[11] = bfhi(src[1].y); dst[12] = bflo(src[1].z); dst[13] = bfhi(src[1].z); dst[14] = bflo(src[1].w); dst[15] = bfhi(src[1].w); } while (0)
        P5_LOAD(r0);
#pragma unroll 1
        for (int rr = 0; rr < 8; ++rr) {
            const int r = r0 + rr, xr = xrow_of(r);
            float o[16], z[16], gp[16], gd[16], pm[16], sum[16];
            P5_UNPK(o, nO); P5_UNPK(z, nZ); P5_UNPK(gp, nP); P5_UNPK(gd, nD); P5_UNPK(pm, nM);
            if (rr < 7) P5_LOAD(r + 1);
#pragma unroll
            for (int e = 0; e < 16; ++e) sum[e] = pm[e];
            for (int j = 1; j < win; ++j) { float t[16]; load16(PM + (size_t)(xr - j) * D + n0, t);
#pragma unroll
                for (int e = 0; e < 16; ++e) sum[e] += t[e]; }
            float ss = 0.f;
#pragma unroll
            for (int e = 0; e < 16; ++e) ss += o[e] * o[e];
            ss += __shfl_xor(ss, 1); ss += __shfl_xor(ss, 2); ss += __shfl_xor(ss, 4);
            const float rstd = __builtin_amdgcn_rsqf(ss * (1.f / HD) + EPS);
            float m[16];
#pragma unroll
            for (int e = 0; e < 16; ++e) m[e] = gp[e] * psc[e] * (sum[e] * rwin - pm[e]) + gd[e] * (o[e] * rstd * dnw[e]) * z[e];
            v4u w0, w1; w0.x = pk2(m[0], m[1]); w0.y = pk2(m[2], m[3]); w0.z = pk2(m[4], m[5]); w0.w = pk2(m[6], m[7]);
            w1.x = pk2(m[8], m[9]); w1.y = pk2(m[10], m[11]); w1.z = pk2(m[12], m[13]); w1.w = pk2(m[14], m[15]);
            *(v4u*)(MG + (size_t)r * D + n0) = w0; *(v4u*)(MG + (size_t)r * D + n0 + 8) = w1;
        }
    }
}

struct TokRec { int e0, e1, s0, s1; float w0, w1, rstd, pad; };
constexpr int P7_WS = 1032, P7_WH = 0, P7_WL = 74304, P7_LG = 148608, P7_LGS = 2624, P7_CNT = P7_LG + 4 * P7_LGS;
__device__ __forceinline__ void p7_router(Frame& F) {
    LAS unsigned char* L = F.lds; const int tid = F.tid, lane = F.lane, wave = F.wave;
    for (int k = tid; k < D; k += NWAVES * 64) {
        const float nwk = F.norm_ffn_w[k]; const f32x4 g4 = *(const f32x4*)(F.rg_w + k * 4);
        f32x4 e4[8];
#pragma unroll
        for (int j = 0; j < 8; ++j) e4[j] = *(const f32x4*)(F.re_w + k * 32 + 4 * j);
#pragma unroll
        for (int o = 0; o < 36; ++o) { const float w = (o < 4 ? g4[o & 3] : e4[(o - 4) >> 2][(o - 4) & 3]) * nwk;
            const unsigned short hi = f2bf(w); const unsigned short lo = f2bf(w - bf2f(hi));
            *(LAS bf16*)(L + P7_WH + (o * P7_WS + k) * 2) = hi; *(LAS bf16*)(L + P7_WL + (o * P7_WS + k) * 2) = lo; }
    }
    LAS int* lcnt = (LAS int*)(L + P7_CNT);
    if (tid < 32) lcnt[tid] = 0;
    __syncthreads();
    const float* H1 = (const float*)(F.ws + WS_H1); TokRec* TOK = (TokRec*)(F.ws + WS_TOK);
    const int task = wave & 3, kh = wave >> 2, m = lane & 15, q = lane >> 4, row = 64 * F.vcu + 16 * task + m;
    {
        const float* hp = H1 + (size_t)row * D + 512 * kh + 8 * q;
        f32x4 acc[3] = {{0.f, 0.f, 0.f, 0.f}, {0.f, 0.f, 0.f, 0.f}, {0.f, 0.f, 0.f, 0.f}};
        float ss = 0.f;
        const int orow[3] = {m, 16 + m, (32 + m) < 36 ? 32 + m : 35};
        f32x4 av[32];
#pragma unroll
        for (int s = 0; s < 16; ++s) { av[2 * s] = *(const f32x4*)(hp + 32 * s); av[2 * s + 1] = *(const f32x4*)(hp + 32 * s + 4); }
#pragma unroll
        for (int s = 0; s < 16; ++s) {
            const f32x4 a0 = av[2 * s], a1 = av[2 * s + 1];
            const float x[8] = {a0.x, a0.y, a0.z, a0.w, a1.x, a1.y, a1.z, a1.w};
            v4u xh, xl; unsigned hh[4], ll[4];
#pragma unroll
            for (int j = 0; j < 4; ++j) { const unsigned ph = pk2(x[2 * j], x[2 * j + 1]); hh[j] = ph; ll[j] = pk2(x[2 * j] - bflo(ph), x[2 * j + 1] - bfhi(ph)); ss += x[2 * j] * x[2 * j] + x[2 * j + 1] * x[2 * j + 1]; }
            xh.x = hh[0]; xh.y = hh[1]; xh.z = hh[2]; xh.w = hh[3]; xl.x = ll[0]; xl.y = ll[1]; xl.z = ll[2]; xl.w = ll[3];
            const int ko = 512 * kh + 32 * s + 8 * q;
#pragma unroll
            for (int t = 0; t < 3; ++t) {
                const bf16x8 wh = *(const LAS bf16x8*)(L + P7_WH + (orow[t] * P7_WS + ko) * 2), wl = *(const LAS bf16x8*)(L + P7_WL + (orow[t] * P7_WS + ko) * 2);
                acc[t] = MFMA16(__builtin_bit_cast(bf16x8, xh), wh, acc[t]); acc[t] = MFMA16(__builtin_bit_cast(bf16x8, xl), wh, acc[t]); acc[t] = MFMA16(__builtin_bit_cast(bf16x8, xh), wl, acc[t]);
            }
        }
        ss += __shfl_xor(ss, 16); ss += __shfl_xor(ss, 32);
        LAS float* lg = (LAS float*)(L + P7_LG + task * P7_LGS);
        if (kh == 1) {
#pragma unroll
            for (int t = 0; t < 3; ++t)
#pragma unroll
                for (int i = 0; i < 4; ++i) if (16 * t + m < 36) lg[(4 * q + i) * 40 + 16 * t + m] = acc[t][i];
            if (lane < 16) lg[640 + lane] = ss;
        }
        __syncthreads();
        if (kh == 0) {
#pragma unroll
            for (int t = 0; t < 3; ++t)
#pragma unroll
                for (int i = 0; i < 4; ++i) if (16 * t + m < 36) lg[(4 * q + i) * 40 + 16 * t + m] += acc[t][i];
            if (lane < 16) ss += lg[640 + lane];
            LDS_WAIT(); asm volatile("" ::: "memory");
            if (lane < 16) {
                const float rstd = __builtin_amdgcn_rsqf(ss * (1.f / D) + EPS);
                float gl[4];
#pragma unroll
                for (int o = 0; o < 4; ++o) gl[o] = lg[lane * 40 + o] * rstd + F.rg_b[o];
                int gi = 0; float gm = gl[0];
#pragma unroll
                for (int o = 1; o < 4; ++o) if (gl[o] > gm) { gm = gl[o]; gi = o; }
                float den = 0.f;
#pragma unroll
                for (int o = 0; o < 4; ++o) den += __expf(gl[o] - gm);
                const float pg = 1.f / den;
                float el[8];
#pragma unroll
                for (int e = 0; e < 8; ++e) el[e] = lg[lane * 40 + 4 + 8 * gi + e] * rstd + F.re_b[8 * gi + e];
                int i0 = 0; float m0 = el[0];
#pragma unroll
                for (int e = 1; e < 8; ++e) if (el[e] > m0) { m0 = el[e]; i0 = e; }
                int i1 = -1; float m1 = -3.0e38f;
#pragma unroll
                for (int e = 0; e < 8; ++e) if (e != i0 && el[e] > m1) { m1 = el[e]; i1 = e; }
                const float w0 = 1.f / (1.f + __expf(m1 - m0)), w1 = 1.f - w0;
                const int e0 = gi * 8 + i0, e1 = gi * 8 + i1;
                TokRec t; t.e0 = e0; t.e1 = e1; t.s0 = __hip_atomic_fetch_add(&lcnt[e0], 1, __ATOMIC_RELAXED, __HIP_MEMORY_SCOPE_WORKGROUP); t.s1 = __hip_atomic_fetch_add(&lcnt[e1], 1, __ATOMIC_RELAXED, __HIP_MEMORY_SCOPE_WORKGROUP);
                t.w0 = pg * w0; t.w1 = pg * w1; t.rstd = rstd; t.pad = 0.f;
                TOK[64 * F.vcu + 16 * task + lane] = t;
            }
        }
    }
    __syncthreads();
    if (tid < 32) ((int*)(F.ws + WS_CNT))[F.vcu * 32 + tid] = lcnt[tid];
    __syncthreads();
    const int gw = F.vcu * NWAVES + wave, NGW = F.G * NWAVES;
    LAS float* scr = (LAS float*)(L + wave * 8448);
    bf16* BTGU = (bf16*)(F.ws + WS_BTGU); bf16* BTDN = (bf16*)(F.ws + WS_BTDN);
    for (int it = gw; it < NEXP * 512 + NEXP * 256; it += NGW) {
        if (it < NEXP * 512) { const int e = it >> 9, nb = (it >> 4) & 31, kb = it & 15;
            transpose_item_gu(F.w_gate + (size_t)e * D * FF, F.w_up + (size_t)e * D * FF, F.norm_ffn_w, BTGU + (size_t)e * 1024 * D, 32 * nb, 64 * kb, scr, lane); }
        else { const int jt = it - NEXP * 512, e = jt >> 8, nb = (jt >> 3) & 31, kb = jt & 7;
            transpose_item(F.w_down + (size_t)e * FF * D, D, 32 * nb, BTDN + (size_t)e * 1024 * FF, FF, 32 * nb, 64 * kb, scr, lane); }
    }
}

__device__ __forceinline__ void p8_index(Frame& F) {
    LAS int* tot = (LAS int*)F.lds; LAS int* mine = tot + 32; LAS int* base = tot + 64; LAS int* part = tot + 128;
    const int tid = F.tid; const int* CNT = (const int*)(F.ws + WS_CNT);
    { const int e = tid & 31, seg = tid >> 5;
        int st = 0, sm = 0;
        for (int w = seg * 16; w < seg * 16 + 16; ++w) { const int v = CNT[w * 32 + e]; st += v; if (w < F.vcu) sm += v; }
        part[seg * 32 + e] = st; part[512 + seg * 32 + e] = sm; }
    __syncthreads();
    if (tid < 32) { int st = 0, sm = 0; for (int s = 0; s < 16; ++s) { st += part[s * 32 + tid]; sm += part[512 + s * 32 + tid]; } tot[tid] = st; mine[tid] = sm; }
    __syncthreads();
    if (tid == 0) { int acc = 0; for (int e = 0; e < 32; ++e) { base[e] = acc; acc += ((tot[e] + 255) >> 8) << 8; } base[32] = acc; }
    __syncthreads();
    int* ROWIDX = (int*)(F.ws + WS_ROWIDX); float* ROWS = (float*)(F.ws + WS_ROWS); float* ROWW = (float*)(F.ws + WS_ROWW); int* TOKPOS = (int*)(F.ws + WS_TOKPOS);
    const TokRec* TOK = (const TokRec*)(F.ws + WS_TOK);
    if (tid < 128) { const int tk = 64 * F.vcu + (tid >> 1), sl = tid & 1; const TokRec t = TOK[tk];
        const int e = sl ? t.e1 : t.e0, s = sl ? t.s1 : t.s0; const int pos = base[e] + mine[e] + s;
        ROWIDX[pos] = tk; ROWS[pos] = t.rstd; ROWW[pos] = sl ? t.w1 : t.w0; TOKPOS[tk * 2 + sl] = pos; }
    if (F.vcu < 32) { const int e = F.vcu, lo = base[e] + tot[e], hi = base[e + 1];
        for (int p = lo + tid; p < hi; p += NWAVES * 64) { ROWIDX[p] = 0; ROWS[p] = 0.f; ROWW[p] = 0.f; } }
    if (F.vcu == 0 && tid < MAXT + 1) { int* TILEE = (int*)(F.ws + WS_TILEE);
        const int nt = base[32] >> 8;
        if (tid == MAXT) TILEE[MAXT] = nt;
        else { int e = 0; for (int q = 1; q < 32; ++q) if ((base[q] >> 8) <= tid) e = q; TILEE[tid] = (tid < nt) ? e : 0; } }
}

__device__ __forceinline__ void p11_final(Frame& F) {
    const int gw = F.vcu * NWAVES + F.wave, NGW = F.G * NWAVES, lane = F.lane;
    const float* H1 = (const float*)(F.ws + WS_H1); const bf16* Y = (const bf16*)(F.ws + WS_Y); const int* TOKPOS = (const int*)(F.ws + WS_TOKPOS);
    f32x4 nw[4];
#pragma unroll
    for (int j = 0; j < 4; ++j) nw[j] = ((const f32x4*)F.norm_final_w)[64 * j + lane];
    for (int r = gw; r < MR; r += NGW) {
        const int p0 = TOKPOS[r * 2], p1 = TOKPOS[r * 2 + 1];
        const f32x4* hr = (const f32x4*)(H1 + (size_t)r * D) + lane;
        const v2u* y0 = (const v2u*)(Y + (size_t)p0 * D) + lane; const v2u* y1 = (const v2u*)(Y + (size_t)p1 * D) + lane;
        f32x4 v[4]; float s = 0.f;
#pragma unroll
        for (int j = 0; j < 4; ++j) { v[j] = hr[64 * j]; const v2u a = y0[64 * j], b = y1[64 * j];
            v[j].x += bflo(a.x) + bflo(b.x); v[j].y += bfhi(a.x) + bfhi(b.x); v[j].z += bflo(a.y) + bflo(b.y); v[j].w += bfhi(a.y) + bfhi(b.y);
            s += (v[j].x * v[j].x + v[j].y * v[j].y) + (v[j].z * v[j].z + v[j].w * v[j].w); }
        const float rstd = 1.f / sqrtf(wave_sum(s) * (1.f / D) + EPS);
        f32x4* orow = (f32x4*)(F.out + (size_t)r * D) + lane;
#pragma unroll
        for (int j = 0; j < 4; ++j) orow[64 * j] = v[j] * rstd * nw[j];
    }
}

constexpr int NPHASES = 12;
#ifndef MK_ONE_LAUNCH
#define MK_ONE_LAUNCH 1
#endif
struct Args { const float* in[20]; float* out; unsigned char* ws; int ph_lo, ph_hi, mode, pad; };
__global__ void __launch_bounds__(NWAVES * 64, 2) hybrid_fwd(Args args) {
    extern __shared__ __attribute__((aligned(16))) unsigned char lds[];
    Frame F;
    F.lds = (LAS unsigned char*)lds;
    F.MISC = (volatile LAS unsigned*)(F.lds + MISC_OFF);
    F.tid = threadIdx.x; F.lane = F.tid & 63; F.wave = __builtin_amdgcn_readfirstlane(F.tid >> 6);
    F.G = gridDim.x; { const int bx = blockIdx.x; F.vcu = (F.G % 8 == 0) ? (bx % 8) * (F.G / 8) + bx / 8 : bx; }
    F.ws = args.ws; F.out = args.out;
    F.x = args.in[0]; F.meta = args.in[1]; F.norm_mix_w = args.in[2]; F.w_in = args.in[3]; F.conv_w = args.in[4]; F.pool_w = args.in[5]; F.pool_scale = args.in[6];
    F.a_log = args.in[7]; F.dt_bias = args.in[8]; F.dn_norm_w = args.in[9]; F.w_out = args.in[10]; F.norm_ffn_w = args.in[11]; F.rg_w = args.in[12]; F.rg_b = args.in[13];
    F.re_w = args.in[14]; F.re_b = args.in[15]; F.w_gate = args.in[16]; F.w_up = args.in[17]; F.w_down = args.in[18]; F.norm_final_w = args.in[19];
    if (F.tid < 64) F.MISC[F.tid] = 0u;
    __syncthreads();
    const int lo = args.ph_lo, hi = args.ph_hi;
    XcdBarrier bar; bar.bar = (unsigned*)(F.ws + WS_CTL); bar.x = 0; bar.st = nullptr;
    if (hi - lo > 1) bar = xcd_barrier_post((unsigned*)(F.ws + WS_CTL), F.MISC + 8);
#ifndef PHMASK
#define PHMASK 0xFFF
#endif
#define IN(k) ((((PHMASK) >> (k)) & 1) && lo <= (k) && (k) < hi)
#define SEAM(k) do { if (IN(k) && IN((k) + 1)) xcd_barrier(bar); } while (0)

    if (IN(0)) { p0_prologue(F); } SEAM(0);

    if (IN(1)) {
        pg8::Gemm g{(const bf16*)(F.ws + WS_U), (const bf16*)(F.ws + WS_BTIN), MR, 3072, D}; pg8::StaticOrder S; S.init(MR, 3072, F.G, (int)blockIdx.x);
        EpiQKV E{(bf16*)(F.ws + WS_QKV), (bf16*)(F.ws + WS_HALO)};
        pg8::gemm_phase<EpiQKV, pg8::StaticOrder, true, false>(F.lds, g, S, E);
        meta_rows_job(F, (const bf16*)(F.ws + WS_BTIN), 3072, (bf16*)(F.ws + WS_QKV), 3072, (bf16*)(F.ws + WS_HALO));
    } SEAM(1);

    if (IN(2)) { p2_chunk_local(F); } SEAM(2);

    if (IN(3)) { p3_scan(F, 0); } SEAM(3);

    if (IN(4)) {
        pg8::Gemm g{(const bf16*)(F.ws + WS_U), (const bf16*)(F.ws + WS_BTIN) + (size_t)3072 * D, MR, 4096, D}; pg8::StaticOrder S; S.init(MR, 4096, F.G, (int)blockIdx.x);
        EpiPZG E{(bf16*)(F.ws + WS_PM), (bf16*)(F.ws + WS_ZS), (bf16*)(F.ws + WS_GP), (bf16*)(F.ws + WS_GD)};
        pg8::gemm_phase<EpiPZG, pg8::StaticOrder, true, false>(F.lds, g, S, E);
        meta_rows_job(F, (const bf16*)(F.ws + WS_BTIN) + (size_t)3072 * D, 1024, (bf16*)(F.ws + WS_PM), 1024, nullptr);
    } SEAM(4);

    if (IN(5)) { p5_merge(F); } SEAM(5);

    if (IN(6)) {
        pg8::Gemm g{(const bf16*)(F.ws + WS_MERGED), (const bf16*)(F.ws + WS_BTOUT), MR, D, D}; pg8::StaticOrder S; S.init(MR, D, F.G, (int)blockIdx.x);
        EpiOut E{F.x, (float*)(F.ws + WS_H1), (bf16*)(F.ws + WS_XN)};
        pg8::gemm_phase<EpiOut, pg8::StaticOrder, false, false>(F.lds, g, S, E);
    } SEAM(6);

    if (IN(7)) { p7_router(F); } SEAM(7);

    if (IN(8)) { p8_index(F); } SEAM(8);

    if (IN(9) || IN(10)) {
        const int* TILEE = (const int*)(F.ws + WS_TILEE); const int ntiles = TILEE[MAXT];
        LAS int* idx = (LAS int*)(F.lds + 131072);
        if (IN(9)) {
            const int* ROWIDX = (const int*)(F.ws + WS_ROWIDX);
            for (int i = 0; i < 3; ++i) { const int Lu = i * F.G + F.vcu; if (Lu < 4 * ntiles) for (int t = F.tid; t < 256; t += NWAVES * 64) idx[i * 256 + t] = ROWIDX[(Lu >> 2) * 256 + t]; }
            __syncthreads();
            pg8::Gemm g{(const bf16*)(F.ws + WS_XN), (const bf16*)(F.ws + WS_BTGU), 0, 0, D};
            MoeOrder S{ntiles, F.G, F.vcu, TILEE, idx};
            EpiGU E{(bf16*)(F.ws + WS_HDN), (const float*)(F.ws + WS_ROWS)};
            pg8::gemm_phase<EpiGU, MoeOrder, true, true>(F.lds, g, S, E);
        }
        SEAM(9);
        if (IN(10)) {
            pg8::Gemm g{(const bf16*)(F.ws + WS_HDN), (const bf16*)(F.ws + WS_BTDN), 0, 0, FF};
            MoeOrder S{ntiles, F.G, F.vcu, TILEE, idx};
            EpiDown E{(bf16*)(F.ws + WS_Y), (const float*)(F.ws + WS_ROWW)};
            pg8::gemm_phase<EpiDown, MoeOrder, true, false>(F.lds, g, S, E);
        }
    }
    SEAM(10);

    if (IN(11)) { p11_final(F); }
#undef IN
#undef SEAM
}

extern "C" void kernel_launch(void* const* d_in, const int* in_sizes, int n_in, void* d_out, int out_size, void* d_ws, size_t ws_size, hipStream_t stream) {
    static int ready = 0;
    if (ready == 0) {
        if (n_in != 20 || in_sizes[0] != MR * D || out_size != MR * D || ws_size < WS_END) {
            fprintf(stderr, "kernel_launch: unexpected problem (n_in %d, in0 %d, out %d, ws %zu)\n", n_in, n_in > 0 ? in_sizes[0] : -1, out_size, ws_size); ready = -1; return; }
        if (hipFuncSetAttribute((const void*)hybrid_fwd, hipFuncAttributeMaxDynamicSharedMemorySize, LDS_BYTES) != hipSuccess) { fprintf(stderr, "kernel_launch: hipFuncSetAttribute failed\n"); ready = -1; return; }
        int per_cu = 0;
        if (hipOccupancyMaxActiveBlocksPerMultiprocessor(&per_cu, (const void*)hybrid_fwd, NWAVES * 64, LDS_BYTES) != hipSuccess || per_cu < 1)
            fprintf(stderr, "kernel_launch: note: occupancy query reports %d workgroups per CU\n", per_cu);
        (void)hipGetLastError();
        ready = 1;
    }
    if (ready < 0) return;
    (void)hipMemsetAsync((char*)d_ws + WS_CTL, 0, CTL_ZERO_BYTES, stream);
    Args a{};
    for (int i = 0; i < 20; ++i) a.in[i] = (const float*)d_in[i];
    a.out = (float*)d_out; a.ws = (unsigned char*)d_ws;
#if defined(PROBE_LO)
    a.ph_lo = 0; a.ph_hi = PROBE_HI; hipLaunchKernelGGL(hybrid_fwd, dim3(256), dim3(NWAVES * 64), LDS_BYTES, stream, a);
    (void)hipMemsetAsync((char*)d_ws + WS_CTL, 0, CTL_ZERO_BYTES, stream);
#if defined(PROBE_MODE)
    a.mode = PROBE_MODE;
#endif
    a.ph_lo = PROBE_LO; a.ph_hi = PROBE_HI; hipLaunchKernelGGL(hybrid_fwd, dim3(256), dim3(NWAVES * 64), LDS_BYTES, stream, a);
    a.mode = 0;
    (void)hipMemsetAsync((char*)d_ws + WS_CTL, 0, CTL_ZERO_BYTES, stream);
    if (PROBE_HI < NPHASES) { a.ph_lo = PROBE_HI; a.ph_hi = NPHASES; hipLaunchKernelGGL(hybrid_fwd, dim3(256), dim3(NWAVES * 64), LDS_BYTES, stream, a); }
#elif MK_ONE_LAUNCH
    a.ph_lo = 0; a.ph_hi = NPHASES;
    hipLaunchKernelGGL(hybrid_fwd, dim3(256), dim3(NWAVES * 64), LDS_BYTES, stream, a);
#else
    for (int p = 0; p < NPHASES; ++p) { a.ph_lo = p; a.ph_hi = p + 1; hipLaunchKernelGGL(hybrid_fwd, dim3(256), dim3(NWAVES * 64), LDS_BYTES, stream, a); }
#endif
}
```
